# Optimizing an MI355X kernel written in HIP

```python
import jax
import jax.numpy as jnp
from jax import lax
import numpy as np

D_MODEL = 1024
BATCH = 16
SEQ = 256
DEPTH = 1
DEC_BATCH = 4
DEC_SEQ = 4096
PAST_LEN = 256

GRID_W = 64
D_FOURIER = 512
N_FOURIER_GROUPS = 8
FOURIER_GROUP = D_FOURIER // N_FOURIER_GROUPS
D_RWKV = D_MODEL - D_FOURIER
HEAD_SIZE = 64
N_RWKV_HEADS = D_RWKV // HEAD_SIZE
DECAY_LORA = 64
ICLR_LORA = 64
GATE_LORA = 128
D_RWKV_IN = 3 * D_RWKV + 2 * DECAY_LORA + 2 * ICLR_LORA + GATE_LORA
D_IN = D_FOURIER + D_RWKV_IN
D_FF = 2816
N_MOD = 9
RMS_EPS = 1e-6
GN_EPS = 64e-5

kernel_name = 'hybrid_fnet_rwkv7_diffusion_step'


def _rmsnorm(x, g):
    xf = x.astype(jnp.float32)
    y = xf * lax.rsqrt(jnp.mean(xf * xf, axis=-1, keepdims=True) + RMS_EPS)
    return (y * g.astype(jnp.float32)).astype(x.dtype)


def _modulate(h, shift, scale):
    return h * (1 + scale[:, None, :]) + shift[:, None, :]


def _swiglu(h, w_gate, w_up, w_down):
    return (jax.nn.silu(h @ w_gate) * (h @ w_up)) @ w_down


def _shift(p, axis, offset):
    n = p.shape[axis]
    pad = [(0, 0)] * p.ndim
    if offset > 0:
        body = lax.slice_in_dim(p, 0, n - offset, axis=axis)
        pad[axis] = (offset, 0)
    else:
        body = lax.slice_in_dim(p, -offset, n, axis=axis)
        pad[axis] = (0, -offset)
    return jnp.pad(body, pad)


def _token_shift(z, grid):
    B, S, C = z.shape
    q = z.reshape(B, S, C // 4, 4)
    if grid:
        rows = S // GRID_W
        g = q.reshape(B, rows, GRID_W, C // 4, 4)
        parts = [_shift(g[..., 0], 2, 1), _shift(g[..., 1], 2, -1),
                 _shift(g[..., 2], 1, 1), _shift(g[..., 3], 1, -1)]
    else:
        parts = [_shift(q[..., 0], 1, 1), _shift(q[..., 1], 1, -1),
                 _shift(q[..., 2], 1, 1), _shift(q[..., 3], 1, -1)]
    return jnp.stack(parts, axis=-1).reshape(B, S, C)


def _wkv7_scan(r, decay, k, v, kk, a, s0, reverse):
    def step(state, inp):
        r_t, w_t, k_t, v_t, kk_t, a_t = inp
        sa = jnp.einsum('bhvk,bhk->bhv', state, -kk_t)
        state = (state * w_t[:, :, None, :]
                 + sa[..., None] * (kk_t * a_t)[:, :, None, :]
                 + v_t[..., None] * k_t[:, :, None, :])
        return state, jnp.einsum('bhvk,bhk->bhv', state, r_t)
    xs = tuple(jnp.moveaxis(t, 1, 0) for t in (r, decay, k, v, kk, a))
    s_final, ys = lax.scan(step, s0, xs, reverse=reverse)
    return jnp.moveaxis(ys, 0, 1), s_final


def _mixer(h, s0_f, s0_b, grid, w_in, mu, w0, w2, a0, a2, g2, k_k, k_a, r_k, ln_w, ln_b, w_out):
    B, S, _ = h.shape
    f32 = jnp.float32
    proj = h @ w_in
    u = proj[..., :D_FOURIER]
    z = proj[..., D_FOURIER:]
    z = (z + mu * (_token_shift(z, grid) - z)).astype(f32)

    uf = u.astype(f32).reshape(B, S, N_FOURIER_GROUPS, FOURIER_GROUP)
    y_four = jnp.fft.fft2(uf, axes=(1, 3), norm='ortho').real.reshape(B, S, D_FOURIER)

    o1, o2, o3 = D_RWKV, 2 * D_RWKV, 3 * D_RWKV
    o4 = o3 + 2 * DECAY_LORA
    o5 = o4 + 2 * ICLR_LORA
    r, k, v = z[..., :o1], z[..., o1:o2], z[..., o2:o3]
    wd = z[..., o3:o4].reshape(B, S, 2, DECAY_LORA)
    ad = z[..., o4:o5].reshape(B, S, 2, ICLR_LORA)
    gd = z[..., o5:]

    def heads(t):
        return t.reshape(B, S, N_RWKV_HEADS, HEAD_SIZE)

    kk = heads(k * k_k.astype(f32))
    kk = kk / jnp.maximum(jnp.linalg.norm(kk, axis=-1, keepdims=True), 1e-12)
    r_h, v_h = heads(r), heads(v)
    r_k_h = r_k.astype(f32).reshape(N_RWKV_HEADS, HEAD_SIZE)

    ys, bonuses, finals = [], [], []
    for d, s0 in enumerate((s0_f, s0_b)):
        w_raw = w0[d] + jnp.tanh(wd[:, :, d]) @ w2[d]
        decay = jnp.exp(-jnp.exp(-jax.nn.softplus(-w_raw) - 0.5))
        a = jax.nn.sigmoid(a0[d] + ad[:, :, d] @ a2[d])
        k_d = heads(k * (1 + (a - 1) * k_a))
        y_d, s_d = _wkv7_scan(r_h, heads(decay), k_d, v_h, kk, heads(a),
                              s0.astype(f32), reverse=(d == 1))
        ys.append(y_d)
        bonuses.append(jnp.sum(r_h * k_d * r_k_h, axis=-1, keepdims=True) * v_h)
        finals.append(s_d)
    y_sum = ys[0] + ys[1]
    mean = jnp.mean(y_sum, axis=-1, keepdims=True)
    var = jnp.mean(jnp.square(y_sum - mean), axis=-1, keepdims=True)
    y_gn = ((y_sum - mean) * lax.rsqrt(var + GN_EPS)).reshape(B, S, D_RWKV) * ln_w + ln_b
    gate = jax.nn.sigmoid(gd) @ g2
    y_rwkv = (y_gn + (bonuses[0] + bonuses[1]).reshape(B, S, D_RWKV)) * gate

    mixed = jnp.concatenate([y_four, y_rwkv], axis=-1).astype(h.dtype)
    return mixed @ w_out, finals[0], finals[1]


def _layer(x, mod, s0_f, s0_b, grid, norm_g, ffn_gate, ffn_up, ffn_down, mixer_params):
    sh1, sc1, g1, sh2, sc2, g2, sh3, sc3, g3 = jnp.split(mod, N_MOD, axis=-1)
    h = _modulate(_rmsnorm(x, norm_g[0]), sh1, sc1)
    x = x + 0.5 * g1[:, None, :] * _swiglu(h, ffn_gate[0], ffn_up[0], ffn_down[0])
    h = _modulate(_rmsnorm(x, norm_g[1]), sh2, sc2)
    mixed, s_f, s_b = _mixer(h, s0_f, s0_b, grid, *mixer_params)
    x = x + g2[:, None, :] * mixed
    h = _modulate(_rmsnorm(x, norm_g[2]), sh3, sc3)
    x = x + 0.5 * g3[:, None, :] * _swiglu(h, ffn_gate[1], ffn_up[1], ffn_down[1])
    return x, s_f, s_b


def setup_inputs(seed: int = 0) -> dict:
    key = jax.random.key(seed)
    ks = jax.random.split(key, 32)
    f32 = jnp.float32

    def nrm(k, shape, s):
        return jax.random.normal(k, shape, f32) * s

    def unif(k, shape, lo, hi):
        return jax.random.uniform(k, shape, f32, lo, hi)

    L = DEPTH
    st_shape = (DEC_BATCH, DEPTH, N_RWKV_HEADS, HEAD_SIZE, HEAD_SIZE)
    return {
        'x_prompt': nrm(ks[0], (BATCH, SEQ, D_MODEL), 1.0),
        'x_sample': nrm(ks[1], (DEC_BATCH, DEC_SEQ, D_MODEL), 1.0),
        'state_fwd': nrm(ks[2], st_shape, 0.5),
        'state_bwd': nrm(ks[3], st_shape, 0.5),
        'c': nrm(ks[4], (DEC_BATCH, D_MODEL), 1.0),
        'c_ctx': nrm(ks[5], (D_MODEL,), 1.0),
        'w_mod': nrm(ks[6], (L, D_MODEL, N_MOD * D_MODEL), 0.5 * D_MODEL ** -0.5),
        'b_mod': nrm(ks[7], (L, N_MOD * D_MODEL), 0.02),
        'norm_g': 1.0 + nrm(ks[8], (L, 3, D_MODEL), 0.05),
        'ffn_w_gate': nrm(ks[9], (L, 2, D_MODEL, D_FF), D_MODEL ** -0.5),
        'ffn_w_up': nrm(ks[10], (L, 2, D_MODEL, D_FF), D_MODEL ** -0.5),
        'ffn_w_down': nrm(ks[11], (L, 2, D_FF, D_MODEL), D_FF ** -0.5),
        'w_in': nrm(ks[12], (L, D_MODEL, D_IN), D_MODEL ** -0.5),
        'shift_mu': unif(ks[13], (L, D_RWKV_IN), 0.2, 0.8),
        'decay_w0': unif(ks[14], (L, 2, D_RWKV), -6.0, -1.0),
        'decay_w2': nrm(ks[15], (L, 2, DECAY_LORA, D_RWKV), 0.5 * DECAY_LORA ** -0.5),
        'iclr_a0': nrm(ks[16], (L, 2, D_RWKV), 0.1),
        'iclr_a2': nrm(ks[17], (L, 2, ICLR_LORA, D_RWKV), 0.5 * ICLR_LORA ** -0.5),
        'gate_g2': nrm(ks[18], (L, GATE_LORA, D_RWKV), GATE_LORA ** -0.5),
        'k_k': 0.85 + nrm(ks[19], (L, D_RWKV), 0.05),
        'k_a': 1.0 + nrm(ks[20], (L, D_RWKV), 0.05),
        'r_k': nrm(ks[21], (L, D_RWKV), 0.1),
        'ln_x_w': 1.0 + nrm(ks[22], (L, D_RWKV), 0.05),
        'ln_x_b': nrm(ks[23], (L, D_RWKV), 0.02),
        'w_out': nrm(ks[24], (L, D_MODEL, D_MODEL), D_MODEL ** -0.5),
        'final_norm': 1.0 + nrm(ks[25], (D_MODEL,), 0.05),
    }


def reference(x_prompt, x_sample, state_fwd, state_bwd, c, c_ctx, w_mod, b_mod, norm_g,
              ffn_w_gate, ffn_w_up, ffn_w_down, w_in, shift_mu, decay_w0, decay_w2,
              iclr_a0, iclr_a2, gate_g2, k_k, k_a, r_k, ln_x_w, ln_x_b, w_out, final_norm):
    xp, xs = x_prompt, x_sample
    bp = xp.shape[0]
    zero_state = jnp.zeros((bp, N_RWKV_HEADS, HEAD_SIZE, HEAD_SIZE), jnp.float32)
    new_f, new_b = [], []
    for l in range(DEPTH):
        mp = (w_in[l], shift_mu[l], decay_w0[l], decay_w2[l], iclr_a0[l], iclr_a2[l],
              gate_g2[l], k_k[l], k_a[l], r_k[l], ln_x_w[l], ln_x_b[l], w_out[l])
        mod_ctx = jnp.broadcast_to(jax.nn.silu(c_ctx) @ w_mod[l] + b_mod[l], (bp, N_MOD * D_MODEL))
        xp, s_f, s_b = _layer(xp, mod_ctx, zero_state, zero_state, False, norm_g[l],
                              ffn_w_gate[l], ffn_w_up[l], ffn_w_down[l], mp)
        new_f.append(s_f.astype(x_prompt.dtype))
        new_b.append(s_b.astype(x_prompt.dtype))
        mod_lat = jax.nn.silu(c) @ w_mod[l] + b_mod[l]
        xs, _, _ = _layer(xs, mod_lat, state_fwd[:, l], state_bwd[:, l], True, norm_g[l],
                          ffn_w_gate[l], ffn_w_up[l], ffn_w_down[l], mp)
    y_prompt = _rmsnorm(xp, final_norm)
    y_sample = _rmsnorm(xs, final_norm)
    return (y_prompt, y_sample, jnp.stack(new_f, axis=1), jnp.stack(new_b, axis=1))
```

```cpp
#include <hip/hip_runtime.h>
#include <hip/hip_cooperative_groups.h>
#include <cstdio>
namespace cg = cooperative_groups;

namespace pg8 {
#define PG8_LAS __attribute__((address_space(3)))
typedef unsigned short bf16_t;
typedef short bf16x8 __attribute__((ext_vector_type(8)));
typedef float f32x4 __attribute__((ext_vector_type(4)));
typedef unsigned u32x4 __attribute__((ext_vector_type(4)));
typedef unsigned u32x2 __attribute__((ext_vector_type(2)));
constexpr int BM = 256, BK = 64, HALF = 128, HTB = HALF * BK * 2, STAGE_BYTES = 8 * HTB, NXCD = 8, WGM = 8;

__host__ __device__ __forceinline__ int lds_byte(int r, int c) { const int st = (r >> 4) * 2 + (c >> 5), rr = r & 15, cc = c & 31, ob = rr * 64 + cc * 2; return st * 1024 + (ob ^ (((ob >> 9) & 1) << 5)); }
__host__ __device__ __forceinline__ void stage_rc(int b, int& R, int& C) { const int st = b / 1024, sb = b % 1024, swz = sb ^ (((sb >> 9) & 1) << 5); R = (st >> 1) * 16 + swz / 64; C = (st & 1) * 32 + (swz % 64) / 2; }
__host__ __device__ __forceinline__ int perm32(int rho) { const int n = rho >> 4, i = rho & 15; return 8 * (i >> 2) + 4 * n + (i & 3); }

struct Unit { int pm, pn, kind, aux; const char* a; const char* b; };

__device__ __forceinline__ void tile_of(int wgid, int nM, int nN, int& pm, int& pn) {
    const int nwg = nM * nN;
    { const int q = nwg / NXCD, r = nwg % NXCD, xcd = wgid % NXCD, off = wgid / NXCD; wgid = (xcd < r ? xcd * (q + 1) : r * (q + 1) + (xcd - r) * q) + off; }
    const int nig = WGM * nN, gid = wgid / nig, fm = gid * WGM, gsz = (nM - fm) < WGM ? (nM - fm) : WGM;
    pm = fm + ((wgid % nig) % gsz); pn = (wgid % nig) / gsz;
}
__device__ __forceinline__ unsigned cvt_pk_bf16(float lo, float hi) { unsigned r; asm volatile("v_cvt_pk_bf16_f32 %0, %1, %2" : "=v"(r) : "v"(lo), "v"(hi)); return r; }

template <class Epi, class Sched>
__device__ __forceinline__ void gemm_phase(PG8_LAS unsigned char* lds, const int K, const Sched& S, const Epi& E) {
    int tid = threadIdx.x; asm volatile("" : "+v"(tid));
    const int wid = __builtin_amdgcn_readfirstlane(tid >> 6), lane = tid & 63, wr = wid >> 2, wc = wid & 3, fr = lane & 15, fq = lane >> 4;
    const int nt = K / BK;
#define PG8_STAMP() do {} while (0)
    PG8_STAMP();
    unsigned voffA[2], voffB[2];
#pragma unroll
    for (int i = 0; i < 2; ++i) { int R, C; stage_rc(tid * 16 + i * 8192, R, C); const int Rb = Epi::PERM ? ((R & ~31) + perm32(R & 31)) : R;
        voffA[i] = (unsigned)(R * K + C) * 2u; voffB[i] = (unsigned)(Rb * K + C) * 2u; }
    const size_t kstep = (size_t)(BK * 2);
    const size_t hstep = (size_t)HALF * K * 2;
    const unsigned ldsw = (unsigned)wid * 1024u;
    const int aoff = lds_byte(wr * 64 + fr, fq * 8), boff = lds_byte(wc * 32 + fr, fq * 8);
#define PG8_SA(b, h) (((b) * 2 + (h)) * HTB)
#define PG8_SB(b, h) ((4 + (b) * 2 + (h)) * HTB)
#define PG8_STAGE(bufoff, gbase, voff) do { _Pragma("unroll") for (int _i = 0; _i < 2; ++_i) \
        __builtin_amdgcn_global_load_lds((const unsigned*)((const char*)(gbase) + (voff)[_i]), (PG8_LAS unsigned*)(lds + (bufoff) + ldsw + _i * 8192), 16, 0, 0); } while (0)
#define PG8_LDA(dst, b, h) do { _Pragma("unroll") for (int m = 0; m < 4; ++m) _Pragma("unroll") for (int k = 0; k < 2; ++k) dst[m][k] = *(const PG8_LAS bf16x8*)(lds + PG8_SA(b, h) + aoff + m * 2048 + k * 1024); } while (0)
#define PG8_LDB(dst, b, h) do { _Pragma("unroll") for (int n = 0; n < 2; ++n) _Pragma("unroll") for (int k = 0; k < 2; ++k) dst[n][k] = *(const PG8_LAS bf16x8*)(lds + PG8_SB(b, h) + boff + n * 2048 + k * 1024); } while (0)
#define PG8_MMA(ai, bj, At, Bt) do { __builtin_amdgcn_s_setprio(1); _Pragma("unroll") for (int m = 0; m < 4; ++m) _Pragma("unroll") for (int n = 0; n < 2; ++n) _Pragma("unroll") for (int k = 0; k < 2; ++k) \
        acc[ai][bj][m][n] = __builtin_amdgcn_mfma_f32_16x16x32_bf16(Bt[n][k], At[m][k], acc[ai][bj][m][n], 0, 0, 0); __builtin_amdgcn_s_setprio(0); } while (0)
#define PG8_WAIT_V(n) asm volatile("s_waitcnt vmcnt(" #n ")" ::: "memory")
#define PG8_WAIT_L(n) asm volatile("s_waitcnt lgkmcnt(" #n ")" ::: "memory")
#define PG8_BAR __builtin_amdgcn_s_barrier()
#define PG8_SCHED __builtin_amdgcn_sched_barrier(0)
    Unit cur, nxt; int ui = 0;
    if (!S.next(0, cur)) return;
    f32x4 acc[2][2][4][2];
#pragma unroll
    for (int a = 0; a < 2; ++a)
#pragma unroll
        for (int b = 0; b < 2; ++b)
#pragma unroll
            for (int m = 0; m < 4; ++m)
#pragma unroll
                for (int n = 0; n < 2; ++n) acc[a][b][m][n] = (f32x4){0.f, 0.f, 0.f, 0.f};
    bf16x8 At[4][2], B0[2][2], B1[2][2];
    const char* cA = cur.a; const char* cB = cur.b;
    PG8_STAGE(PG8_SB(0, 0), cB, voffB); PG8_STAGE(PG8_SA(0, 0), cA, voffA); PG8_STAGE(PG8_SB(0, 1), cB + hstep, voffB); PG8_STAGE(PG8_SA(0, 1), cA + hstep, voffA);
    if (wr == 1) PG8_BAR;
    PG8_WAIT_V(4); PG8_BAR;
    PG8_STAGE(PG8_SB(1, 0), cB + kstep, voffB); PG8_STAGE(PG8_SA(1, 0), cA + kstep, voffA); PG8_STAGE(PG8_SB(1, 1), cB + hstep + kstep, voffB);
    PG8_WAIT_V(6); PG8_BAR;
    PG8_STAMP();
    for (;;) {
        const bool has_next = S.next(ui + 1, nxt);
        const char* nA = has_next ? nxt.a : cA; const char* nB = has_next ? nxt.b : cB;
        for (int t = 0; t < nt; t += 2) {
            const bool last = (t == nt - 2);
            const char* a1 = cA + (size_t)(t + 1) * kstep;
            const char* a2 = last ? nA : cA + (size_t)(t + 2) * kstep; const char* b2 = last ? nB : cB + (size_t)(t + 2) * kstep;
            const char* a3 = a2 + kstep; const char* b3 = b2 + kstep;
            PG8_LDB(B0, 0, 0); PG8_SCHED; PG8_LDA(At, 0, 0); PG8_STAGE(PG8_SA(1, 1), a1 + hstep, voffA);
            PG8_WAIT_L(8); PG8_BAR; PG8_WAIT_L(0); PG8_MMA(0, 0, At, B0); PG8_BAR; PG8_SCHED;
            PG8_LDB(B1, 0, 1); PG8_STAGE(PG8_SB(0, 0), b2, voffB);
            PG8_BAR; PG8_WAIT_L(0); PG8_MMA(0, 1, At, B1); PG8_BAR;
            PG8_LDA(At, 0, 1); PG8_STAGE(PG8_SA(0, 0), a2, voffA);
            PG8_BAR; PG8_WAIT_L(0); PG8_MMA(1, 0, At, B0); PG8_BAR; PG8_SCHED;
            PG8_STAGE(PG8_SB(0, 1), b2 + hstep, voffB);
            PG8_WAIT_V(6); PG8_BAR; PG8_MMA(1, 1, At, B1); PG8_BAR;
            PG8_LDB(B0, 1, 0); PG8_SCHED; PG8_LDA(At, 1, 0); PG8_STAGE(PG8_SA(0, 1), a2 + hstep, voffA);
            PG8_WAIT_L(8); PG8_BAR; PG8_WAIT_L(0); PG8_MMA(0, 0, At, B0); PG8_BAR; PG8_SCHED;
            PG8_LDB(B1, 1, 1); PG8_STAGE(PG8_SB(1, 0), b3, voffB);
            PG8_BAR; PG8_WAIT_L(0); PG8_MMA(0, 1, At, B1); PG8_BAR;
            PG8_LDA(At, 1, 1); PG8_STAGE(PG8_SA(1, 0), a3, voffA);
            PG8_BAR; PG8_WAIT_L(0); PG8_MMA(1, 0, At, B0); PG8_BAR; PG8_SCHED;
            PG8_STAGE(PG8_SB(1, 1), b3 + hstep, voffB);
            PG8_WAIT_V(6); PG8_BAR; PG8_MMA(1, 1, At, B1); PG8_BAR;
        }
        PG8_STAMP();
        { int fr2 = lane & 15, fq2 = lane >> 4; asm volatile("" : "+v"(fr2), "+v"(fq2)); E(acc, cur, wr, wc, fr2, fq2); }
        PG8_STAMP();
        if (!has_next) break;
#pragma unroll
        for (int a = 0; a < 2; ++a)
#pragma unroll
            for (int b = 0; b < 2; ++b)
#pragma unroll
                for (int m = 0; m < 4; ++m)
#pragma unroll
                    for (int n = 0; n < 2; ++n) acc[a][b][m][n] = (f32x4){0.f, 0.f, 0.f, 0.f};
        cur = nxt; cA = nA; cB = nB; ++ui;
    }
    PG8_WAIT_V(0);
    if (wr == 0) PG8_BAR;
    PG8_BAR;
    PG8_STAMP();
#undef PG8_STAMP
#undef PG8_SA
#undef PG8_SB
#undef PG8_STAGE
#undef PG8_LDA
#undef PG8_LDB
#undef PG8_MMA
#undef PG8_WAIT_V
#undef PG8_WAIT_L
#undef PG8_BAR
#undef PG8_SCHED
}
}
using pg8::bf16_t; using pg8::bf16x8; using pg8::f32x4; using pg8::u32x4; using pg8::u32x2; using pg8::Unit; using pg8::cvt_pk_bf16;

constexpr int NTOK = 20480, NCTX = 4096, DM = 1024, DFF = 2816, DRW = 512, DZ = 1920, NMOD = 9216;
constexpr int LDS_BYTES = 131072;
constexpr size_t WS_MOD = 0, WS_BONUS = 262144, WS_W2T = 1572864, WS_A2T = 1703936, WS_G2T = 1835008, WS_DCTX = 1966080, WS_WOUT = 2228224,
    WS_EARLY = 4325376, WS_W1GU = WS_EARLY, WS_W1D = WS_W1GU + 11534336, WS_WZ = WS_W1D + 5767168, WS_WF = WS_WZ + 4194304, WS_Y1 = WS_EARLY,
    WS_H = 27918336, WS_BIG = 69861376, WS_Z = WS_BIG, WS_PT = WS_Z + 78643200, WS_DLAT = WS_PT + 41943040, WS_ACT = WS_BIG,
    WS_W2GU = WS_DLAT, WS_W2D = WS_W2GU + 11534336, WS_END = WS_DLAT + 67108864;
static_assert(WS_WF + 2097152 <= WS_H && WS_ACT + (size_t)NTOK * DFF * 2 <= WS_DLAT && WS_END <= 268435456, "workspace map");

struct Params { const float* in[26]; float* out; unsigned char* ws; };
enum { I_XP = 0, I_XS, I_SF, I_SB, I_C, I_CCTX, I_WMOD, I_BMOD, I_NORMG, I_WG, I_WU, I_WD, I_WIN, I_MU, I_W0, I_W2, I_A0, I_A2, I_G2, I_KK, I_KA, I_RK, I_LNW, I_LNB, I_WOUT, I_FN };

__device__ __forceinline__ float bf2f(bf16_t v) { return __uint_as_float(((unsigned)v) << 16); }
__device__ __forceinline__ bf16_t f2bf(float f) { unsigned u = __float_as_uint(f); u += 0x7FFFu + ((u >> 16) & 1u); return (bf16_t)(u >> 16); }
__device__ __forceinline__ float sigm(float x) { return __builtin_amdgcn_rcpf(1.0f + __expf(-x)); }
__device__ __forceinline__ float wave_sum(float x) {
#pragma unroll
    for (int o = 32; o > 0; o >>= 1) x += __shfl_xor(x, o);
    return x;
}
template <int CTRL> __device__ __forceinline__ float dpp_mov(float x) { return __int_as_float(__builtin_amdgcn_update_dpp(0, __float_as_int(x), CTRL, 0xF, 0xF, true)); }
__device__ __forceinline__ float red16(float x) { x += dpp_mov<0xB1>(x); x += dpp_mov<0x4E>(x); x += dpp_mov<0x141>(x); x += dpp_mov<0x140>(x); return x; }

__device__ __forceinline__ float zshift(const bf16_t* __restrict__ Z, int tb, int t, int S, bool grid, int col, float mu) {
    const float z0 = bf2f(Z[(size_t)(tb + t) * DZ + col]);
    const int d = col & 3; int tn; bool ok;
    if (!grid) { if (d & 1) { tn = t + 1; ok = tn < S; } else { tn = t - 1; ok = tn >= 0; } }
    else { if (d == 0) { tn = t - 1; ok = (t & 63) != 0; } else if (d == 1) { tn = t + 1; ok = (t & 63) != 63; } else if (d == 2) { tn = t - 64; ok = t >= 64; } else { tn = t + 64; ok = t < S - 64; } }
    const float zn = ok ? bf2f(Z[(size_t)(tb + tn) * DZ + col]) : 0.0f;
    return z0 + mu * (zn - z0);
}

struct SchedPlain { const char* A; const char* B; int nM, nN, K, G, c;
    __device__ __forceinline__ bool next(int i, Unit& u) const { const long L = (long)i * G + c; if (L >= (long)nM * nN) return false;
        pg8::tile_of((int)L, nM, nN, u.pm, u.pn); u.kind = 0; u.aux = 0; u.a = A + (size_t)u.pm * 512 * K; u.b = B + (size_t)u.pn * 512 * K; return true; } };
struct SchedWin { const char* H; const char* WZ; const char* WF; int G, c;
    __device__ __forceinline__ bool next(int i, Unit& u) const { const long L = (long)i * G + c; if (L >= 960) return false;
        if (L < 640) { pg8::tile_of((int)L, 80, 8, u.pm, u.pn); u.kind = 0; u.a = H + (size_t)u.pm * 524288; u.b = WZ + (size_t)u.pn * 524288; }
        else { pg8::tile_of((int)L - 640, 4, 80, u.pm, u.pn); u.kind = 1; u.a = WF + (size_t)u.pm * 524288; u.b = H + (size_t)u.pn * 524288; }
        u.aux = 0; return true; } };
struct SchedFourLat { const char* D; const char* PT; int G, c;
    __device__ __forceinline__ bool next(int i, Unit& u) const { const long L = (long)i * G + c; if (L >= 128) return false;
        const int b = (int)L >> 5, r = (int)L & 31; u.pm = r & 15; u.pn = r >> 4; u.kind = 0; u.aux = NCTX + b * 4096;
        u.a = D + (size_t)u.pm * 256 * 8192 * 2; u.b = PT + ((size_t)b * 512 + u.pn * 256) * 8192 * 2; return true; } };
struct SchedFourCtx { const char* D; const char* PT; int G, c;
    __device__ __forceinline__ bool next(int i, Unit& u) const { const long L = (long)i * G + c; if (L >= 32) return false;
        const int b = (int)L >> 1; u.pm = 0; u.pn = (int)L & 1; u.kind = 0; u.aux = b * 256;
        u.a = D; u.b = PT + ((size_t)b * 512 + u.pn * 256) * 512 * 2; return true; } };

struct EpiGU {
    static constexpr bool PERM = true; bf16_t* ACT;
    __device__ __forceinline__ void operator()(const f32x4 (&acc)[2][2][4][2], const Unit& u, int wr, int wc, int fr, int fq) const {
        const int row0 = u.pm * 256 + wr * 64 + fr, col0 = u.pn * 128 + wc * 32 + fq * 8;
#pragma unroll
        for (int ai = 0; ai < 2; ++ai)
#pragma unroll
            for (int m = 0; m < 4; ++m) {
                float o[8];
#pragma unroll
                for (int n = 0; n < 2; ++n)
#pragma unroll
                    for (int j = 0; j < 4; ++j) { const float g = acc[ai][0][m][n][j], uu = acc[ai][1][m][n][j]; o[n * 4 + j] = g * sigm(g) * uu; }
                u32x4 w; w.x = cvt_pk_bf16(o[0], o[1]); w.y = cvt_pk_bf16(o[2], o[3]); w.z = cvt_pk_bf16(o[4], o[5]); w.w = cvt_pk_bf16(o[6], o[7]);
                *(u32x4*)(ACT + (size_t)(row0 + ai * 128 + m * 16) * DFF + col0) = w;
            }
    }
};
struct EpiRes {
    static constexpr bool PERM = true; const float* xa; const float* xb; float* out; const float* mod; int goff; float scale;
    __device__ __forceinline__ void operator()(const f32x4 (&acc)[2][2][4][2], const Unit& u, int wr, int wc, int fr, int fq) const {
        const int mi = u.pm < 16 ? 0 : 1 + ((u.pm - 16) >> 4);
        const int row0 = u.pm * 256 + wr * 64 + fr, col0 = u.pn * 256 + wc * 32 + fq * 8;
        f32x4 gv[2][2];
#pragma unroll
        for (int bj = 0; bj < 2; ++bj)
#pragma unroll
            for (int n = 0; n < 2; ++n) gv[bj][n] = *(const f32x4*)(mod + mi * NMOD + goff + col0 + bj * 128 + n * 4) * scale;
#pragma unroll
        for (int ai = 0; ai < 2; ++ai)
#pragma unroll
            for (int m = 0; m < 4; ++m) {
                const int row = row0 + ai * 128 + m * 16;
                const float* sp = (row < NCTX ? xa + (size_t)row * DM : xb + (size_t)(row - NCTX) * DM) + col0;
                float* op = out + (size_t)row * DM + col0;
#pragma unroll
                for (int bj = 0; bj < 2; ++bj)
#pragma unroll
                    for (int n = 0; n < 2; ++n) { const f32x4 x = *(const f32x4*)(sp + bj * 128 + n * 4); *(f32x4*)(op + bj * 128 + n * 4) = x + gv[bj][n] * acc[ai][bj][m][n]; }
            }
    }
};
struct EpiWin {
    static constexpr bool PERM = true; bf16_t* Z; bf16_t* PT;
    __device__ __forceinline__ void operator()(const f32x4 (&acc)[2][2][4][2], const Unit& u, int wr, int wc, int fr, int fq) const {
        const int row0 = u.pm * 256 + wr * 64 + fr, cin = wc * 32 + fq * 8;
#pragma unroll
        for (int ai = 0; ai < 2; ++ai)
#pragma unroll
            for (int m = 0; m < 4; ++m) {
                const int row = row0 + ai * 128 + m * 16;
#pragma unroll
                for (int bj = 0; bj < 2; ++bj) {
                    const f32x4 v0 = acc[ai][bj][m][0], v1 = acc[ai][bj][m][1];
                    u32x4 w; w.x = cvt_pk_bf16(v0[0], v0[1]); w.y = cvt_pk_bf16(v0[2], v0[3]); w.z = cvt_pk_bf16(v1[0], v1[1]); w.w = cvt_pk_bf16(v1[2], v1[3]);
                    const int ct = bj * 128 + cin;
                    if (u.kind == 0) { const int col = u.pn * 256 + ct; if (col < DZ) *(u32x4*)(Z + (size_t)row * DZ + col) = w; }
                    else { const int part = row >> 9, ch = row & 511; bf16_t* dst;
                        if (u.pn < 16) dst = PT + (((size_t)u.pn * 512 + ch) * 2 + part) * 256 + ct;
                        else { const int lt = u.pn - 16, bb = lt >> 4, s0 = (lt & 15) * 256; dst = PT + 4194304 + (((size_t)bb * 512 + ch) * 2 + part) * 4096 + s0 + ct; }
                        *(u32x4*)dst = w; }
                }
            }
    }
};
struct EpiFour {
    static constexpr bool PERM = true; bf16_t* MIX; float scale;
    __device__ __forceinline__ void operator()(const f32x4 (&acc)[2][2][4][2], const Unit& u, int wr, int wc, int fr, int fq) const {
        const int row0 = u.aux + u.pm * 256 + wr * 64 + fr, col0 = u.pn * 256 + wc * 32 + fq * 8;
#pragma unroll
        for (int ai = 0; ai < 2; ++ai)
#pragma unroll
            for (int m = 0; m < 4; ++m)
#pragma unroll
                for (int bj = 0; bj < 2; ++bj) {
                    const f32x4 v0 = acc[ai][bj][m][0] * scale, v1 = acc[ai][bj][m][1] * scale;
                    u32x4 w; w.x = cvt_pk_bf16(v0[0], v0[1]); w.y = cvt_pk_bf16(v0[2], v0[3]); w.z = cvt_pk_bf16(v1[0], v1[1]); w.w = cvt_pk_bf16(v1[2], v1[3]);
                    *(u32x4*)(MIX + (size_t)(row0 + ai * 128 + m * 16) * DM + col0 + bj * 128) = w;
                }
    }
};

__device__ __forceinline__ void tconv_load(const float* __restrict__ src, int ld, int k0, int n0, float* tile) {
    const int tid = threadIdx.x;
#pragma unroll
    for (int r = 0; r < 2; ++r) { const int idx = tid + 512 * r, i = idx >> 4, j4 = idx & 15; const float4 v = *(const float4*)(src + (size_t)(k0 + i) * ld + n0 + 4 * j4);
        float* t = tile + i * 65 + 4 * j4; t[0] = v.x; t[1] = v.y; t[2] = v.z; t[3] = v.w; }
}
__device__ __forceinline__ void tconv_tile(const float* __restrict__ src, int ld, int k0, int n0, bf16_t* __restrict__ dst, int ldd, int drow0, float* tile) {
    const int tid = threadIdx.x;
    tconv_load(src, ld, k0, n0, tile);
    __syncthreads();
    { const int j = tid >> 3, ic = tid & 7; const float* t = tile + (ic * 8) * 65 + j; u32x4 w;
      w.x = cvt_pk_bf16(t[0], t[65]); w.y = cvt_pk_bf16(t[130], t[195]); w.z = cvt_pk_bf16(t[260], t[325]); w.w = cvt_pk_bf16(t[390], t[455]);
      *(u32x4*)(dst + (size_t)(drow0 + j) * ldd + k0 + ic * 8) = w; }
    __syncthreads();
}
__device__ __forceinline__ void ffn_conv(const float* wg, const float* wu, const float* wd, bf16_t* WGU, bf16_t* WD, float* tile) {
    for (int t = blockIdx.x; t < 2112; t += gridDim.x) {
        int u = t;
        if (u < 1408) { const bool up = u >= 704; if (up) u -= 704; const int k0 = (u / 44) * 64, n0 = (u % 44) * 64;
            tconv_tile(up ? wu : wg, DFF, k0, n0, WGU, DM, (n0 >> 7) * 256 + (n0 & 127) + (up ? 128 : 0), tile); }
        else { u -= 1408; const int k0 = (u >> 4) * 64, n0 = (u & 15) * 64; tconv_tile(wd, DM, k0, n0, WD, DFF, n0, tile); }
    }
}

__device__ __forceinline__ void phase0(const Params& p, unsigned char* lds) {
    float* tile = (float*)lds; float* cos64 = (float*)(lds + 16640); float* T = (float*)(lds + 16896); float* sil = (float*)(lds + 33280); float* red = (float*)(lds + 53760);
    const int tid = threadIdx.x, bid = blockIdx.x, nb = gridDim.x;
    unsigned char* ws = p.ws;
    for (int i = tid; i < 4096; i += 512) T[i] = cospif((float)i * (1.0f / 2048.0f));
    if (tid < 64) cos64[tid] = cospif((float)tid * (1.0f / 32.0f));
    for (int i = tid; i < 5120; i += 512) { const int r = i >> 10, k = i & 1023; const float c = r == 0 ? p.in[I_CCTX][k] : p.in[I_C][(r - 1) * 1024 + k]; sil[i] = c * sigm(c); }
    __syncthreads();
    for (int it = bid; it < 288; it += nb) {
        const int jj = tid & 31, kg = tid >> 5, j = it * 32 + jj; const float* wp = p.in[I_WMOD] + (size_t)(kg * 64) * NMOD + j; const float* sp = sil + kg * 64;
        float a0 = 0.f, a1 = 0.f, a2 = 0.f, a3 = 0.f, a4 = 0.f;
#pragma unroll 8
        for (int k = 0; k < 64; ++k) { const float w = wp[(size_t)k * NMOD]; a0 += sp[k] * w; a1 += sp[1024 + k] * w; a2 += sp[2048 + k] * w; a3 += sp[3072 + k] * w; a4 += sp[4096 + k] * w; }
        float* rp = red + kg * 160 + jj; rp[0] = a0; rp[32] = a1; rp[64] = a2; rp[96] = a3; rp[128] = a4;
        __syncthreads();
        if (tid < 160) { float s = 0.f;
#pragma unroll
            for (int g = 0; g < 16; ++g) s += red[g * 160 + tid];
            const int i = tid >> 5; ((float*)(ws + WS_MOD))[i * NMOD + it * 32 + (tid & 31)] = s + p.in[I_BMOD][it * 32 + (tid & 31)]; }
        __syncthreads();
    }
    ffn_conv(p.in[I_WG], p.in[I_WU], p.in[I_WD], (bf16_t*)(ws + WS_W1GU), (bf16_t*)(ws + WS_W1D), tile);
    for (int t = bid; t < 784; t += nb) {
        int u = t;
        if (u < 480) { const int k0 = (u / 30) * 64, n0 = (u % 30) * 64; tconv_tile(p.in[I_WIN] + 512, 2432, k0, n0, (bf16_t*)(ws + WS_WZ), DM, n0, tile); }
        else if ((u -= 480) < 256) { const int k0 = (u >> 4) * 64, n0 = (u & 15) * 64; tconv_tile(p.in[I_WOUT], DM, k0, n0, (bf16_t*)(ws + WS_WOUT), DM, n0, tile); }
        else if ((u -= 256) < 16) { const int d = u >> 3, n0 = (u & 7) * 64; tconv_tile(p.in[I_W2] + d * 64 * 512, 512, 0, n0, (bf16_t*)(ws + WS_W2T) + d * 512 * 64, 64, n0, tile); }
        else if ((u -= 16) < 16) { const int d = u >> 3, n0 = (u & 7) * 64; tconv_tile(p.in[I_A2] + d * 64 * 512, 512, 0, n0, (bf16_t*)(ws + WS_A2T) + d * 512 * 64, 64, n0, tile); }
        else { u -= 16; const int k0 = (u >> 3) * 64, n0 = (u & 7) * 64; tconv_tile(p.in[I_G2], 512, k0, n0, (bf16_t*)(ws + WS_G2T), 128, n0, tile); }
    }
    for (int t = bid; t < 128; t += nb) {
        const int kt = t >> 3, g = t & 7;
        tconv_load(p.in[I_WIN], 2432, kt * 64, g * 64, tile);
        __syncthreads();
        { const int j = tid >> 3, ic = tid & 7; float ac[8], as[8];
#pragma unroll
          for (int e = 0; e < 8; ++e) { ac[e] = 0.f; as[e] = 0.f; }
          for (int c = 0; c < 64; ++c) { const float cs = cos64[(c * j) & 63], sn = cos64[(c * j - 16) & 63];
#pragma unroll
              for (int e = 0; e < 8; ++e) { const float w = tile[(ic * 8 + e) * 65 + c]; ac[e] += w * cs; as[e] += w * sn; } }
          u32x4 w; bf16_t* WF = (bf16_t*)(ws + WS_WF);
          w.x = cvt_pk_bf16(ac[0], ac[1]); w.y = cvt_pk_bf16(ac[2], ac[3]); w.z = cvt_pk_bf16(ac[4], ac[5]); w.w = cvt_pk_bf16(ac[6], ac[7]);
          *(u32x4*)(WF + (size_t)(g * 64 + j) * DM + kt * 64 + ic * 8) = w;
          w.x = cvt_pk_bf16(as[0], as[1]); w.y = cvt_pk_bf16(as[2], as[3]); w.z = cvt_pk_bf16(as[4], as[5]); w.w = cvt_pk_bf16(as[6], as[7]);
          *(u32x4*)(WF + (size_t)(512 + g * 64 + j) * DM + kt * 64 + ic * 8) = w; }
        __syncthreads();
    }
    const size_t gt = (size_t)bid * 512 + tid, ngt = (size_t)nb * 512;
    for (size_t i = gt; i < 16384; i += ngt) ((u32x4*)(ws + WS_WZ + (size_t)1920 * DM * 2))[i] = (u32x4){0u, 0u, 0u, 0u};
    for (size_t i = gt; i < (size_t)4096 * 1024; i += ngt) {
        const int sp = (int)(i >> 10), k0 = ((int)i & 1023) * 8, part = k0 >> 12, kk0 = k0 & 4095; float v[8];
#pragma unroll
        for (int e = 0; e < 8; ++e) { const int j = (sp * (kk0 + e)) & 4095; v[e] = part ? -T[(j - 1024) & 4095] : T[j]; }
        u32x4 w; w.x = cvt_pk_bf16(v[0], v[1]); w.y = cvt_pk_bf16(v[2], v[3]); w.z = cvt_pk_bf16(v[4], v[5]); w.w = cvt_pk_bf16(v[6], v[7]);
        ((u32x4*)(ws + WS_DLAT))[i] = w;
    }
    for (size_t i = gt; i < (size_t)256 * 64; i += ngt) {
        const int sp = (int)(i >> 6), k0 = ((int)i & 63) * 8, part = k0 >> 8, kk0 = k0 & 255; float v[8];
#pragma unroll
        for (int e = 0; e < 8; ++e) { const int j = ((sp * (kk0 + e)) & 255) * 16; v[e] = part ? -T[(j - 1024) & 4095] : T[j]; }
        u32x4 w; w.x = cvt_pk_bf16(v[0], v[1]); w.y = cvt_pk_bf16(v[2], v[3]); w.z = cvt_pk_bf16(v[4], v[5]); w.w = cvt_pk_bf16(v[6], v[7]);
        ((u32x4*)(ws + WS_DCTX))[i] = w;
    }
}

__device__ __forceinline__ void norm_phase(const float* xa, const float* xb, const float* gamma, const float* mod, int sh_off, int sc_off, bf16_t* H) {
    const int lane = threadIdx.x & 63, gw = blockIdx.x * 8 + (threadIdx.x >> 6), nw = gridDim.x * 8;
    for (int row = gw; row < NTOK; row += nw) {
        const float* x = row < NCTX ? xa + (size_t)row * DM : xb + (size_t)(row - NCTX) * DM;
        const float* mp = mod + (row < NCTX ? 0 : 1 + ((row - NCTX) >> 12)) * NMOD;
        float4 v[4]; float ss = 0.f;
#pragma unroll
        for (int i = 0; i < 4; ++i) { v[i] = ((const float4*)x)[lane + 64 * i]; ss += v[i].x * v[i].x + v[i].y * v[i].y + v[i].z * v[i].z + v[i].w * v[i].w; }
        ss = wave_sum(ss);
        const float rs = rsqrtf(ss * (1.0f / 1024.0f) + 1e-6f);
#pragma unroll
        for (int i = 0; i < 4; ++i) { const int col = 4 * (lane + 64 * i);
            const float4 g = *(const float4*)(gamma + col), sc = *(const float4*)(mp + sc_off + col), sh = *(const float4*)(mp + sh_off + col);
            u32x2 w; w.x = cvt_pk_bf16(v[i].x * rs * g.x * (1.0f + sc.x) + sh.x, v[i].y * rs * g.y * (1.0f + sc.y) + sh.y);
            w.y = cvt_pk_bf16(v[i].z * rs * g.z * (1.0f + sc.z) + sh.z, v[i].w * rs * g.w * (1.0f + sc.w) + sh.w);
            *(u32x2*)(H + (size_t)row * DM + col) = w; }
    }
}
__device__ __forceinline__ void final_norm_phase(float* out, const float* gamma) {
    const int lane = threadIdx.x & 63, gw = blockIdx.x * 8 + (threadIdx.x >> 6), nw = gridDim.x * 8;
    for (int row = gw; row < NTOK; row += nw) {
        float* x = out + (size_t)row * DM; float4 v[4]; float ss = 0.f;
#pragma unroll
        for (int i = 0; i < 4; ++i) { v[i] = ((const float4*)x)[lane + 64 * i]; ss += v[i].x * v[i].x + v[i].y * v[i].y + v[i].z * v[i].z + v[i].w * v[i].w; }
        ss = wave_sum(ss);
        const float rs = rsqrtf(ss * (1.0f / 1024.0f) + 1e-6f);
#pragma unroll
        for (int i = 0; i < 4; ++i) { const float4 g = ((const float4*)gamma)[lane + 64 * i];
            ((float4*)x)[lane + 64 * i] = make_float4(v[i].x * rs * g.x, v[i].y * rs * g.y, v[i].z * rs * g.z, v[i].w * rs * g.w); }
    }
}

__device__ __forceinline__ void scan_phase(const Params& p, unsigned char* lds) {
    float* R = (float*)lds; float* W = R + 4096; float* Bv = W + 4096; float* KD = Bv + 4096; float* V = KD + 4096; float* KK = V + 4096;
    bf16_t* TW = (bf16_t*)(lds + 98304); bf16_t* TA = (bf16_t*)(lds + 107520); float* YC = (float*)(lds + 116736);
    const int tid = threadIdx.x, wid = tid >> 6, lane = tid & 63;
    unsigned char* ws = p.ws;
    const bf16_t* Z = (const bf16_t*)(ws + WS_Z); bf16_t* MIX = (bf16_t*)(ws + WS_H); bf16_t* Y1 = (bf16_t*)(ws + WS_Y1); float* BON = (float*)(ws + WS_BONUS);
    const float* mu = p.in[I_MU];
    for (int it = blockIdx.x; it < 1280; it += gridDim.x) {
        const bool lat = it < 256; const int q = lat ? it : it - 256;
        const int quarter = q & 3, dir = (q >> 2) & 1, h = (q >> 3) & 7, b = q >> 6;
        const int S = lat ? 4096 : 256, tb = lat ? NCTX + b * 4096 : b * 256;
        const int rl = (tid >> 4) & 15, ks = tid & 15, row = quarter * 16 + rl;
        float s0 = 0.f, s1 = 0.f, s2 = 0.f, s3 = 0.f;
        if (lat && tid < 256) { const float4 v = *(const float4*)((dir ? p.in[I_SB] : p.in[I_SF]) + ((size_t)(b * 8 + h) * 64 + row) * 64 + ks * 4); s0 = v.x; s1 = v.y; s2 = v.z; s3 = v.w; }
        for (int c = 0; c < (S >> 6); ++c) {
            for (int i = 0; i < 40; ++i) {
                const int e = tid + 512 * i, j = e & 63, pp = (e >> 6) & 63, sec = e >> 12;
                const int pos = c * 64 + pp, t = dir ? S - 1 - pos : pos;
                const int col = sec < 3 ? sec * 512 + h * 64 + j : (sec == 3 ? 1536 + dir * 64 + j : 1664 + dir * 64 + j);
                const float val = zshift(Z, tb, t, S, lat, col, mu[col]);
                if (sec == 0) R[pp * 64 + j] = val; else if (sec == 1) KD[pp * 64 + j] = val; else if (sec == 2) V[pp * 64 + j] = val;
                else if (sec == 3) TW[pp * 72 + j] = f2bf(tanhf(val)); else TA[pp * 72 + j] = f2bf(val);
            }
            __syncthreads();
            { const int mat = wid >> 2, mt = wid & 3; const bf16_t* TX = mat ? TA : TW;
              const bf16_t* WT = (const bf16_t*)(ws + (mat ? WS_A2T : WS_W2T)) + (size_t)dir * 512 * 64 + (size_t)h * 64 * 64;
              f32x4 acc[4];
#pragma unroll
              for (int nt = 0; nt < 4; ++nt) acc[nt] = (f32x4){0.f, 0.f, 0.f, 0.f};
#pragma unroll
              for (int k2 = 0; k2 < 2; ++k2) { const bf16x8 a = *(const bf16x8*)(TX + (16 * mt + (lane & 15)) * 72 + 32 * k2 + 8 * (lane >> 4));
#pragma unroll
                  for (int nt = 0; nt < 4; ++nt) { const bf16x8 bb = *(const bf16x8*)(WT + (16 * nt + (lane & 15)) * 64 + 32 * k2 + 8 * (lane >> 4));
                      acc[nt] = __builtin_amdgcn_mfma_f32_16x16x32_bf16(a, bb, acc[nt], 0, 0, 0); } }
#pragma unroll
              for (int nt = 0; nt < 4; ++nt) { const int j = 16 * nt + (lane & 15); const float bias = (mat ? p.in[I_A0] : p.in[I_W0])[dir * 512 + h * 64 + j];
#pragma unroll
                  for (int i = 0; i < 4; ++i) { const int pp = 16 * mt + 4 * (lane >> 4) + i; const float x = acc[nt][i] + bias;
                      if (mat == 0) W[pp * 64 + j] = __expf(-0.60653066f * sigm(x)); else Bv[pp * 64 + j] = sigm(x); } } }
            __syncthreads();
            { const int j = lane, hj = h * 64 + j; const float kkw = p.in[I_KK][hj], kaw = p.in[I_KA][hj], rkw = p.in[I_RK][hj];
#pragma unroll
              for (int i = 0; i < 8; ++i) { const int pp = 8 * wid + i; const float k = KD[pp * 64 + j], a = Bv[pp * 64 + j], r = R[pp * 64 + j];
                  const float kkr = k * kkw, n2 = wave_sum(kkr * kkr), kk = kkr / fmaxf(sqrtf(n2), 1e-12f);
                  const float kd = k * (1.0f + (a - 1.0f) * kaw), bon = wave_sum(r * kd * rkw);
                  KK[pp * 64 + j] = kk; KD[pp * 64 + j] = kd; Bv[pp * 64 + j] = kk * a;
                  if (quarter == 0 && lane == 0) { const int pos = c * 64 + pp, t = dir ? S - 1 - pos : pos; BON[(size_t)(tb + t) * 16 + dir * 8 + h] = bon; } } }
            __syncthreads();
            if (tid < 256) {
#pragma unroll 2
                for (int pp = 0; pp < 64; ++pp) {
                    const float4 kk = *(const float4*)(KK + pp * 64 + ks * 4), w = *(const float4*)(W + pp * 64 + ks * 4), bb = *(const float4*)(Bv + pp * 64 + ks * 4),
                                 kd = *(const float4*)(KD + pp * 64 + ks * 4), r = *(const float4*)(R + pp * 64 + ks * 4);
                    const float vv = V[pp * 64 + row];
                    float sa = s0 * kk.x + s1 * kk.y + s2 * kk.z + s3 * kk.w; sa = -red16(sa);
                    s0 = s0 * w.x + (sa * bb.x + vv * kd.x); s1 = s1 * w.y + (sa * bb.y + vv * kd.y); s2 = s2 * w.z + (sa * bb.z + vv * kd.z); s3 = s3 * w.w + (sa * bb.w + vv * kd.w);
                    float y = s0 * r.x + s1 * r.y + s2 * r.z + s3 * r.w; y = red16(y);
                    if (ks == 0) YC[pp * 16 + rl] = y;
                }
            }
            __syncthreads();
            for (int e = tid; e < 1024; e += 512) { const int pp = e >> 4, r_ = e & 15, pos = c * 64 + pp, t = dir ? S - 1 - pos : pos; const bf16_t yv = f2bf(YC[e]);
                if (dir == 0) MIX[(size_t)(tb + t) * DM + 512 + h * 64 + quarter * 16 + r_] = yv; else Y1[(size_t)(tb + t) * DRW + h * 64 + quarter * 16 + r_] = yv; }
        }
        if (!lat && tid < 256) *(float4*)(p.out + (size_t)NTOK * DM + (size_t)dir * 524288 + ((size_t)(b * 8 + h) * 64 + row) * 64 + ks * 4) = make_float4(s0, s1, s2, s3);
        __syncthreads();
    }
}

__device__ __forceinline__ void finalize_phase(const Params& p, unsigned char* lds) {
    bf16_t* GA = (bf16_t*)lds;
    const int tid = threadIdx.x, wid = tid >> 6, lane = tid & 63;
    unsigned char* ws = p.ws;
    const bf16_t* Z = (const bf16_t*)(ws + WS_Z); bf16_t* MIX = (bf16_t*)(ws + WS_H); const bf16_t* Y1 = (const bf16_t*)(ws + WS_Y1); const float* BON = (const float*)(ws + WS_BONUS);
    const bf16_t* G2T = (const bf16_t*)(ws + WS_G2T); const float* mu = p.in[I_MU];
    for (int tile = blockIdx.x; tile < 1280; tile += gridDim.x) {
        const int t0 = tile * 16; const bool lat = t0 >= NCTX;
        const int b = lat ? (t0 - NCTX) >> 12 : t0 >> 8, tb = lat ? NCTX + b * 4096 : b * 256, S = lat ? 4096 : 256, tl0 = t0 - tb;
        for (int e = tid; e < 2048; e += 512) { const int tt = e >> 7, j = e & 127, col = 1792 + j; GA[tt * 136 + j] = f2bf(sigm(zshift(Z, tb, tl0 + tt, S, lat, col, mu[col]))); }
        __syncthreads();
        f32x4 acc[4];
#pragma unroll
        for (int nt = 0; nt < 4; ++nt) acc[nt] = (f32x4){0.f, 0.f, 0.f, 0.f};
#pragma unroll
        for (int k4 = 0; k4 < 4; ++k4) { const bf16x8 a = *(const bf16x8*)(GA + (lane & 15) * 136 + 32 * k4 + 8 * (lane >> 4));
#pragma unroll
            for (int nt = 0; nt < 4; ++nt) { const bf16x8 bb = *(const bf16x8*)(G2T + (size_t)(64 * wid + 16 * nt + (lane & 15)) * 128 + 32 * k4 + 8 * (lane >> 4));
                acc[nt] = __builtin_amdgcn_mfma_f32_16x16x32_bf16(a, bb, acc[nt], 0, 0, 0); } }
#pragma unroll
        for (int i = 0; i < 4; ++i) {
            const int tl = tl0 + 4 * (lane >> 4) + i, tg = tb + tl; float ys[4]; float sm = 0.f;
#pragma unroll
            for (int nt = 0; nt < 4; ++nt) { const int c = 64 * wid + 16 * nt + (lane & 15); ys[nt] = bf2f(MIX[(size_t)tg * DM + 512 + c]) + bf2f(Y1[(size_t)tg * DRW + c]); sm += ys[nt]; }
            const float mean = red16(sm) * (1.0f / 64.0f); float sq = 0.f;
#pragma unroll
            for (int nt = 0; nt < 4; ++nt) { const float d = ys[nt] - mean; sq += d * d; }
            const float rstd = rsqrtf(red16(sq) * (1.0f / 64.0f) + 64e-5f);
            const float bon = BON[(size_t)tg * 16 + wid] + BON[(size_t)tg * 16 + 8 + wid];
#pragma unroll
            for (int nt = 0; nt < 4; ++nt) { const int c = 64 * wid + 16 * nt + (lane & 15);
                const float vs = zshift(Z, tb, tl, S, lat, 1024 + c, mu[1024 + c]);
                const float o = ((ys[nt] - mean) * rstd * p.in[I_LNW][c] + p.in[I_LNB][c] + bon * vs) * acc[nt][i];
                MIX[(size_t)tg * DM + 512 + c] = f2bf(o); }
        }
        __syncthreads();
    }
}

__global__ void __launch_bounds__(512, 2) fwd_megakernel(Params p) {
    extern __shared__ __attribute__((aligned(16))) unsigned char shm[];
    cg::grid_group grid = cg::this_grid();
    PG8_LAS unsigned char* lds3 = (PG8_LAS unsigned char*)shm;
    unsigned char* ws = p.ws; float* out = p.out; const float* mod = (const float*)(ws + WS_MOD);
    const char* H = (const char*)(ws + WS_H); const int G = gridDim.x, c = blockIdx.x;

    phase0(p, shm);
    grid.sync();
    norm_phase(p.in[I_XP], p.in[I_XS], p.in[I_NORMG], mod, 0, 1024, (bf16_t*)(ws + WS_H));
    grid.sync();
    { SchedPlain S{H, (const char*)(ws + WS_W1GU), 80, 22, DM, G, c}; EpiGU E{(bf16_t*)(ws + WS_ACT)}; pg8::gemm_phase(lds3, DM, S, E); }
    grid.sync();
    { SchedPlain S{(const char*)(ws + WS_ACT), (const char*)(ws + WS_W1D), 80, 4, DFF, G, c}; EpiRes E{p.in[I_XP], p.in[I_XS], out, mod, 2048, 0.5f}; pg8::gemm_phase(lds3, DFF, S, E); }
    grid.sync();
    norm_phase(out, out + (size_t)NCTX * DM, p.in[I_NORMG] + 1024, mod, 3072, 4096, (bf16_t*)(ws + WS_H));
    grid.sync();
    { SchedWin S{H, (const char*)(ws + WS_WZ), (const char*)(ws + WS_WF), G, c}; EpiWin E{(bf16_t*)(ws + WS_Z), (bf16_t*)(ws + WS_PT)}; pg8::gemm_phase(lds3, DM, S, E); }
    grid.sync();
    scan_phase(p, shm);
    __syncthreads();
    { SchedFourLat S{(const char*)(ws + WS_DLAT), (const char*)(ws + WS_PT) + (size_t)4194304 * 2, G, c}; EpiFour E{(bf16_t*)(ws + WS_H), 1.0f / 512.0f}; pg8::gemm_phase(lds3, 8192, S, E); }
    __syncthreads();
    { SchedFourCtx S{(const char*)(ws + WS_DCTX), (const char*)(ws + WS_PT), G, c}; EpiFour E{(bf16_t*)(ws + WS_H), 1.0f / 128.0f}; pg8::gemm_phase(lds3, 512, S, E); }
    grid.sync();
    finalize_phase(p, shm);
    grid.sync();
    ffn_conv(p.in[I_WG] + (size_t)DM * DFF, p.in[I_WU] + (size_t)DM * DFF, p.in[I_WD] + (size_t)DM * DFF, (bf16_t*)(ws + WS_W2GU), (bf16_t*)(ws + WS_W2D), (float*)shm);
    __syncthreads();
    { SchedPlain S{H, (const char*)(ws + WS_WOUT), 80, 4, DM, G, c}; EpiRes E{out, out + (size_t)NCTX * DM, out, mod, 5120, 1.0f}; pg8::gemm_phase(lds3, DM, S, E); }
    grid.sync();
    norm_phase(out, out + (size_t)NCTX * DM, p.in[I_NORMG] + 2048, mod, 6144, 7168, (bf16_t*)(ws + WS_H));
    grid.sync();
    { SchedPlain S{H, (const char*)(ws + WS_W2GU), 80, 22, DM, G, c}; EpiGU E{(bf16_t*)(ws + WS_ACT)}; pg8::gemm_phase(lds3, DM, S, E); }
    grid.sync();
    { SchedPlain S{(const char*)(ws + WS_ACT), (const char*)(ws + WS_W2D), 80, 4, DFF, G, c}; EpiRes E{out, out + (size_t)NCTX * DM, out, mod, 8192, 0.5f}; pg8::gemm_phase(lds3, DFF, S, E); }
    grid.sync();
    final_norm_phase(out, p.in[I_FN]);
}

extern "C" void kernel_launch(void* const* d_in, const int* in_sizes, int n_in, void* d_out, int out_size, void* d_ws, size_t ws_size, hipStream_t stream) {
    static int grid_blocks = 0;
    if (grid_blocks == 0) {
        if (n_in != 26 || ws_size < WS_END) { fprintf(stderr, "kernel_launch: unexpected n_in %d / ws_size %zu (need %zu)\n", n_in, ws_size, (size_t)WS_END); grid_blocks = -1; return; }
        int dev = 0, cus = 0, per_cu = 0;
        hipGetDevice(&dev);
        hipDeviceGetAttribute(&cus, hipDeviceAttributeMultiprocessorCount, dev);
        if (hipFuncSetAttribute((const void*)fwd_megakernel, hipFuncAttributeMaxDynamicSharedMemorySize, LDS_BYTES) != hipSuccess) { fprintf(stderr, "kernel_launch: hipFuncSetAttribute failed\n"); grid_blocks = -1; return; }
        if (hipOccupancyMaxActiveBlocksPerMultiprocessor(&per_cu, (const void*)fwd_megakernel, 512, LDS_BYTES) != hipSuccess || per_cu < 1) { fprintf(stderr, "kernel_launch: occupancy query failed (%d)\n", per_cu); grid_blocks = -1; return; }
        grid_blocks = cus * per_cu;
    }
    if (grid_blocks < 0) return;
    Params p{};
    for (int i = 0; i < 26; ++i) p.in[i] = (const float*)d_in[i];
    p.out = (float*)d_out; p.ws = (unsigned char*)d_ws;
    void* args[] = {&p};
    hipError_t e = hipLaunchCooperativeKernel((const void*)fwd_megakernel, dim3(grid_blocks), dim3(512), args, LDS_BYTES, stream);
    if (e != hipSuccess) fprintf(stderr, "cooperative launch failed: %s (grid %d)\n", hipGetErrorString(e), grid_blocks);
}
```

```cpp
#include <hip/hip_runtime.h>
#include <hip/hip_cooperative_groups.h>
#include <cstdio>
namespace cg = cooperative_groups;

namespace pg8 {
#define PG8_LAS __attribute__((address_space(3)))
typedef unsigned short bf16_t;
typedef short bf16x8 __attribute__((ext_vector_type(8)));
typedef float f32x4 __attribute__((ext_vector_type(4)));
typedef unsigned u32x4 __attribute__((ext_vector_type(4)));
typedef unsigned u32x2 __attribute__((ext_vector_type(2)));
constexpr int BM = 256, BK = 64, HALF = 128, HTB = HALF * BK * 2, STAGE_BYTES = 8 * HTB, NXCD = 8, WGM = 4;

__host__ __device__ __forceinline__ int lds_byte(int r, int c) { const int st = (r >> 4) * 2 + (c >> 5), rr = r & 15, cc = c & 31, ob = rr * 64 + cc * 2; return st * 1024 + (ob ^ (((ob >> 9) & 1) << 5)); }
__host__ __device__ __forceinline__ void stage_rc(int b, int& R, int& C) { const int st = b / 1024, sb = b % 1024, swz = sb ^ (((sb >> 9) & 1) << 5); R = (st >> 1) * 16 + swz / 64; C = (st & 1) * 32 + (swz % 64) / 2; }
__host__ __device__ __forceinline__ int perm32(int rho) { const int n = rho >> 4, i = rho & 15; return 8 * (i >> 2) + 4 * n + (i & 3); }

struct Unit { int pm, pn, kind, aux; const char* a; const char* b; };

__device__ __forceinline__ void tile_of(int wgid, int nM, int nN, int& pm, int& pn, const int wgm = WGM) {
    const int nwg = nM * nN;
    { const int q = nwg / NXCD, r = nwg % NXCD, xcd = wgid % NXCD, off = wgid / NXCD; wgid = (xcd < r ? xcd * (q + 1) : r * (q + 1) + (xcd - r) * q) + off; }
    const int nig = wgm * nN, gid = wgid / nig, fm = gid * wgm, gsz = (nM - fm) < wgm ? (nM - fm) : wgm;
    pm = fm + ((wgid % nig) % gsz); pn = (wgid % nig) / gsz;
}
typedef __bf16 bf16v2_t __attribute__((ext_vector_type(2)));
__device__ __forceinline__ unsigned cvt_pk_bf16(float lo, float hi) { const bf16v2_t v = {(__bf16)lo, (__bf16)hi}; return __builtin_bit_cast(unsigned, v); }

template <class Epi, class Sched>
__device__ __forceinline__ void gemm_phase(PG8_LAS unsigned char* lds, const int K, const Sched& S, const Epi& E, const int KL = 0) {
    int tid = threadIdx.x; asm volatile("" : "+v"(tid));
    const int wid = __builtin_amdgcn_readfirstlane(tid >> 6), lane = tid & 63, wr = wid >> 2, wc = wid & 3, fr = lane & 15, fq = lane >> 4;
    const int nt = (KL ? KL : K) / BK;
#define PG8_STAMP() do {} while (0)
    PG8_STAMP();
    unsigned voffA[2], voffB[2];
#pragma unroll
    for (int i = 0; i < 2; ++i) { int R, C; stage_rc(tid * 16 + i * 8192, R, C); const int Rb = Epi::PERM ? ((R & ~31) + perm32(R & 31)) : R;
        voffA[i] = (unsigned)(R * K + C) * 2u; voffB[i] = (unsigned)(Rb * K + C) * 2u; }
    const size_t kstep = (size_t)(BK * 2);
    const size_t hstep = (size_t)HALF * K * 2;
    const unsigned ldsw = (unsigned)wid * 1024u;
    const int aoff = lds_byte(wr * 64 + fr, fq * 8), boff = lds_byte(wc * 32 + fr, fq * 8);
#define PG8_SA(b, h) (((b) * 2 + (h)) * HTB)
#define PG8_SB(b, h) ((4 + (b) * 2 + (h)) * HTB)
#define PG8_STAGE(bufoff, gbase, voff) do { _Pragma("unroll") for (int _i = 0; _i < 2; ++_i) \
        __builtin_amdgcn_global_load_lds((const unsigned*)((const char*)(gbase) + (voff)[_i]), (PG8_LAS unsigned*)(lds + (bufoff) + ldsw + _i * 8192), 16, 0, 0); } while (0)
#define PG8_LDA(dst, b, h) do { _Pragma("unroll") for (int m = 0; m < 4; ++m) _Pragma("unroll") for (int k = 0; k < 2; ++k) dst[m][k] = *(const PG8_LAS bf16x8*)(lds + PG8_SA(b, h) + aoff + m * 2048 + k * 1024); } while (0)
#define PG8_LDB(dst, b, h) do { _Pragma("unroll") for (int n = 0; n < 2; ++n) _Pragma("unroll") for (int k = 0; k < 2; ++k) dst[n][k] = *(const PG8_LAS bf16x8*)(lds + PG8_SB(b, h) + boff + n * 2048 + k * 1024); } while (0)
#define PG8_MMA(ai, bj, At, Bt) do { __builtin_amdgcn_s_setprio(1); _Pragma("unroll") for (int m = 0; m < 4; ++m) _Pragma("unroll") for (int n = 0; n < 2; ++n) _Pragma("unroll") for (int k = 0; k < 2; ++k) \
        acc[ai][bj][m][n] = __builtin_amdgcn_mfma_f32_16x16x32_bf16(Bt[n][k], At[m][k], acc[ai][bj][m][n], 0, 0, 0); __builtin_amdgcn_s_setprio(0); } while (0)
#define PG8_WAIT_V(n) asm volatile("s_waitcnt vmcnt(" #n ")" ::: "memory")
#define PG8_WAIT_L(n) asm volatile("s_waitcnt lgkmcnt(" #n ")" ::: "memory")
#define PG8_BAR __builtin_amdgcn_s_barrier()
#define PG8_SCHED __builtin_amdgcn_sched_barrier(0)
    Unit cur, nxt; int ui = 0;
    if (!S.next(0, cur)) return;
    f32x4 acc[2][2][4][2];
#pragma unroll
    for (int a = 0; a < 2; ++a)
#pragma unroll
        for (int b = 0; b < 2; ++b)
#pragma unroll
            for (int m = 0; m < 4; ++m)
#pragma unroll
                for (int n = 0; n < 2; ++n) acc[a][b][m][n] = (f32x4){0.f, 0.f, 0.f, 0.f};
    bf16x8 At[4][2], B0[2][2], B1[2][2];
    const char* cA = cur.a; const char* cB = cur.b;
    PG8_STAGE(PG8_SB(0, 0), cB, voffB); PG8_STAGE(PG8_SA(0, 0), cA, voffA); PG8_STAGE(PG8_SB(0, 1), cB + hstep, voffB); PG8_STAGE(PG8_SA(0, 1), cA + hstep, voffA);
    if (wr == 1) PG8_BAR;
    PG8_WAIT_V(4); PG8_BAR;
    PG8_STAGE(PG8_SB(1, 0), cB + kstep, voffB); PG8_STAGE(PG8_SA(1, 0), cA + kstep, voffA); PG8_STAGE(PG8_SB(1, 1), cB + hstep + kstep, voffB);
    PG8_WAIT_V(6); PG8_BAR;
    PG8_STAMP();
    for (;;) {
        const bool has_next = S.next(ui + 1, nxt);
        const char* nA = has_next ? nxt.a : cA; const char* nB = has_next ? nxt.b : cB;
        for (int t = 0; t < nt; t += 2) {
            const bool last = (t == nt - 2);
            const char* a1 = cA + (size_t)(t + 1) * kstep;
            const char* a2 = last ? nA : cA + (size_t)(t + 2) * kstep; const char* b2 = last ? nB : cB + (size_t)(t + 2) * kstep;
            const char* a3 = a2 + kstep; const char* b3 = b2 + kstep;
            PG8_LDB(B0, 0, 0); PG8_SCHED; PG8_LDA(At, 0, 0); PG8_STAGE(PG8_SA(1, 1), a1 + hstep, voffA);
            PG8_WAIT_L(8); PG8_BAR; PG8_WAIT_L(0); PG8_MMA(0, 0, At, B0); PG8_BAR; PG8_SCHED;
            PG8_LDB(B1, 0, 1); PG8_STAGE(PG8_SB(0, 0), b2, voffB);
            PG8_BAR; PG8_WAIT_L(0); PG8_MMA(0, 1, At, B1); PG8_BAR;
            PG8_LDA(At, 0, 1); PG8_STAGE(PG8_SA(0, 0), a2, voffA);
            PG8_BAR; PG8_WAIT_L(0); PG8_MMA(1, 0, At, B0); PG8_BAR; PG8_SCHED;
            PG8_STAGE(PG8_SB(0, 1), b2 + hstep, voffB);
            PG8_WAIT_V(6); PG8_BAR; PG8_MMA(1, 1, At, B1); PG8_BAR;
            PG8_LDB(B0, 1, 0); PG8_SCHED; PG8_LDA(At, 1, 0); PG8_STAGE(PG8_SA(0, 1), a2 + hstep, voffA);
            PG8_WAIT_L(8); PG8_BAR; PG8_WAIT_L(0); PG8_MMA(0, 0, At, B0); PG8_BAR; PG8_SCHED;
            PG8_LDB(B1, 1, 1); PG8_STAGE(PG8_SB(1, 0), b3, voffB);
            PG8_BAR; PG8_WAIT_L(0); PG8_MMA(0, 1, At, B1); PG8_BAR;
            PG8_LDA(At, 1, 1); PG8_STAGE(PG8_SA(1, 0), a3, voffA);
            PG8_BAR; PG8_WAIT_L(0); PG8_MMA(1, 0, At, B0); PG8_BAR; PG8_SCHED;
            PG8_STAGE(PG8_SB(1, 1), b3 + hstep, voffB);
            PG8_WAIT_V(6); PG8_BAR; PG8_MMA(1, 1, At, B1); PG8_BAR;
        }
        PG8_STAMP();
        { int fr2 = lane & 15, fq2 = lane >> 4; asm volatile("" : "+v"(fr2), "+v"(fq2)); E(acc, cur, wr, wc, fr2, fq2); }
        PG8_STAMP();
        if (!has_next) break;
        if (nxt.kind != 3) {
#pragma unroll
        for (int a = 0; a < 2; ++a)
#pragma unroll
            for (int b = 0; b < 2; ++b)
#pragma unroll
                for (int m = 0; m < 4; ++m)
#pragma unroll
                    for (int n = 0; n < 2; ++n) acc[a][b][m][n] = (f32x4){0.f, 0.f, 0.f, 0.f};
        }
        cur = nxt; cA = nA; cB = nB; ++ui;
    }
    PG8_WAIT_V(0);
    if (wr == 0) PG8_BAR;
    PG8_BAR;
    PG8_STAMP();
#undef PG8_STAMP
#undef PG8_SA
#undef PG8_SB
#undef PG8_STAGE
#undef PG8_LDA
#undef PG8_LDB
#undef PG8_MMA
#undef PG8_WAIT_V
#undef PG8_WAIT_L
#undef PG8_BAR
#undef PG8_SCHED
}
}
#define XB_TMO      128
#define XB_XCNT(j)  (256  + 64 * (j))
#define XB_XSUB(j)  (1280 + 64 * (j))
#define XB_XGEN(j)  (2304 + 64 * (j))
#define XB_TOP      3328
#define XB_TOPGEN   3392
#define XCD_BAR_WORDS 3456
#define XB_SPIN_CAP (1u << 18)
#define LAS PG8_LAS

__device__ __forceinline__ unsigned xb_ld(unsigned* p)              { return __hip_atomic_load(p, __ATOMIC_RELAXED, __HIP_MEMORY_SCOPE_AGENT); }
__device__ __forceinline__ unsigned xb_add(unsigned* p, unsigned v) { return __hip_atomic_fetch_add(p, v, __ATOMIC_RELAXED, __HIP_MEMORY_SCOPE_AGENT); }
__device__ __forceinline__ unsigned xb_xcc_id() { return (unsigned)__builtin_amdgcn_s_getreg((3 << 11) | 20) & 0xFu; }
#define XB_SPIN(cond, bar) do { unsigned _sp = 0; while (cond) { __builtin_amdgcn_s_sleep(1); \
    if ((++_sp & 255u) == 0u) { if (xb_ld(&(bar)[XB_TMO])) break; if (_sp > XB_SPIN_CAP) { atomicAdd(&(bar)[XB_TMO], 1u); break; } } } } while (0)

struct XcdBarrier {
    unsigned* bar; unsigned x;
    volatile LAS unsigned* st;
};

__device__ __forceinline__ XcdBarrier xcd_barrier_post(unsigned* bar, volatile LAS unsigned* st) {
    XcdBarrier b; b.bar = bar; b.x = xb_xcc_id(); b.st = st;
    if (threadIdx.x == 0) (void)xb_add(&bar[XB_XCNT(b.x)], 1u);
    return b;
}
__device__ __forceinline__ void xcd_barrier_complete(unsigned* bar, unsigned x, unsigned& nloc, unsigned& nx) {
    const unsigned G = gridDim.x * gridDim.y * gridDim.z;
    unsigned sum, cnt, mine, sp = 0u;
    for (;;) {
        sum = 0u; cnt = 0u; mine = 0u;
#pragma unroll
        for (unsigned j = 0; j < 16; ++j) { const unsigned c = xb_ld(&bar[XB_XCNT(j)]); sum += c; cnt += (c > 0u) ? 1u : 0u; mine = (j == x) ? c : mine; }
        if (sum == G) break;
        __builtin_amdgcn_s_sleep(1);
        if ((++sp & 255u) == 0u) { if (xb_ld(&bar[XB_TMO])) break; if (sp > XB_SPIN_CAP) { atomicAdd(&bar[XB_TMO], 1u); break; } }
    }
    nloc = mine > 0u ? mine : 1u; nx = cnt > 0u ? cnt : 1u;
}

__device__ __forceinline__ void xcd_barrier(const XcdBarrier& b) {
    asm volatile("s_waitcnt vmcnt(0)" ::: "memory");
    __syncthreads();
    if (threadIdx.x == 0) {
        unsigned* bar = b.bar;
        __builtin_amdgcn_s_waitcnt(0);
        unsigned nloc = b.st[0], nx = b.st[1];
        if (nloc == 0u) { xcd_barrier_complete(bar, b.x, nloc, nx); b.st[0] = nloc; b.st[1] = nx; }
        const unsigned old = xb_add(&bar[XB_XSUB(b.x)], 1u);
        const unsigned gen = old / nloc;
        if (old + 1u == (gen + 1u) * nloc) {
            __builtin_amdgcn_fence(__ATOMIC_RELEASE, "agent");
            asm volatile("s_waitcnt vmcnt(0)" ::: "memory");
            const unsigned og = xb_add(&bar[XB_TOP], 1u);
            const unsigned tg = og / nx;
            if (og + 1u == (tg + 1u) * nx) xb_add(&bar[XB_TOPGEN], 1u);
            else XB_SPIN(xb_ld(&bar[XB_TOPGEN]) == tg, bar);
            __builtin_amdgcn_fence(__ATOMIC_ACQUIRE, "agent");
            xb_add(&bar[XB_XGEN(b.x)], 1u);
            asm volatile("s_waitcnt vmcnt(0)" ::: "memory");
        } else {
            XB_SPIN(xb_ld(&bar[XB_XGEN(b.x)]) == gen, bar);
            __builtin_amdgcn_fence(__ATOMIC_ACQUIRE, "agent");
            asm volatile("s_waitcnt vmcnt(0)" ::: "memory");
        }
    }
    __syncthreads();
}


using pg8::bf16_t; using pg8::bf16x8; using pg8::f32x4; using pg8::u32x4; using pg8::u32x2; using pg8::Unit; using pg8::cvt_pk_bf16;

constexpr int NTOK = 20480, NCTX = 4096, DM = 1024, DFF = 2816, DRW = 512, DZ = 1920, NMOD = 9216;
constexpr int LDS_BYTES = 157440 + 16;
constexpr size_t WS_MOD = 0, WS_BONUS = 262144, WS_W2T = 1572864, WS_A2T = 1703936, WS_G2T = 1835008, WS_DCTX = 1966080, WS_WOUT = 2228224,
    WS_EARLY = 4325376, WS_W1GU = WS_EARLY, WS_W1D = WS_W1GU + 11534336, WS_WZ = WS_W1D + 5767168, WS_WF = WS_WZ + 4194304, WS_Y1 = WS_EARLY,
    WS_H = 27918336, WS_BIG = 69861376, WS_Z = WS_BIG, WS_PT = WS_Z + 78643200, WS_DLAT = WS_PT + 41943040, WS_ACT = WS_BIG,
    WS_W2GU = WS_DLAT, WS_W2D = WS_W2GU + 11534336, WS_BAR = WS_DLAT + 67108864, WS_SEG = WS_BAR + 16384, WS_SSQ = WS_SEG + 6291456, WS_CBW = WS_SSQ + 1310720, WS_CBG = WS_CBW + 61440, WS_GP = WS_CBG + 112640, WS_END = WS_GP + 40960,
    WS_XG3 = WS_DLAT + 20971520;
static_assert(WS_WF + 2097152 <= WS_H && WS_ACT + (size_t)NTOK * DFF * 2 <= WS_DLAT && WS_END <= 268435456, "workspace map");

struct Params { const float* in[26]; float* out; unsigned char* ws; };
enum { I_XP = 0, I_XS, I_SF, I_SB, I_C, I_CCTX, I_WMOD, I_BMOD, I_NORMG, I_WG, I_WU, I_WD, I_WIN, I_MU, I_W0, I_W2, I_A0, I_A2, I_G2, I_KK, I_KA, I_RK, I_LNW, I_LNB, I_WOUT, I_FN };

__device__ __forceinline__ float bf2f(bf16_t v) { return __uint_as_float(((unsigned)v) << 16); }
__device__ __forceinline__ bf16_t f2bf(float f) { unsigned u = __float_as_uint(f); u += 0x7FFFu + ((u >> 16) & 1u); return (bf16_t)(u >> 16); }
__device__ __forceinline__ float sigm(float x) { return __builtin_amdgcn_rcpf(1.0f + __expf(-x)); }
__device__ __forceinline__ float wave_sum(float x) {
#pragma unroll
    for (int o = 32; o > 0; o >>= 1) x += __shfl_xor(x, o);
    return x;
}
template <int CTRL> __device__ __forceinline__ float dpp_mov(float x) { return __int_as_float(__builtin_amdgcn_update_dpp(0, __float_as_int(x), CTRL, 0xF, 0xF, true)); }
__device__ __forceinline__ float red16(float x) { x += dpp_mov<0xB1>(x); x += dpp_mov<0x4E>(x); x += dpp_mov<0x141>(x); x += dpp_mov<0x140>(x); return x; }

__device__ __forceinline__ float zshift(const bf16_t* __restrict__ Z, int tb, int t, int S, bool grid, int col, float mu) {
    const float z0 = bf2f(Z[(size_t)(tb + t) * DZ + col]);
    const int d = col & 3; int tn; bool ok;
    if (!grid) { if (d & 1) { tn = t + 1; ok = tn < S; } else { tn = t - 1; ok = tn >= 0; } }
    else { if (d == 0) { tn = t - 1; ok = (t & 63) != 0; } else if (d == 1) { tn = t + 1; ok = (t & 63) != 63; } else if (d == 2) { tn = t - 64; ok = t >= 64; } else { tn = t + 64; ok = t < S - 64; } }
    const float zn = ok ? bf2f(Z[(size_t)(tb + tn) * DZ + col]) : 0.0f;
    return z0 + mu * (zn - z0);
}

struct SchedPlain { const char* A; const char* B; int nM, nN, K, G, c; int wgm = pg8::WGM;
    __device__ __forceinline__ bool next(int i, Unit& u) const { const long L = (long)i * G + c; if (L >= (long)nM * nN) return false;
        pg8::tile_of((int)L, nM, nN, u.pm, u.pn, wgm); u.kind = 0; u.aux = 0; u.a = A + (size_t)u.pm * 512 * K; u.b = B + (size_t)u.pn * 512 * K; return true; } };
struct SchedSplitK { const char* A; const char* B; int nM, nN, K, KS, G, c;
    __device__ __forceinline__ bool next(int i, Unit& u) const { const long L = (long)i * G + c; if (L >= (long)nM * nN * KS) return false;
        const int kh = (int)(L % KS); pg8::tile_of((int)(L / KS), nM, nN, u.pm, u.pn); u.kind = 0; u.aux = kh;
        u.a = A + (size_t)u.pm * 512 * K + (size_t)kh * (K / KS) * 2; u.b = B + (size_t)u.pn * 512 * K + (size_t)kh * (K / KS) * 2; return true; } };
struct SchedWin { const char* H; const char* WZ; const char* WF; int G, c;
    __device__ __forceinline__ bool next(int i, Unit& u) const { const long L = (long)i * G + c; if (L >= 960) return false;
        if (L < 640) { pg8::tile_of((int)L, 80, 8, u.pm, u.pn); u.kind = 0; u.a = H + (size_t)u.pm * 524288; u.b = WZ + (size_t)u.pn * 524288; }
        else { pg8::tile_of((int)L - 640, 4, 80, u.pm, u.pn); u.kind = 1; u.a = WF + (size_t)u.pm * 524288; u.b = H + (size_t)u.pn * 524288; }
        u.aux = 0; return true; } };
struct SchedFourLat { const char* D; const char* PT; int G, c;
    __device__ __forceinline__ bool next(int i, Unit& u) const { const long L = (long)i * G + c; if (L >= 128) return false;
        const int b = (int)L >> 5, r = (int)L & 31; u.pm = r & 15; u.pn = r >> 4; u.kind = 0; u.aux = NCTX + b * 4096;
        u.a = D + (size_t)u.pm * 256 * 8192 * 2; u.b = PT + ((size_t)b * 512 + u.pn * 256) * 8192 * 2; return true; } };
struct SchedFourCtx { const char* D; const char* PT; int G, c;
    __device__ __forceinline__ bool next(int i, Unit& u) const { const long L = (long)i * G + c; if (L >= 32) return false;
        const int b = (int)L >> 1; u.pm = 0; u.pn = (int)L & 1; u.kind = 0; u.aux = b * 256;
        u.a = D; u.b = PT + ((size_t)b * 512 + u.pn * 256) * 512 * 2; return true; } };

struct EpiGU {
    static constexpr bool PERM = true; bf16_t* ACT;
    __device__ __forceinline__ void operator()(const f32x4 (&acc)[2][2][4][2], const Unit& u, int wr, int wc, int fr, int fq) const {
        const int row0 = u.pm * 256 + wr * 64 + fr, col0 = u.pn * 128 + wc * 32 + fq * 8;
#pragma unroll
        for (int ai = 0; ai < 2; ++ai)
#pragma unroll
            for (int m = 0; m < 4; ++m) {
                float o[8];
#pragma unroll
                for (int n = 0; n < 2; ++n)
#pragma unroll
                    for (int j = 0; j < 4; ++j) { const float g = acc[ai][0][m][n][j], uu = acc[ai][1][m][n][j]; o[n * 4 + j] = g * sigm(g) * uu; }
                u32x4 w; w.x = cvt_pk_bf16(o[0], o[1]); w.y = cvt_pk_bf16(o[2], o[3]); w.z = cvt_pk_bf16(o[4], o[5]); w.w = cvt_pk_bf16(o[6], o[7]);
                *(u32x4*)(ACT + (size_t)(row0 + ai * 128 + m * 16) * DFF + col0) = w;
            }
    }
};
struct EpiRes {
    static constexpr bool PERM = true; const float* xa; const float* xb; float* out; const float* mod; int goff; float scale;
    __device__ __forceinline__ void operator()(const f32x4 (&acc)[2][2][4][2], const Unit& u, int wr, int wc, int fr, int fq) const {
        const int mi = u.pm < 16 ? 0 : 1 + ((u.pm - 16) >> 4);
        const int row0 = u.pm * 256 + wr * 64 + fr, col0 = u.pn * 256 + wc * 32 + fq * 8;
        f32x4 gv[2][2];
#pragma unroll
        for (int bj = 0; bj < 2; ++bj)
#pragma unroll
            for (int n = 0; n < 2; ++n) gv[bj][n] = *(const f32x4*)(mod + mi * NMOD + goff + col0 + bj * 128 + n * 4) * scale;
        const bool lo = (u.pm * 256) < NCTX;
        const float* sbase = (lo ? xa + (size_t)row0 * DM : xb + (size_t)(row0 - NCTX) * DM) + col0;
        float* obase = out + (size_t)row0 * DM + col0;
        f32x4 xv[2][2], nx[2][2];
#pragma unroll
        for (int bj = 0; bj < 2; ++bj)
#pragma unroll
            for (int n = 0; n < 2; ++n) xv[bj][n] = *(const f32x4*)(sbase + bj * 128 + n * 4);
#pragma unroll
        for (int r = 0; r < 8; ++r) {
            const int ai = r >> 2, m = r & 3;
            if (r < 7) { const int r1 = r + 1; const float* sp = sbase + (size_t)((r1 >> 2) * 128 + (r1 & 3) * 16) * DM;
#pragma unroll
                for (int bj = 0; bj < 2; ++bj)
#pragma unroll
                    for (int n = 0; n < 2; ++n) nx[bj][n] = *(const f32x4*)(sp + bj * 128 + n * 4); }
            float* op = obase + (size_t)(ai * 128 + m * 16) * DM;
#pragma unroll
            for (int bj = 0; bj < 2; ++bj)
#pragma unroll
                for (int n = 0; n < 2; ++n) *(f32x4*)(op + bj * 128 + n * 4) = xv[bj][n] + gv[bj][n] * acc[ai][bj][m][n];
#pragma unroll
            for (int bj = 0; bj < 2; ++bj)
#pragma unroll
                for (int n = 0; n < 2; ++n) xv[bj][n] = nx[bj][n];
        }
    }
};
struct SchedFourSym { const char* D; const char* PT; int pair;
    __device__ __forceinline__ bool next(int i, Unit& u) const { if (pair >= 64 || i >= 2) return false;
        const int b = pair >> 4; u.pm = pair & 7; u.pn = (pair >> 3) & 1; u.kind = 2 + i; u.aux = NCTX + b * 4096;
        u.a = D + (size_t)u.pm * 256 * 8192 * 2 + (size_t)i * 8192; u.b = PT + ((size_t)b * 512 + u.pn * 256) * 8192 * 2 + (size_t)i * 8192; return true; } };
struct EpiFourSym {
    static constexpr bool PERM = true; bf16_t* MIX; float scale;
    __device__ __forceinline__ void operator()(const f32x4 (&acc)[2][2][4][2], const Unit& u, int wr, int wc, int fr, int fq) const {
        const int s0 = u.pm * 256 + wr * 64 + fr, col0 = u.pn * 256 + wc * 32 + fq * 8;
        if (u.kind == 2) {
#pragma unroll
            for (int ai = 0; ai < 2; ++ai)
#pragma unroll
                for (int m = 0; m < 4; ++m) { const int sp = s0 + ai * 128 + m * 16;
                    if (sp > 0) { bf16_t* mp = MIX + (size_t)(u.aux + 4096 - sp) * DM + col0;
#pragma unroll
                        for (int bj = 0; bj < 2; ++bj) { const f32x4 v0 = acc[ai][bj][m][0] * scale, v1 = acc[ai][bj][m][1] * scale;
                            u32x4 w; w.x = cvt_pk_bf16(v0[0], v0[1]); w.y = cvt_pk_bf16(v0[2], v0[3]); w.z = cvt_pk_bf16(v1[0], v1[1]); w.w = cvt_pk_bf16(v1[2], v1[3]);
                            *(u32x4*)(mp + bj * 128) = w; } } }
        } else {
            u32x4 yc[2][4][2];
#pragma unroll
            for (int ai = 0; ai < 2; ++ai)
#pragma unroll
                for (int m = 0; m < 4; ++m) { const int sp = s0 + ai * 128 + m * 16; const bf16_t* mp = MIX + (size_t)(u.aux + (sp > 0 ? 4096 - sp : 0)) * DM + col0;
#pragma unroll
                    for (int bj = 0; bj < 2; ++bj) yc[ai][m][bj] = *(const u32x4*)(mp + bj * 128); }
#pragma unroll
            for (int ai = 0; ai < 2; ++ai)
#pragma unroll
                for (int m = 0; m < 4; ++m) { const int sp = s0 + ai * 128 + m * 16; bf16_t* yp = MIX + (size_t)(u.aux + sp) * DM + col0; bf16_t* mp = MIX + (size_t)(u.aux + 4096 - sp) * DM + col0;
#pragma unroll
                    for (int bj = 0; bj < 2; ++bj) { const f32x4 v0 = acc[ai][bj][m][0] * scale, v1 = acc[ai][bj][m][1] * scale; const u32x4 c = yc[ai][m][bj];
                        u32x4 w; w.x = cvt_pk_bf16(v0[0], v0[1]); w.y = cvt_pk_bf16(v0[2], v0[3]); w.z = cvt_pk_bf16(v1[0], v1[1]); w.w = cvt_pk_bf16(v1[2], v1[3]);
                        *(u32x4*)(yp + bj * 128) = w;
                        if (sp > 0) { u32x4 x;
                            x.x = cvt_pk_bf16(2.0f * __uint_as_float(c.x << 16) - v0[0], 2.0f * __uint_as_float(c.x & 0xFFFF0000u) - v0[1]);
                            x.y = cvt_pk_bf16(2.0f * __uint_as_float(c.y << 16) - v0[2], 2.0f * __uint_as_float(c.y & 0xFFFF0000u) - v0[3]);
                            x.z = cvt_pk_bf16(2.0f * __uint_as_float(c.z << 16) - v1[0], 2.0f * __uint_as_float(c.z & 0xFFFF0000u) - v1[1]);
                            x.w = cvt_pk_bf16(2.0f * __uint_as_float(c.w << 16) - v1[2], 2.0f * __uint_as_float(c.w & 0xFFFF0000u) - v1[3]);
                            *(u32x4*)(mp + bj * 128) = x; } } }
        }
    }
};
__device__ __forceinline__ void fourier_nyquist(const bf16_t* PTlat, bf16_t* MIX, float scale) {
    const int lane = threadIdx.x & 63, gw = blockIdx.x * 8 + (threadIdx.x >> 6), nw = gridDim.x * 8;
    for (int r = gw; r < 2048; r += nw) { const int b = r >> 9, ch = r & 511; const bf16_t* row = PTlat + ((size_t)b * 512 + ch) * 8192;
        float sm = 0.f;
#pragma unroll
        for (int i = 0; i < 8; ++i) { const u32x4 v = *(const u32x4*)(row + (i * 64 + lane) * 8);
            sm += (__uint_as_float(v.x << 16) - __uint_as_float(v.x & 0xFFFF0000u)) + (__uint_as_float(v.y << 16) - __uint_as_float(v.y & 0xFFFF0000u))
                + (__uint_as_float(v.z << 16) - __uint_as_float(v.z & 0xFFFF0000u)) + (__uint_as_float(v.w << 16) - __uint_as_float(v.w & 0xFFFF0000u)); }
        sm = wave_sum(sm);
        if (lane == 0) MIX[(size_t)(NCTX + b * 4096 + 2048) * DM + ch] = f2bf(sm * scale); }
}
struct EpiResB16 {
    static constexpr bool PERM = true; const float* xa; const float* xb; bf16_t* X3; const float* mod; int goff; float scale;
    __device__ __forceinline__ void operator()(const f32x4 (&acc)[2][2][4][2], const Unit& u, int wr, int wc, int fr, int fq) const {
        const int mi = u.pm < 16 ? 0 : 1 + ((u.pm - 16) >> 4);
        const int row0 = u.pm * 256 + wr * 64 + fr, col0 = u.pn * 256 + wc * 32 + fq * 8;
        f32x4 gv[2][2];
#pragma unroll
        for (int bj = 0; bj < 2; ++bj)
#pragma unroll
            for (int n = 0; n < 2; ++n) gv[bj][n] = *(const f32x4*)(mod + mi * NMOD + goff + col0 + bj * 128 + n * 4) * scale;
        const bool lo = (u.pm * 256) < NCTX;
        const float* sbase = (lo ? xa + (size_t)row0 * DM : xb + (size_t)(row0 - NCTX) * DM) + col0;
        bf16_t* obase = X3 + (size_t)row0 * DM + col0;
        f32x4 xv[2][2], nx[2][2];
#pragma unroll
        for (int bj = 0; bj < 2; ++bj)
#pragma unroll
            for (int n = 0; n < 2; ++n) xv[bj][n] = *(const f32x4*)(sbase + bj * 128 + n * 4);
#pragma unroll
        for (int r = 0; r < 8; ++r) {
            const int ai = r >> 2, m = r & 3;
            if (r < 7) { const int r1 = r + 1; const float* sp = sbase + (size_t)((r1 >> 2) * 128 + (r1 & 3) * 16) * DM;
#pragma unroll
                for (int bj = 0; bj < 2; ++bj)
#pragma unroll
                    for (int n = 0; n < 2; ++n) nx[bj][n] = *(const f32x4*)(sp + bj * 128 + n * 4); }
            bf16_t* op = obase + (size_t)(ai * 128 + m * 16) * DM;
#pragma unroll
            for (int bj = 0; bj < 2; ++bj) { const f32x4 v0 = xv[bj][0] + gv[bj][0] * acc[ai][bj][m][0], v1 = xv[bj][1] + gv[bj][1] * acc[ai][bj][m][1];
                u32x4 w; w.x = cvt_pk_bf16(v0[0], v0[1]); w.y = cvt_pk_bf16(v0[2], v0[3]); w.z = cvt_pk_bf16(v1[0], v1[1]); w.w = cvt_pk_bf16(v1[2], v1[3]);
                *(u32x4*)(op + bj * 128) = w; }
#pragma unroll
            for (int bj = 0; bj < 2; ++bj)
#pragma unroll
                for (int n = 0; n < 2; ++n) xv[bj][n] = nx[bj][n];
        }
    }
};
struct EpiResAtomic {
    static constexpr bool PERM = true; float* out; const float* mod; int goff; float scale;
    __device__ __forceinline__ void operator()(const f32x4 (&acc)[2][2][4][2], const Unit& u, int wr, int wc, int fr, int fq) const {
        const int mi = u.pm < 16 ? 0 : 1 + ((u.pm - 16) >> 4);
        const int row0 = u.pm * 256 + wr * 64 + fr, col0 = u.pn * 256 + wc * 32 + fq * 8;
        f32x4 gv[2][2];
#pragma unroll
        for (int bj = 0; bj < 2; ++bj)
#pragma unroll
            for (int n = 0; n < 2; ++n) gv[bj][n] = *(const f32x4*)(mod + mi * NMOD + goff + col0 + bj * 128 + n * 4) * scale;
#pragma unroll
        for (int ai = 0; ai < 2; ++ai)
#pragma unroll
            for (int m = 0; m < 4; ++m) {
                float* op = out + (size_t)(row0 + ai * 128 + m * 16) * DM + col0;
#pragma unroll
                for (int bj = 0; bj < 2; ++bj)
#pragma unroll
                    for (int n = 0; n < 2; ++n) { const f32x4 v = gv[bj][n] * acc[ai][bj][m][n];
#pragma unroll
                        for (int j = 0; j < 4; ++j) unsafeAtomicAdd(op + bj * 128 + n * 4 + j, v[j]); }
            }
    }
};
__device__ __forceinline__ float row_rs(const float* SSQ, int row) {
    const f32x4 a = *(const f32x4*)(SSQ + (size_t)row * 16), b = *(const f32x4*)(SSQ + (size_t)row * 16 + 4), c = *(const f32x4*)(SSQ + (size_t)row * 16 + 8), d = *(const f32x4*)(SSQ + (size_t)row * 16 + 12);
    const f32x4 t = (a + b) + (c + d); return rsqrtf(((t[0] + t[1]) + (t[2] + t[3])) * (1.0f / 1024.0f) + 1e-6f);
}
struct EpiResN {
    static constexpr bool PERM = true; const float* xa; const float* xb; float* out; unsigned char* ws; int goff; float scale; int which;
    __device__ __forceinline__ void operator()(const f32x4 (&acc)[2][2][4][2], const Unit& u, int wr, int wc, int fr, int fq) const {
        const float* mod = (const float*)(ws + WS_MOD); const float* GP = (const float*)(ws + WS_GP) + which * 5120; bf16_t* XG = (bf16_t*)(ws + (which ? WS_XG3 : WS_H)); float* SSQ = (float*)(ws + WS_SSQ);
        const int mi = u.pm < 16 ? 0 : 1 + ((u.pm - 16) >> 4);
        const int row0 = u.pm * 256 + wr * 64 + fr, col0 = u.pn * 256 + wc * 32 + fq * 8;
        f32x4 gv[2][2], gp[2][2];
#pragma unroll
        for (int bj = 0; bj < 2; ++bj)
#pragma unroll
            for (int n = 0; n < 2; ++n) { gv[bj][n] = *(const f32x4*)(mod + mi * NMOD + goff + col0 + bj * 128 + n * 4) * scale; gp[bj][n] = *(const f32x4*)(GP + mi * 1024 + col0 + bj * 128 + n * 4); }
        const bool lo = (u.pm * 256) < NCTX;
        const float* sbase = (lo ? xa + (size_t)row0 * DM : xb + (size_t)(row0 - NCTX) * DM) + col0;
        float* obase = out + (size_t)row0 * DM + col0; bf16_t* xbase = XG + (size_t)row0 * DM + col0;
#pragma unroll
        for (int rp = 0; rp < 4; ++rp) {
            unsigned ro[2]; f32x4 xv[2][2][2];
#pragma unroll
            for (int h2 = 0; h2 < 2; ++h2) { const int r = rp * 2 + h2; ro[h2] = (unsigned)((r >> 2) * 128 + (r & 3) * 16) * DM; asm volatile("" : "+v"(ro[h2]));
#pragma unroll
                for (int bj = 0; bj < 2; ++bj)
#pragma unroll
                    for (int n = 0; n < 2; ++n) xv[h2][bj][n] = *(const f32x4*)(sbase + ro[h2] + bj * 128 + n * 4); }
#pragma unroll
            for (int h2 = 0; h2 < 2; ++h2) { const int r = rp * 2 + h2, ai = r >> 2, m = r & 3;
                float ss = 0.f;
#pragma unroll
                for (int bj = 0; bj < 2; ++bj) {
                    const f32x4 v0 = xv[h2][bj][0] + gv[bj][0] * acc[ai][bj][m][0], v1 = xv[h2][bj][1] + gv[bj][1] * acc[ai][bj][m][1];
                    *(f32x4*)(obase + ro[h2] + bj * 128) = v0; *(f32x4*)(obase + ro[h2] + bj * 128 + 4) = v1;
                    ss += (v0[0] * v0[0] + v0[1] * v0[1]) + (v0[2] * v0[2] + v0[3] * v0[3]) + (v1[0] * v1[0] + v1[1] * v1[1]) + (v1[2] * v1[2] + v1[3] * v1[3]);
                    const f32x4 y0 = v0 * gp[bj][0], y1 = v1 * gp[bj][1];
                    u32x4 w; w.x = cvt_pk_bf16(y0[0], y0[1]); w.y = cvt_pk_bf16(y0[2], y0[3]); w.z = cvt_pk_bf16(y1[0], y1[1]); w.w = cvt_pk_bf16(y1[2], y1[3]);
                    *(u32x4*)(xbase + ro[h2] + bj * 128) = w;
                }
                ss += __shfl_xor(ss, 16); ss += __shfl_xor(ss, 32);
                if (fq == 0) SSQ[(size_t)(row0 + ai * 128 + m * 16) * 16 + u.pn * 4 + wc] = ss; }
        }
    }
};
struct EpiGUN {
    static constexpr bool PERM = true; bf16_t* ACT; const float* SSQ; const float* CB;
    __device__ __forceinline__ void operator()(const f32x4 (&acc)[2][2][4][2], const Unit& u, int wr, int wc, int fr, int fq) const {
        const int mi = u.pm < 16 ? 0 : 1 + ((u.pm - 16) >> 4);
        const int row0 = u.pm * 256 + wr * 64 + fr, col0 = u.pn * 128 + wc * 32 + fq * 8;
        const float* cb = CB + mi * 5632 + u.pn * 256 + wc * 32 + fq * 8;
        const f32x4 cg0 = *(const f32x4*)cb, cg1 = *(const f32x4*)(cb + 4), cu0 = *(const f32x4*)(cb + 128), cu1 = *(const f32x4*)(cb + 132);
        const int laneL = fr + 16 * fq, rowW = u.pm * 256 + wr * 64;
        const float my0 = row_rs(SSQ, rowW + laneL), my1 = row_rs(SSQ, rowW + 128 + laneL);
        float rs[8];
#pragma unroll
        for (int m = 0; m < 4; ++m) { rs[m] = __shfl(my0, m * 16 + fr); rs[4 + m] = __shfl(my1, m * 16 + fr); }
#pragma unroll
        for (int ai = 0; ai < 2; ++ai)
#pragma unroll
            for (int m = 0; m < 4; ++m) {
                int row = row0 + ai * 128 + m * 16; asm volatile("" : "+v"(row)); const float rr = rs[ai * 4 + m];
                const f32x4 g0 = acc[ai][0][m][0] * rr + cg0, g1 = acc[ai][0][m][1] * rr + cg1, u0 = acc[ai][1][m][0] * rr + cu0, u1 = acc[ai][1][m][1] * rr + cu1;
                float o[8];
#pragma unroll
                for (int j = 0; j < 4; ++j) { o[j] = g0[j] * sigm(g0[j]) * u0[j]; o[4 + j] = g1[j] * sigm(g1[j]) * u1[j]; }
                u32x4 w; w.x = cvt_pk_bf16(o[0], o[1]); w.y = cvt_pk_bf16(o[2], o[3]); w.z = cvt_pk_bf16(o[4], o[5]); w.w = cvt_pk_bf16(o[6], o[7]);
                *(u32x4*)(ACT + (size_t)row * DFF + col0) = w;
            }
    }
};
struct EpiWinN {
    static constexpr bool PERM = true; bf16_t* Z; bf16_t* PT; const float* SSQ; const float* CB;
    __device__ __forceinline__ void operator()(const f32x4 (&acc)[2][2][4][2], const Unit& u, int wr, int wc, int fr, int fq) const {
        const int row0 = u.pm * 256 + wr * 64 + fr, cin = wc * 32 + fq * 8;
        if (u.kind == 0) {
            const int mi = u.pm < 16 ? 0 : 1 + ((u.pm - 16) >> 4);
            const float* cb = CB + mi * 3072 + u.pn * 256 + cin;
            f32x4 cv[2][2];
#pragma unroll
            for (int bj = 0; bj < 2; ++bj)
#pragma unroll
                for (int n = 0; n < 2; ++n) cv[bj][n] = *(const f32x4*)(cb + bj * 128 + n * 4);
            const int laneL = fr + 16 * fq, rowW = u.pm * 256 + wr * 64;
            const float my0 = row_rs(SSQ, rowW + laneL), my1 = row_rs(SSQ, rowW + 128 + laneL);
            float rs8[8];
#pragma unroll
            for (int m = 0; m < 4; ++m) { rs8[m] = __shfl(my0, m * 16 + fr); rs8[4 + m] = __shfl(my1, m * 16 + fr); }
#pragma unroll
            for (int ai = 0; ai < 2; ++ai)
#pragma unroll
                for (int m = 0; m < 4; ++m) {
                    const int row = row0 + ai * 128 + m * 16; const float rs = rs8[ai * 4 + m];
#pragma unroll
                    for (int bj = 0; bj < 2; ++bj) { const int col = u.pn * 256 + bj * 128 + cin;
                        const f32x4 v0 = acc[ai][bj][m][0] * rs + cv[bj][0], v1 = acc[ai][bj][m][1] * rs + cv[bj][1];
                        u32x4 w; w.x = cvt_pk_bf16(v0[0], v0[1]); w.y = cvt_pk_bf16(v0[2], v0[3]); w.z = cvt_pk_bf16(v1[0], v1[1]); w.w = cvt_pk_bf16(v1[2], v1[3]);
                        if (col < DZ) *(u32x4*)(Z + (size_t)row * DZ + col) = w; }
                }
        } else {
            const int mi = u.pn < 16 ? 0 : 1 + ((u.pn - 16) >> 4);
            const int lane_ = fr + 16 * fq;
            const float myrs = row_rs(SSQ, u.pn * 256 + (lane_ >> 5) * 128 + wc * 32 + (lane_ & 31));
            float rs[2][8];
#pragma unroll
            for (int bj = 0; bj < 2; ++bj)
#pragma unroll
                for (int e = 0; e < 8; ++e) rs[bj][e] = __shfl(myrs, bj * 32 + fq * 8 + e);
            float cb8[8];
#pragma unroll
            for (int r = 0; r < 8; ++r) cb8[r] = CB[mi * 3072 + 2048 + row0 + (r >> 2) * 128 + (r & 3) * 16];
#pragma unroll
            for (int ai = 0; ai < 2; ++ai)
#pragma unroll
                for (int m = 0; m < 4; ++m) {
                    const int row = row0 + ai * 128 + m * 16, part = row >> 9, ch = row & 511; const float cbv = cb8[ai * 4 + m];
#pragma unroll
                    for (int bj = 0; bj < 2; ++bj) {
                        const f32x4 a0 = acc[ai][bj][m][0], a1 = acc[ai][bj][m][1];
                        u32x4 w; w.x = cvt_pk_bf16(a0[0] * rs[bj][0] + cbv, a0[1] * rs[bj][1] + cbv); w.y = cvt_pk_bf16(a0[2] * rs[bj][2] + cbv, a0[3] * rs[bj][3] + cbv);
                        w.z = cvt_pk_bf16(a1[0] * rs[bj][4] + cbv, a1[1] * rs[bj][5] + cbv); w.w = cvt_pk_bf16(a1[2] * rs[bj][6] + cbv, a1[3] * rs[bj][7] + cbv);
                        const int ct = bj * 128 + cin; bf16_t* dst;
                        if (u.pn < 16) dst = PT + (((size_t)u.pn * 512 + ch) * 2 + part) * 256 + ct;
                        else { const int lt = u.pn - 16, bb = lt >> 4, s0 = (lt & 15) * 256; dst = PT + 4194304 + (((size_t)bb * 512 + ch) * 2 + part) * 4096 + s0 + ct; }
                        *(u32x4*)dst = w; }
                }
        }
    }
};
struct EpiWin {
    static constexpr bool PERM = true; bf16_t* Z; bf16_t* PT;
    __device__ __forceinline__ void operator()(const f32x4 (&acc)[2][2][4][2], const Unit& u, int wr, int wc, int fr, int fq) const {
        const int row0 = u.pm * 256 + wr * 64 + fr, cin = wc * 32 + fq * 8;
#pragma unroll
        for (int ai = 0; ai < 2; ++ai)
#pragma unroll
            for (int m = 0; m < 4; ++m) {
                const int row = row0 + ai * 128 + m * 16;
#pragma unroll
                for (int bj = 0; bj < 2; ++bj) {
                    const f32x4 v0 = acc[ai][bj][m][0], v1 = acc[ai][bj][m][1];
                    u32x4 w; w.x = cvt_pk_bf16(v0[0], v0[1]); w.y = cvt_pk_bf16(v0[2], v0[3]); w.z = cvt_pk_bf16(v1[0], v1[1]); w.w = cvt_pk_bf16(v1[2], v1[3]);
                    const int ct = bj * 128 + cin;
                    if (u.kind == 0) { const int col = u.pn * 256 + ct; if (col < DZ) *(u32x4*)(Z + (size_t)row * DZ + col) = w; }
                    else { const int part = row >> 9, ch = row & 511; bf16_t* dst;
                        if (u.pn < 16) dst = PT + (((size_t)u.pn * 512 + ch) * 2 + part) * 256 + ct;
                        else { const int lt = u.pn - 16, bb = lt >> 4, s0 = (lt & 15) * 256; dst = PT + 4194304 + (((size_t)bb * 512 + ch) * 2 + part) * 4096 + s0 + ct; }
                        *(u32x4*)dst = w; }
                }
            }
    }
};
struct EpiFour {
    static constexpr bool PERM = true; bf16_t* MIX; float scale;
    __device__ __forceinline__ void operator()(const f32x4 (&acc)[2][2][4][2], const Unit& u, int wr, int wc, int fr, int fq) const {
        const int row0 = u.aux + u.pm * 256 + wr * 64 + fr, col0 = u.pn * 256 + wc * 32 + fq * 8;
#pragma unroll
        for (int ai = 0; ai < 2; ++ai)
#pragma unroll
            for (int m = 0; m < 4; ++m)
#pragma unroll
                for (int bj = 0; bj < 2; ++bj) {
                    const f32x4 v0 = acc[ai][bj][m][0] * scale, v1 = acc[ai][bj][m][1] * scale;
                    u32x4 w; w.x = cvt_pk_bf16(v0[0], v0[1]); w.y = cvt_pk_bf16(v0[2], v0[3]); w.z = cvt_pk_bf16(v1[0], v1[1]); w.w = cvt_pk_bf16(v1[2], v1[3]);
                    *(u32x4*)(MIX + (size_t)(row0 + ai * 128 + m * 16) * DM + col0 + bj * 128) = w;
                }
    }
};

__device__ __forceinline__ void tconv_load(const float* __restrict__ src, int ld, int k0, int n0, float* tile) {
    const int tid = threadIdx.x;
#pragma unroll
    for (int r = 0; r < 2; ++r) { const int idx = tid + 512 * r, i = idx >> 4, j4 = idx & 15; const float4 v = *(const float4*)(src + (size_t)(k0 + i) * ld + n0 + 4 * j4);
        float* t = tile + i * 65 + 4 * j4; t[0] = v.x; t[1] = v.y; t[2] = v.z; t[3] = v.w; }
}
__device__ __forceinline__ void tconv_tile(const float* __restrict__ src, int ld, int k0, int n0, bf16_t* __restrict__ dst, int ldd, int drow0, float* tile) {
    const int tid = threadIdx.x;
    tconv_load(src, ld, k0, n0, tile);
    __syncthreads();
    { const int j = tid >> 3, ic = tid & 7; const float* t = tile + (ic * 8) * 65 + j; u32x4 w;
      w.x = cvt_pk_bf16(t[0], t[65]); w.y = cvt_pk_bf16(t[130], t[195]); w.z = cvt_pk_bf16(t[260], t[325]); w.w = cvt_pk_bf16(t[390], t[455]);
      *(u32x4*)(dst + (size_t)(drow0 + j) * ldd + k0 + ic * 8) = w; }
    __syncthreads();
}
__device__ __forceinline__ void ffn_conv(const float* wg, const float* wu, const float* wd, bf16_t* WGU, bf16_t* WD, float* tile, int bid, int nb) {
    for (int t = bid; t < 2112; t += nb) {
        int u = t;
        if (u < 1408) { const bool up = u >= 704; if (up) u -= 704; const int k0 = (u / 44) * 64, n0 = (u % 44) * 64;
            tconv_tile(up ? wu : wg, DFF, k0, n0, WGU, DM, (n0 >> 7) * 256 + (n0 & 127) + (up ? 128 : 0), tile); }
        else { u -= 1408; const int k0 = (u >> 4) * 64, n0 = (u & 15) * 64; tconv_tile(wd, DM, k0, n0, WD, DFF, n0, tile); }
    }
}

__device__ __forceinline__ void phase0(const Params& p, unsigned char* lds) {
    float* tile = (float*)lds; float* cos64 = (float*)(lds + 16640); float* T = (float*)(lds + 16896); float* sil = (float*)(lds + 33280); float* red = (float*)(lds + 53760);
    const int tid = threadIdx.x, bid = blockIdx.x, nb = gridDim.x;
    unsigned char* ws = p.ws;
    for (int i = tid; i < 4096; i += 512) T[i] = cospif((float)i * (1.0f / 2048.0f));
    if (tid < 64) cos64[tid] = cospif((float)tid * (1.0f / 32.0f));
    for (int i = tid; i < 5120; i += 512) { const int r = i >> 10, k = i & 1023; const float c = r == 0 ? p.in[I_CCTX][k] : p.in[I_C][(r - 1) * 1024 + k]; sil[i] = c * sigm(c); }
    __syncthreads();
    for (int it = bid; it < 288; it += nb) {
        const int jj = tid & 31, kg = tid >> 5, j = it * 32 + jj; const float* wp = p.in[I_WMOD] + (size_t)(kg * 64) * NMOD + j; const float* sp = sil + kg * 64;
        float a0 = 0.f, a1 = 0.f, a2 = 0.f, a3 = 0.f, a4 = 0.f;
#pragma unroll 8
        for (int k = 0; k < 64; ++k) { const float w = wp[(size_t)k * NMOD]; a0 += sp[k] * w; a1 += sp[1024 + k] * w; a2 += sp[2048 + k] * w; a3 += sp[3072 + k] * w; a4 += sp[4096 + k] * w; }
        float* rp = red + kg * 160 + jj; rp[0] = a0; rp[32] = a1; rp[64] = a2; rp[96] = a3; rp[128] = a4;
        __syncthreads();
        if (tid < 160) { float s = 0.f;
#pragma unroll
            for (int g = 0; g < 16; ++g) s += red[g * 160 + tid];
            const int i = tid >> 5; ((float*)(ws + WS_MOD))[i * NMOD + it * 32 + (tid & 31)] = s + p.in[I_BMOD][it * 32 + (tid & 31)]; }
        __syncthreads();
    }
}
__device__ __forceinline__ void phase0b(const Params& p, unsigned char* lds, const int bid, const int nb) {
    float* tile = (float*)lds; float* cos64 = (float*)(lds + 16640); float* T = (float*)(lds + 16896);
    const int tid = threadIdx.x;
    unsigned char* ws = p.ws;
    __syncthreads();
    for (int i = tid; i < 4096; i += 512) T[i] = cospif((float)i * (1.0f / 2048.0f));
    if (tid < 64) cos64[tid] = cospif((float)tid * (1.0f / 32.0f));
    __syncthreads();
    for (int t = bid; t < 784; t += nb) {
        int u = t;
        if (u < 480) { const int k0 = (u / 30) * 64, n0 = (u % 30) * 64; tconv_tile(p.in[I_WIN] + 512, 2432, k0, n0, (bf16_t*)(ws + WS_WZ), DM, n0, tile); }
        else if ((u -= 480) < 256) { const int k0 = (u >> 4) * 64, n0 = (u & 15) * 64; tconv_tile(p.in[I_WOUT], DM, k0, n0, (bf16_t*)(ws + WS_WOUT), DM, n0, tile); }
        else if ((u -= 256) < 16) { const int d = u >> 3, n0 = (u & 7) * 64; tconv_tile(p.in[I_W2] + d * 64 * 512, 512, 0, n0, (bf16_t*)(ws + WS_W2T) + d * 512 * 64, 64, n0, tile); }
        else if ((u -= 16) < 16) { const int d = u >> 3, n0 = (u & 7) * 64; tconv_tile(p.in[I_A2] + d * 64 * 512, 512, 0, n0, (bf16_t*)(ws + WS_A2T) + d * 512 * 64, 64, n0, tile); }
        else { u -= 16; const int k0 = (u >> 3) * 64, n0 = (u & 7) * 64; tconv_tile(p.in[I_G2], 512, k0, n0, (bf16_t*)(ws + WS_G2T), 128, n0, tile); }
    }
    for (int t = bid; t < 128; t += nb) {
        const int kt = t >> 3, g = t & 7;
        tconv_load(p.in[I_WIN], 2432, kt * 64, g * 64, tile);
        __syncthreads();
        { const int j = tid >> 3, ic = tid & 7; float ac[8], as[8];
#pragma unroll
          for (int e = 0; e < 8; ++e) { ac[e] = 0.f; as[e] = 0.f; }
          for (int c = 0; c < 64; ++c) { const float cs = cos64[(c * j) & 63], sn = cos64[(c * j - 16) & 63];
#pragma unroll
              for (int e = 0; e < 8; ++e) { const float w = tile[(ic * 8 + e) * 65 + c]; ac[e] += w * cs; as[e] += w * sn; } }
          u32x4 w; bf16_t* WF = (bf16_t*)(ws + WS_WF);
          w.x = cvt_pk_bf16(ac[0], ac[1]); w.y = cvt_pk_bf16(ac[2], ac[3]); w.z = cvt_pk_bf16(ac[4], ac[5]); w.w = cvt_pk_bf16(ac[6], ac[7]);
          *(u32x4*)(WF + (size_t)(g * 64 + j) * DM + kt * 64 + ic * 8) = w;
          w.x = cvt_pk_bf16(as[0], as[1]); w.y = cvt_pk_bf16(as[2], as[3]); w.z = cvt_pk_bf16(as[4], as[5]); w.w = cvt_pk_bf16(as[6], as[7]);
          *(u32x4*)(WF + (size_t)(512 + g * 64 + j) * DM + kt * 64 + ic * 8) = w; }
        __syncthreads();
    }
    { float* v2 = (float*)(lds + 33280); float* v3 = (float*)(lds + 53760); float* red = (float*)(lds + 74240); float* tb5 = (float*)(lds + 84480);
      const float* mod = (const float*)(ws + WS_MOD); float* CBW = (float*)(ws + WS_CBW); float* CBG = (float*)(ws + WS_CBG);
      for (int i = tid; i < 5120; i += 512) { const int r = i >> 10, k = i & 1023; v2[i] = mod[r * NMOD + 3072 + k]; v3[i] = mod[r * NMOD + 6144 + k]; }
      __syncthreads();
      for (int it = bid; it < 252; it += nb) {
          const bool isu = it >= 60 && it < 76; if (isu && (it & 1)) continue;
          for (int half = 0; half < (isu ? 2 : 1); ++half) {
              const float* W; int ld, colw; const float* vp;
              if (it < 60) { W = p.in[I_WIN]; ld = 2432; colw = 512 + it * 32; vp = v2; }
              else if (isu) { W = p.in[I_WIN]; ld = 2432; colw = (it - 60 + half) * 32; vp = v2; }
              else { const int u = it - 76; W = (u < 88 ? p.in[I_WG] : p.in[I_WU]) + (size_t)DM * DFF; ld = DFF; colw = (u % 88) * 32; vp = v3; }
              const int jj = tid & 31, kg = tid >> 5; const float* wp = W + (size_t)(kg * 64) * ld + colw + jj; const float* sp = vp + kg * 64;
              float a0 = 0.f, a1 = 0.f, a2 = 0.f, a3 = 0.f, a4 = 0.f;
#pragma unroll 4
              for (int k = 0; k < 64; ++k) { const float w = wp[(size_t)k * ld]; a0 += sp[k] * w; a1 += sp[1024 + k] * w; a2 += sp[2048 + k] * w; a3 += sp[3072 + k] * w; a4 += sp[4096 + k] * w; }
              float* rp = red + kg * 160 + jj; rp[0] = a0; rp[32] = a1; rp[64] = a2; rp[96] = a3; rp[128] = a4;
              __syncthreads();
              if (tid < 160) { float sm = 0.f;
#pragma unroll
                  for (int g = 0; g < 16; ++g) sm += red[g * 160 + tid];
                  const int i = tid >> 5, j5 = tid & 31;
                  if (it < 60) CBW[i * 3072 + it * 32 + j5] = sm;
                  else if (isu) tb5[i * 64 + half * 32 + j5] = sm;
                  else { const int u = it - 76, cgu = (u % 88) * 32 + j5; CBG[i * 5632 + (cgu >> 7) * 256 + (u < 88 ? 0 : 128) + (cgu & 127)] = sm; } }
              __syncthreads();
          }
          if (isu) { const int g = (it - 60) >> 1;
              for (int e = tid; e < 640; e += 512) { const int i = e >> 7, part = (e >> 6) & 1, cp = e & 63; float sm = 0.f;
                  for (int c = 0; c < 64; ++c) sm += tb5[i * 64 + c] * cos64[(c * cp - (part ? 16 : 0)) & 63];
                  CBW[i * 3072 + 2048 + part * 512 + g * 64 + cp] = sm; }
              __syncthreads(); }
      }
      for (int e = bid * 512 + tid; e < 640; e += nb * 512) CBW[(e >> 7) * 3072 + 1920 + (e & 127)] = 0.f; }
    const size_t gt = (size_t)bid * 512 + tid, ngt = (size_t)nb * 512;
    for (size_t i = gt; i < 16384; i += ngt) ((u32x4*)(ws + WS_WZ + (size_t)1920 * DM * 2))[i] = (u32x4){0u, 0u, 0u, 0u};
    for (size_t i = gt; i < (size_t)(gridDim.x == 256 ? 2048 : 4096) * 1024; i += ngt) {
        const int sp = (int)(i >> 10), k0 = ((int)i & 1023) * 8, part = k0 >> 12, kk0 = k0 & 4095; float v[8];
#pragma unroll
        for (int e = 0; e < 8; ++e) { const int j = (sp * (kk0 + e)) & 4095; v[e] = part ? -T[(j - 1024) & 4095] : T[j]; }
        u32x4 w; w.x = cvt_pk_bf16(v[0], v[1]); w.y = cvt_pk_bf16(v[2], v[3]); w.z = cvt_pk_bf16(v[4], v[5]); w.w = cvt_pk_bf16(v[6], v[7]);
        ((u32x4*)(ws + WS_DLAT))[i] = w;
    }
    for (size_t i = gt; i < (size_t)256 * 64; i += ngt) {
        const int sp = (int)(i >> 6), k0 = ((int)i & 63) * 8, part = k0 >> 8, kk0 = k0 & 255; float v[8];
#pragma unroll
        for (int e = 0; e < 8; ++e) { const int j = ((sp * (kk0 + e)) & 255) * 16; v[e] = part ? -T[(j - 1024) & 4095] : T[j]; }
        u32x4 w; w.x = cvt_pk_bf16(v[0], v[1]); w.y = cvt_pk_bf16(v[2], v[3]); w.z = cvt_pk_bf16(v[4], v[5]); w.w = cvt_pk_bf16(v[6], v[7]);
        ((u32x4*)(ws + WS_DCTX))[i] = w;
    }
}

__device__ __forceinline__ void norm_phase(const float* xa, const float* xb, const float* gamma, const float* mod, int sh_off, int sc_off, bf16_t* H, float* xcopy = nullptr) {
    const int lane = threadIdx.x & 63, gw = blockIdx.x * 8 + (threadIdx.x >> 6), nw = gridDim.x * 8;
    for (int row0 = gw * 4; row0 < NTOK; row0 += nw * 4) {
        float4 v[4][4]; float ss[4];
#pragma unroll
        for (int r = 0; r < 4; ++r) { const int row = row0 + r; const float* x = row < NCTX ? xa + (size_t)row * DM : xb + (size_t)(row - NCTX) * DM;
#pragma unroll
            for (int i = 0; i < 4; ++i) v[r][i] = ((const float4*)x)[lane + 64 * i]; }
#pragma unroll
        for (int r = 0; r < 4; ++r) { float s_ = 0.f;
#pragma unroll
            for (int i = 0; i < 4; ++i) s_ += v[r][i].x * v[r][i].x + v[r][i].y * v[r][i].y + v[r][i].z * v[r][i].z + v[r][i].w * v[r][i].w;
            ss[r] = wave_sum(s_); }
        const float* mp = mod + (row0 < NCTX ? 0 : 1 + ((row0 - NCTX) >> 12)) * NMOD;
#pragma unroll
        for (int i = 0; i < 4; ++i) { const int col = 4 * (lane + 64 * i);
            const float4 g = *(const float4*)(gamma + col), sc = *(const float4*)(mp + sc_off + col), sh = *(const float4*)(mp + sh_off + col);
#pragma unroll
            for (int r = 0; r < 4; ++r) { const float rs = rsqrtf(ss[r] * (1.0f / 1024.0f) + 1e-6f); const float4 x = v[r][i];
                u32x2 w; w.x = cvt_pk_bf16(x.x * rs * g.x * (1.0f + sc.x) + sh.x, x.y * rs * g.y * (1.0f + sc.y) + sh.y);
                w.y = cvt_pk_bf16(x.z * rs * g.z * (1.0f + sc.z) + sh.z, x.w * rs * g.w * (1.0f + sc.w) + sh.w);
                *(u32x2*)(H + (size_t)(row0 + r) * DM + col) = w; } }
    }
}
__device__ __forceinline__ void final_norm_phase(float* out, const float* gamma, const bf16_t* X3) {
    const int lane = threadIdx.x & 63, gw = blockIdx.x * 8 + (threadIdx.x >> 6), nw = gridDim.x * 8;
    for (int row0 = gw * 4; row0 < NTOK; row0 += nw * 4) {
        float4 v[4][4]; float ss[4];
#pragma unroll
        for (int r = 0; r < 4; ++r)
#pragma unroll
            for (int i = 0; i < 4; ++i) { const u32x2 pw = ((const u32x2*)(X3 + (size_t)(row0 + r) * DM))[lane + 64 * i];
                v[r][i] = make_float4(__uint_as_float(pw.x << 16), __uint_as_float(pw.x & 0xFFFF0000u), __uint_as_float(pw.y << 16), __uint_as_float(pw.y & 0xFFFF0000u)); }
#pragma unroll
        for (int r = 0; r < 4; ++r) { float s_ = 0.f;
#pragma unroll
            for (int i = 0; i < 4; ++i) s_ += v[r][i].x * v[r][i].x + v[r][i].y * v[r][i].y + v[r][i].z * v[r][i].z + v[r][i].w * v[r][i].w;
            ss[r] = wave_sum(s_); }
#pragma unroll
        for (int i = 0; i < 4; ++i) { const float4 g = ((const float4*)gamma)[lane + 64 * i];
#pragma unroll
            for (int r = 0; r < 4; ++r) { const float rs = rsqrtf(ss[r] * (1.0f / 1024.0f) + 1e-6f); const float4 x = v[r][i];
                ((float4*)(out + (size_t)(row0 + r) * DM))[lane + 64 * i] = make_float4(x.x * rs * g.x, x.y * rs * g.y, x.z * rs * g.z, x.w * rs * g.w); } }
    }
}

typedef float f32x2 __attribute__((ext_vector_type(2)));
constexpr int SC_CH = 32, SC_BUF = 43008, SC_TW = 86016, SC_YC = 104448, SC_CONST = 120832;

struct ScanLoads { u32x4 z0[5]; unsigned nb[5][4][2]; };

__device__ __forceinline__ void scan_issue(ScanLoads& L, const bf16_t* __restrict__ Z, int tb, int S, bool lat, int dir, int h, int c, int pw, int lane) {
    const int pos = c * SC_CH + 8 * pw + (lane >> 3), t = dir ? S - 1 - pos : pos, cg = lane & 7;
    int tn[4]; bool ok[4];
    tn[0] = t - 1; tn[1] = t + 1;
    if (lat) { ok[0] = (t & 63) != 0; ok[1] = (t & 63) != 63; tn[2] = t - 64; ok[2] = t >= 64; tn[3] = t + 64; ok[3] = t < S - 64; }
    else { ok[0] = t > 0; ok[1] = t < S - 1; tn[2] = tn[0]; ok[2] = ok[0]; tn[3] = tn[1]; ok[3] = ok[1]; }
    const bf16_t* zr = Z + (size_t)(tb + t) * DZ + cg * 8;
#pragma unroll
    for (int d = 0; d < 4; ++d) tn[d] = ok[d] ? (tn[d] - t) * DZ : 0;
#pragma unroll
    for (int sec = 0; sec < 5; ++sec) {
        const int col0 = sec < 3 ? sec * 512 + h * 64 : (sec == 3 ? 1536 + dir * 64 : 1664 + dir * 64);
        L.z0[sec] = *(const u32x4*)(zr + col0);
#pragma unroll
        for (int d = 0; d < 4; ++d) { const unsigned* np = (const unsigned*)(zr + col0 + tn[d]) + (d >> 1); const unsigned a = np[0], b = np[2]; L.nb[sec][d][0] = ok[d] ? a : 0u; L.nb[sec][d][1] = ok[d] ? b : 0u; }
    }
}
__device__ __forceinline__ float bfsel(const u32x4& v, int e) { const unsigned w = v[e >> 1]; return __uint_as_float((e & 1) ? (w & 0xFFFF0000u) : (w << 16)); }
__device__ __forceinline__ float bfhalf(unsigned w, int hi) { return __uint_as_float(hi ? (w & 0xFFFF0000u) : (w << 16)); }
template <int CTRL> __device__ __forceinline__ float dpp_add(float x) { return x + dpp_mov<CTRL>(x); }
__device__ __forceinline__ float red8(float x) { x = dpp_add<0xB1>(x); x = dpp_add<0x4E>(x); x = dpp_add<0x141>(x); return x; }

__device__ __forceinline__ void scan_prepA(const ScanLoads& L, unsigned char* lds, int buf, int quarter, int pw, int lane, float (&rv)[8], float (&kv)[8]) {
    float* R = (float*)(lds + buf * SC_BUF); float* W = R + 2048; float* BB = W + 2048; float* KD = BB + 2048; float* KK = KD + 2048; float* V = KK + 2048;
    bf16_t* TW = (bf16_t*)(lds + SC_TW + pw * 4608); bf16_t* TA = TW + 1152;
    const int p8 = lane >> 3, cg = lane & 7, pp = 8 * pw + p8;
    const float* CM = (const float*)(lds + SC_CONST); const bf16_t* CWT = (const bf16_t*)(lds + SC_CONST + 2560);
#pragma unroll
    for (int sec = 0; sec < 5; ++sec) {
        const float4 m0 = *(const float4*)(CM + sec * 64 + cg * 8), m1 = *(const float4*)(CM + sec * 64 + cg * 8 + 4);
        const float mu[8] = {m0.x, m0.y, m0.z, m0.w, m1.x, m1.y, m1.z, m1.w};
        float val[8];
#pragma unroll
        for (int e = 0; e < 8; ++e) { const float z0 = bfsel(L.z0[sec], e), zn = bfhalf(L.nb[sec][e & 3][e >> 2], e & 1); val[e] = z0 + mu[e] * (zn - z0); }
        if (sec == 0) {
#pragma unroll
            for (int e = 0; e < 8; ++e) rv[e] = val[e];
            *(float4*)(R + pp * 64 + cg * 8) = make_float4(val[0], val[1], val[2], val[3]); *(float4*)(R + pp * 64 + cg * 8 + 4) = make_float4(val[4], val[5], val[6], val[7]);
        } else if (sec == 1) {
#pragma unroll
            for (int e = 0; e < 8; ++e) kv[e] = val[e];
        } else if (sec == 2) {
            if ((cg >> 1) == quarter) { *(float4*)(V + pp * 16 + (cg & 1) * 8) = make_float4(val[0], val[1], val[2], val[3]); *(float4*)(V + pp * 16 + (cg & 1) * 8 + 4) = make_float4(val[4], val[5], val[6], val[7]); }
        } else {
            if (sec == 3) {
#pragma unroll
                for (int e = 0; e < 8; ++e) val[e] = 1.0f - 2.0f * __builtin_amdgcn_rcpf(1.0f + __expf(2.0f * val[e]));
            }
            u32x4 w; w.x = cvt_pk_bf16(val[0], val[1]); w.y = cvt_pk_bf16(val[2], val[3]); w.z = cvt_pk_bf16(val[4], val[5]); w.w = cvt_pk_bf16(val[6], val[7]);
            if (sec == 3) { *(u32x4*)(TW + p8 * 136 + cg * 8) = w; *(u32x4*)(TW + p8 * 136 + 64 + cg * 8) = (u32x4){0u, 0u, 0u, 0u}; }
            else { *(u32x4*)(TW + (p8 + 8) * 136 + 64 + cg * 8) = w; *(u32x4*)(TW + (p8 + 8) * 136 + cg * 8) = (u32x4){0u, 0u, 0u, 0u}; }
        }
    }
}
__device__ __forceinline__ void scan_prepB(const Params& p, unsigned char* lds, int buf, int tb, int S, int dir, int h, int quarter, int c, int pw, int lane, const float (&rv)[8], const float (&kv)[8]) {
    unsigned char* ws = p.ws;
    float* R = (float*)(lds + buf * SC_BUF); float* W = R + 2048; float* BB = W + 2048; float* KD = BB + 2048; float* KK = KD + 2048;
    bf16_t* TW = (bf16_t*)(lds + SC_TW + pw * 4608); bf16_t* TA = TW + 1152;
    const int p8 = lane >> 3, cg = lane & 7, pp = 8 * pw + p8;
    const float* CM = (const float*)(lds + SC_CONST); const bf16_t* CWT = (const bf16_t*)(lds + SC_CONST + 2560);
    __builtin_amdgcn_wave_barrier();
    { f32x4 acc[4];
#pragma unroll
      for (int nt = 0; nt < 4; ++nt) acc[nt] = (f32x4){0.f, 0.f, 0.f, 0.f};
#pragma unroll
      for (int k4 = 0; k4 < 4; ++k4) { const bf16x8 a = *(const bf16x8*)(TW + (lane & 15) * 136 + 32 * k4 + 8 * (lane >> 4));
#pragma unroll
          for (int nt = 0; nt < 4; ++nt) { const bf16x8 bb = *(const bf16x8*)(CWT + (16 * nt + (lane & 15)) * 136 + 32 * k4 + 8 * (lane >> 4)); acc[nt] = __builtin_amdgcn_mfma_f32_16x16x32_bf16(a, bb, acc[nt], 0, 0, 0); } }
      const int q4 = lane >> 4, isa = q4 >> 1; float* dst = isa ? BB : W;
#pragma unroll
      for (int nt = 0; nt < 4; ++nt) { const int j = 16 * nt + (lane & 15); const float bias = CM[512 + isa * 64 + j];
#pragma unroll
          for (int i = 0; i < 4; ++i) { const int q = 8 * pw + 4 * (q4 & 1) + i; const float sg = sigm(acc[nt][i] + bias);
              dst[q * 64 + j] = isa ? sg : __expf(-0.60653066f * sg); } } }
    __builtin_amdgcn_wave_barrier();
    { const float4 a0 = *(const float4*)(BB + pp * 64 + cg * 8), a1 = *(const float4*)(BB + pp * 64 + cg * 8 + 4);
      const float4 kw0 = *(const float4*)(CM + 320 + cg * 8), kw1 = *(const float4*)(CM + 324 + cg * 8), ka0 = *(const float4*)(CM + 384 + cg * 8), ka1 = *(const float4*)(CM + 388 + cg * 8),
                   rk0 = *(const float4*)(CM + 448 + cg * 8), rk1 = *(const float4*)(CM + 452 + cg * 8);
      const float a[8] = {a0.x, a0.y, a0.z, a0.w, a1.x, a1.y, a1.z, a1.w}, kw[8] = {kw0.x, kw0.y, kw0.z, kw0.w, kw1.x, kw1.y, kw1.z, kw1.w},
                  ka[8] = {ka0.x, ka0.y, ka0.z, ka0.w, ka1.x, ka1.y, ka1.z, ka1.w}, rk[8] = {rk0.x, rk0.y, rk0.z, rk0.w, rk1.x, rk1.y, rk1.z, rk1.w};
      float kkr[8], kd[8], n2 = 0.f, bon = 0.f;
#pragma unroll
      for (int e = 0; e < 8; ++e) { kkr[e] = kv[e] * kw[e]; n2 += kkr[e] * kkr[e]; kd[e] = kv[e] * (1.0f + (a[e] - 1.0f) * ka[e]); bon += rv[e] * kd[e] * rk[e]; }
      n2 = red8(n2); bon = red8(bon);
      const float inv = 1.0f / fmaxf(sqrtf(n2), 1e-12f);
      float kk[8];
#pragma unroll
      for (int e = 0; e < 8; ++e) kk[e] = kkr[e] * inv;
      *(float4*)(KK + pp * 64 + cg * 8) = make_float4(kk[0], kk[1], kk[2], kk[3]); *(float4*)(KK + pp * 64 + cg * 8 + 4) = make_float4(kk[4], kk[5], kk[6], kk[7]);
      *(float4*)(KD + pp * 64 + cg * 8) = make_float4(kd[0], kd[1], kd[2], kd[3]); *(float4*)(KD + pp * 64 + cg * 8 + 4) = make_float4(kd[4], kd[5], kd[6], kd[7]);
      *(float4*)(BB + pp * 64 + cg * 8) = make_float4(kk[0] * a[0], kk[1] * a[1], kk[2] * a[2], kk[3] * a[3]); *(float4*)(BB + pp * 64 + cg * 8 + 4) = make_float4(kk[4] * a[4], kk[5] * a[5], kk[6] * a[6], kk[7] * a[7]);
      if (quarter == 0 && cg == 0) { const int pos = c * SC_CH + pp, t = dir ? S - 1 - pos : pos; ((float*)(ws + WS_BONUS))[(size_t)(tb + t) * 16 + dir * 8 + h] = bon; } }
}

#define SCAN_BAR() do { asm volatile("s_waitcnt lgkmcnt(0)" ::: "memory"); __builtin_amdgcn_s_barrier(); asm volatile("" ::: "memory"); } while (0)

__device__ __forceinline__ void scan_phase(const Params& p, unsigned char* lds) {
    int tid = threadIdx.x; asm volatile("" : "+v"(tid));
    const int wid = __builtin_amdgcn_readfirstlane(tid >> 6), lane = tid & 63;
    unsigned char* ws = p.ws;
    const bf16_t* Z = (const bf16_t*)(ws + WS_Z); bf16_t* MIX = (bf16_t*)(ws + WS_H); bf16_t* Y1 = (bf16_t*)(ws + WS_Y1);
    float* YC = (float*)(lds + SC_YC);
    const bool bal = gridDim.x == 256; const int nbk = gridDim.x, bk = blockIdx.x;
    const int nitems = bal ? (bk < 128 ? 4 : 6) : (1280 - bk + nbk - 1) / nbk;
    for (int ii = 0; ii < nitems; ++ii) {
        int it;
        if (!bal) it = bk + ii * nbk;
        else if (ii == 0) it = bk;
        else it = 256 + (bk < 128 ? bk * 3 + (ii - 1) : 384 + (bk - 128) * 5 + (ii - 1));
        const bool lat = it < 256; const int q = lat ? it : it - 256;
        const int quarter = q & 3, dir = (q >> 2) & 1, h = (q >> 3) & 7, b = q >> 6;
        const int S = lat ? 4096 : 256, tb = lat ? NCTX + b * 4096 : b * 256, nch = S / SC_CH;
        const bool cons = (wid & 1) == 0;
        const int rl = (wid >> 1) * 4 + ((tid >> 4) & 3), ks = tid & 15, row = quarter * 16 + rl, pw = wid >> 1;
        f32x2 s01 = {0.f, 0.f}, s23 = {0.f, 0.f};
        ScanLoads L;
        { float* CM = (float*)(lds + SC_CONST); bf16_t* CWT = (bf16_t*)(lds + SC_CONST + 2560);
          if (tid < 320) { const int sec = tid >> 6, j = tid & 63; CM[tid] = p.in[I_MU][(sec < 3 ? sec * 512 + h * 64 : (sec == 3 ? 1536 + dir * 64 : 1664 + dir * 64)) + j]; }
          else if (tid < 384) CM[tid] = p.in[I_KK][h * 64 + tid - 320];
          else if (tid < 448) CM[tid] = p.in[I_KA][h * 64 + tid - 384];
          else CM[tid] = p.in[I_RK][h * 64 + tid - 448];
          if (tid < 128) CM[512 + tid] = (tid < 64 ? p.in[I_W0] : p.in[I_A0])[dir * 512 + h * 64 + (tid & 63)];
          for (int e = tid; e < 1024; e += 512) { const int mat = e >> 9, j = (e >> 3) & 63, i8 = e & 7;
              *(u32x4*)(CWT + j * 136 + mat * 64 + i8 * 8) = *(const u32x4*)((const bf16_t*)(ws + (mat ? WS_A2T : WS_W2T)) + (size_t)dir * 512 * 64 + (size_t)(h * 64 + j) * 64 + i8 * 8); }
          SCAN_BAR(); }
        if (cons) { if (lat) { const float4 v = *(const float4*)((dir ? p.in[I_SB] : p.in[I_SF]) + ((size_t)(b * 8 + h) * 64 + row) * 64 + ks * 4); s01 = (f32x2){v.x, v.y}; s23 = (f32x2){v.z, v.w}; } }
        else { float rv[8], kv[8]; scan_issue(L, Z, tb, S, lat, dir, h, 0, pw, lane); scan_prepA(L, lds, 0, quarter, pw, lane, rv, kv); scan_issue(L, Z, tb, S, lat, dir, h, 1, pw, lane);
               scan_prepB(p, lds, 0, tb, S, dir, h, quarter, 0, pw, lane, rv, kv); }
        SCAN_BAR();
        for (int c = 0; c < nch; ++c) {
            if (cons) {
                const unsigned char* bufp = lds + (c & 1) * SC_BUF;
                const float4* R4 = (const float4*)bufp; const float4* W4 = R4 + 512; const float4* B4 = W4 + 512; const float4* KD4 = B4 + 512; const float4* KK4 = KD4 + 512; const float* V = (const float*)(KK4 + 512);
                float* yc = YC + (c & 1) * 2048 + rl * 4 + (ks >> 2);
                float4 kkA, wA, bA, kdA, rA, kkB, wB, bB, kdB, rB; float vA, vB;
#define SC_LOAD(X, pp_) do { kk##X = KK4[(pp_) * 16 + ks]; w##X = W4[(pp_) * 16 + ks]; b##X = B4[(pp_) * 16 + ks]; kd##X = KD4[(pp_) * 16 + ks]; r##X = R4[(pp_) * 16 + ks]; v##X = V[(pp_) * 16 + rl]; } while (0)
#define SC_STEP(X, pp_) do { \
                    f32x2 d = s01 * (f32x2){kk##X.x, kk##X.y}; d = __builtin_elementwise_fma(s23, (f32x2){kk##X.z, kk##X.w}, d); \
                    const float sa = -red16(d.x + d.y); \
                    const f32x2 sa2 = {sa, sa}, vv2 = {v##X, v##X}; \
                    f32x2 t01 = vv2 * (f32x2){kd##X.x, kd##X.y}, t23 = vv2 * (f32x2){kd##X.z, kd##X.w}; \
                    t01 = __builtin_elementwise_fma(sa2, (f32x2){b##X.x, b##X.y}, t01); t23 = __builtin_elementwise_fma(sa2, (f32x2){b##X.z, b##X.w}, t23); \
                    s01 = __builtin_elementwise_fma(s01, (f32x2){w##X.x, w##X.y}, t01); s23 = __builtin_elementwise_fma(s23, (f32x2){w##X.z, w##X.w}, t23); \
                    f32x2 y2 = s01 * (f32x2){r##X.x, r##X.y}; y2 = __builtin_elementwise_fma(s23, (f32x2){r##X.z, r##X.w}, y2); \
                    float yp = y2.x + y2.y; yp = dpp_add<0xB1>(yp); yp = dpp_add<0x4E>(yp); yc[(pp_) * 64] = yp; } while (0)
                SC_LOAD(A, 0);
#pragma unroll 8
                for (int pp = 0; pp < SC_CH; pp += 2) {
                    SC_LOAD(B, pp + 1); __builtin_amdgcn_sched_barrier(0);
                    SC_STEP(A, pp); __builtin_amdgcn_sched_barrier(0);
                    SC_LOAD(A, (pp + 2) & (SC_CH - 1)); __builtin_amdgcn_sched_barrier(0);
                    SC_STEP(B, pp + 1); __builtin_amdgcn_sched_barrier(0);
                }
#undef SC_LOAD
#undef SC_STEP
            } else if (c + 1 < nch) {
                float rv[8], kv[8];
                scan_prepA(L, lds, (c + 1) & 1, quarter, pw, lane, rv, kv);
                if (c + 2 < nch) scan_issue(L, Z, tb, S, lat, dir, h, c + 2, pw, lane);
                __builtin_amdgcn_sched_barrier(0);
                scan_prepB(p, lds, (c + 1) & 1, tb, S, dir, h, quarter, c + 1, pw, lane, rv, kv);
            }
            SCAN_BAR();
            { const int pp = tid >> 4, r_ = tid & 15, pos = c * SC_CH + pp, t = dir ? S - 1 - pos : pos; const float4 y4 = *(const float4*)(YC + (c & 1) * 2048 + tid * 4); const bf16_t yv = f2bf((y4.x + y4.y) + (y4.z + y4.w));
              if (dir == 0) MIX[(size_t)(tb + t) * DM + 512 + h * 64 + quarter * 16 + r_] = yv; else Y1[(size_t)(tb + t) * DRW + h * 64 + quarter * 16 + r_] = yv; }
        }
        if (!lat && cons) *(float4*)(p.out + (size_t)NTOK * DM + (size_t)dir * 524288 + ((size_t)(b * 8 + h) * 64 + row) * 64 + ks * 4) = make_float4(s01.x, s01.y, s23.x, s23.y);
        SCAN_BAR();
    }
}


constexpr int S2_SA = 0, S2_SA_SZ = 16896, S2_SB = 50688, S2_SB_SZ = 16384, S2_SC = 83456, S2_SC_SZ = 15616, S2_SD = 130304, S2_SD_SZ = 3072, S2_CONST = 136448;
typedef short bf16x4 __attribute__((ext_vector_type(4)));

__device__ __forceinline__ bf16x8 frag2(const bf16_t* p0, const bf16_t* p1) { const u32x2 a = *(const u32x2*)p0, b = *(const u32x2*)p1; const u32x4 w = {a.x, a.y, b.x, b.y}; return __builtin_bit_cast(bf16x8, w); }
__device__ __forceinline__ bf16x8 frag1(const bf16_t* p0) { const u32x2 a = *(const u32x2*)p0; const u32x4 w = {a.x, a.y, 0u, 0u}; return __builtin_bit_cast(bf16x8, w); }
__device__ __forceinline__ bf16x8 fragf(const f32x4& lo) { const u32x4 w = {cvt_pk_bf16(lo[0], lo[1]), cvt_pk_bf16(lo[2], lo[3]), 0u, 0u}; return __builtin_bit_cast(bf16x8, w); }
__device__ __forceinline__ bf16x8 fragff(const f32x4& lo, const f32x4& hi) { const u32x4 w = {cvt_pk_bf16(lo[0], lo[1]), cvt_pk_bf16(lo[2], lo[3]), cvt_pk_bf16(hi[0], hi[1]), cvt_pk_bf16(hi[2], hi[3])}; return __builtin_bit_cast(bf16x8, w); }

struct Scan2Loads { u32x4 z0[5]; unsigned nb[5][4][2]; };
__device__ __forceinline__ void scan2_issue(Scan2Loads& L, const bf16_t* __restrict__ Z, int tb, int S, bool lat, int dir, int h, int c, int pw, int lane, bool need_r = true) {
    const int pos = c * 16 + 8 * pw + (lane >> 3), t = dir ? S - 1 - pos : pos, cg = lane & 7;
    int tn[4]; bool ok[4];
    tn[0] = t - 1; tn[1] = t + 1;
    if (lat) { ok[0] = (t & 63) != 0; ok[1] = (t & 63) != 63; tn[2] = t - 64; ok[2] = t >= 64; tn[3] = t + 64; ok[3] = t < S - 64; }
    else { ok[0] = t > 0; ok[1] = t < S - 1; tn[2] = tn[0]; ok[2] = ok[0]; tn[3] = tn[1]; ok[3] = ok[1]; }
    const bf16_t* zr = Z + (size_t)(tb + t) * DZ + cg * 8;
#pragma unroll
    for (int d = 0; d < 4; ++d) tn[d] = ok[d] ? (tn[d] - t) * DZ : 0;
#pragma unroll
    for (int sec = 0; sec < 5; ++sec) {
        const int col0 = sec < 3 ? sec * 512 + h * 64 : (sec == 3 ? 1536 + dir * 64 : 1664 + dir * 64);
        if (sec == 0 && !need_r) continue;
        L.z0[sec] = *(const u32x4*)(zr + col0);
#pragma unroll
        for (int d = 0; d < 4; ++d) { const unsigned* np = (const unsigned*)(zr + col0 + tn[d]) + (d >> 1); const unsigned a = np[0], b = np[2]; L.nb[sec][d][0] = ok[d] ? a : 0u; L.nb[sec][d][1] = ok[d] ? b : 0u; }
    }
}
__device__ __forceinline__ void scan2_stageA(const Scan2Loads& L, unsigned char* lds, int c, int pw, int lane, bool need_r = true) {
    unsigned char* sa = lds + S2_SA + (c % 3) * S2_SA_SZ;
    float* RR = (float*)sa; float* KR = RR + 1024; float* VR = KR + 1024; bf16_t* TWA = (bf16_t*)(sa + 12288); bf16_t* TAA = TWA + 1152;
    const float* CM = (const float*)(lds + S2_CONST);
    const int cg = lane & 7, pp = 8 * pw + (lane >> 3);
#pragma unroll
    for (int sec = 0; sec < 5; ++sec) {
        if (sec == 0 && !need_r) continue;
        const float4 m0 = *(const float4*)(CM + sec * 64 + cg * 8), m1 = *(const float4*)(CM + sec * 64 + cg * 8 + 4);
        const float mu[8] = {m0.x, m0.y, m0.z, m0.w, m1.x, m1.y, m1.z, m1.w};
        float val[8];
#pragma unroll
        for (int e = 0; e < 8; ++e) { const float z0 = bfsel(L.z0[sec], e), zn = bfhalf(L.nb[sec][e & 3][e >> 2], e & 1); val[e] = z0 + mu[e] * (zn - z0); }
        if (sec < 3) { float* D = sec == 0 ? RR : (sec == 1 ? KR : VR);
            *(float4*)(D + pp * 64 + cg * 8) = make_float4(val[0], val[1], val[2], val[3]); *(float4*)(D + pp * 64 + cg * 8 + 4) = make_float4(val[4], val[5], val[6], val[7]); }
        else {
            if (sec == 3) {
#pragma unroll
                for (int e = 0; e < 8; ++e) val[e] = 1.0f - 2.0f * __builtin_amdgcn_rcpf(1.0f + __expf(2.0f * val[e]));
            }
            u32x4 w; w.x = cvt_pk_bf16(val[0], val[1]); w.y = cvt_pk_bf16(val[2], val[3]); w.z = cvt_pk_bf16(val[4], val[5]); w.w = cvt_pk_bf16(val[6], val[7]);
            *(u32x4*)((sec == 3 ? TWA : TAA) + pp * 72 + cg * 8) = w;
        }
    }
}
__device__ __forceinline__ void scan2_stageB(const Params& p, unsigned char* lds, int c, bool iclr, int tb, int S, int dir, int h, int lane, int cb = 0, bool wbon = true) {
    unsigned char* sa = lds + S2_SA + (c % 3) * S2_SA_SZ; unsigned char* sb = lds + S2_SB + (c & 1) * S2_SB_SZ;
    const float* RR = (const float*)sa; const float* KR = RR + 1024; const bf16_t* TX = (const bf16_t*)(sa + 12288) + (iclr ? 1152 : 0);
    float* G = (float*)sb; float* KAP = G + 1024; float* BET = KAP + 1024; float* KDD = BET + 1024;
    const float* CM = (const float*)(lds + S2_CONST); const bf16_t* WT = (const bf16_t*)(lds + S2_CONST + 2560) + (iclr ? 4608 : 0);
    const int jl = lane & 15, q = lane >> 4;
    f32x4 acc[4];
#pragma unroll
    for (int nt = 0; nt < 4; ++nt) acc[nt] = (f32x4){0.f, 0.f, 0.f, 0.f};
#pragma unroll
    for (int k2 = 0; k2 < 2; ++k2) { const bf16x8 a = *(const bf16x8*)(TX + jl * 72 + 32 * k2 + 8 * q);
#pragma unroll
        for (int nt = 0; nt < 4; ++nt) { const bf16x8 bb = *(const bf16x8*)(WT + (16 * nt + jl) * 72 + 32 * k2 + 8 * q); acc[nt] = __builtin_amdgcn_mfma_f32_16x16x32_bf16(a, bb, acc[nt], 0, 0, 0); } }
    if (!iclr) {
#pragma unroll
        for (int nt = 0; nt < 4; ++nt) { const int j = 16 * nt + jl; const float bias = CM[512 + j]; float cs[4]; float run = 0.f;
#pragma unroll
            for (int i = 0; i < 4; ++i) { run += 0.60653066f * sigm(acc[nt][i] + bias); cs[i] = run; }
            const float t1 = __shfl(run, lane - 16), t2 = __shfl(run, lane - 32), t3 = __shfl(run, lane - 48);
            const float off = (q >= 1 ? t1 : 0.f) + (q >= 2 ? t2 : 0.f) + (q >= 3 ? t3 : 0.f);
#pragma unroll
            for (int i = 0; i < 4; ++i) G[(4 * q + i) * 64 + j] = __expf(-(off + cs[i])); }
    } else {
        float a[4][4], kkr[4][4], kv[4][4], rv[4][4], n2[4] = {0.f, 0.f, 0.f, 0.f}, bon[4] = {0.f, 0.f, 0.f, 0.f};
#pragma unroll
        for (int nt = 0; nt < 4; ++nt) { const int j = 16 * nt + jl; const float bias = CM[576 + j], kw = CM[320 + j], ka = CM[384 + j], rk = CM[448 + j];
#pragma unroll
            for (int i = 0; i < 4; ++i) { const int t = 4 * q + i; a[nt][i] = sigm(acc[nt][i] + bias); const float k = KR[t * 64 + j], r = wbon ? RR[t * 64 + j] : 0.f;
                kkr[nt][i] = k * kw; n2[i] += kkr[nt][i] * kkr[nt][i]; kv[nt][i] = k * (1.0f + (a[nt][i] - 1.0f) * ka); bon[i] += r * kv[nt][i] * rk; } }
#pragma unroll
        for (int i = 0; i < 4; ++i) { n2[i] = red16(n2[i]); bon[i] = red16(bon[i]); n2[i] = 1.0f / fmaxf(sqrtf(n2[i]), 1e-12f); }
#pragma unroll
        for (int nt = 0; nt < 4; ++nt) { const int j = 16 * nt + jl;
#pragma unroll
            for (int i = 0; i < 4; ++i) { const int t = 4 * q + i; const float kap = kkr[nt][i] * n2[i]; KAP[t * 64 + j] = kap; BET[t * 64 + j] = kap * a[nt][i]; KDD[t * 64 + j] = kv[nt][i]; } }
        if (jl == 0 && wbon) {
#pragma unroll
            for (int i = 0; i < 4; ++i) { const int pos = (c + cb) * 16 + 4 * q + i, t = dir ? S - 1 - pos : pos; ((float*)(p.ws + WS_BONUS))[(size_t)(tb + t) * 16 + dir * 8 + h] = bon[i]; } }
    }
}
__device__ __forceinline__ void scan2_stageC(unsigned char* lds, int c, int w, int lane) {
    const unsigned char* sa = lds + S2_SA + (c % 3) * S2_SA_SZ; const unsigned char* sb = lds + S2_SB + (c & 1) * S2_SB_SZ; unsigned char* sc = lds + S2_SC + (c % 3) * S2_SC_SZ;
    const float* RR = (const float*)sa; const float* VR = RR + 2048; const float* G = (const float*)sb; const float* KAP = G + 1024; const float* BET = KAP + 1024; const float* KDD = BET + 1024;
    bf16_t* KT = (bf16_t*)sc; bf16_t* RT = KT + 1152; bf16_t* BT = RT + 1152; bf16_t* KKT = BT + 1152; bf16_t* BTT = KKT + 1152; bf16_t* KKTT = BTT + 1024; bf16_t* VT = KKTT + 1024; float* GL = (float*)(sc + 15360);
    const int t = lane >> 2, k0 = 16 * w + 4 * (lane & 3), o = t * 64 + k0;
    const float4 g = *(const float4*)(G + o), gm = t > 0 ? *(const float4*)(G + o - 64) : make_float4(1.f, 1.f, 1.f, 1.f);
    const float4 kap = *(const float4*)(KAP + o), bet = *(const float4*)(BET + o), kdd = *(const float4*)(KDD + o), r = *(const float4*)(RR + o), v = *(const float4*)(VR + o);
    const float4 gi = make_float4(__builtin_amdgcn_rcpf(g.x), __builtin_amdgcn_rcpf(g.y), __builtin_amdgcn_rcpf(g.z), __builtin_amdgcn_rcpf(g.w));
    const float bt[4] = {bet.x * gi.x, bet.y * gi.y, bet.z * gi.z, bet.w * gi.w}, kt[4] = {kdd.x * gi.x, kdd.y * gi.y, kdd.z * gi.z, kdd.w * gi.w}, vv[4] = {v.x, v.y, v.z, v.w};
    u32x2 x;
    x.x = cvt_pk_bf16(kap.x * gm.x, kap.y * gm.y); x.y = cvt_pk_bf16(kap.z * gm.z, kap.w * gm.w); *(u32x2*)(KT + t * 72 + k0) = x;
    x.x = cvt_pk_bf16(r.x * g.x, r.y * g.y); x.y = cvt_pk_bf16(r.z * g.z, r.w * g.w); *(u32x2*)(RT + t * 72 + k0) = x;
    x.x = cvt_pk_bf16(bt[0], bt[1]); x.y = cvt_pk_bf16(bt[2], bt[3]); *(u32x2*)(BT + t * 72 + k0) = x;
    x.x = cvt_pk_bf16(kt[0], kt[1]); x.y = cvt_pk_bf16(kt[2], kt[3]); *(u32x2*)(KKT + t * 72 + k0) = x;
#pragma unroll
    for (int e = 0; e < 4; ++e) { BTT[(k0 + e) * 16 + t] = f2bf(bt[e]); KKTT[(k0 + e) * 16 + t] = f2bf(kt[e]); VT[(k0 + e) * 16 + t] = f2bf(vv[e]); }
    if (t == 15) *(float4*)(GL + k0) = g;
}
__device__ __forceinline__ void scan2_stageD(unsigned char* lds, int c, int w, int lane) {
    const unsigned char* sc = lds + S2_SC + (c % 3) * S2_SC_SZ; unsigned char* sd = lds + S2_SD + (c & 1) * S2_SD_SZ;
    const bf16_t* X = (const bf16_t*)sc + ((w & 2) ? 1152 : 0); const bf16_t* Y = (const bf16_t*)sc + 2304 + ((w & 1) ? 1152 : 0);
    bf16_t* AKK = (bf16_t*)sd; bf16_t* ABR = AKK + 256; bf16_t* AKR = ABR + 256; bf16_t* TT = AKR + 256; float* AF = (float*)(sd + 2048);
    const int s = lane & 15, q = lane >> 4;
    f32x4 acc = {0.f, 0.f, 0.f, 0.f};
#pragma unroll
    for (int k2 = 0; k2 < 2; ++k2) { const bf16x8 a = *(const bf16x8*)(X + s * 72 + 32 * k2 + 8 * q), bb = *(const bf16x8*)(Y + s * 72 + 32 * k2 + 8 * q); acc = __builtin_amdgcn_mfma_f32_16x16x32_bf16(a, bb, acc, 0, 0, 0); }
    if (w != 0) {
#pragma unroll
        for (int i = 0; i < 4; ++i) { const int t = 4 * q + i; const bool keep = (w & 2) ? (s <= t) : (s < t); (w == 1 ? AKK : (w == 2 ? ABR : AKR))[t * 16 + s] = f2bf(keep ? acc[i] : 0.f); }
    } else {
        f32x4 acc2 = {0.f, 0.f, 0.f, 0.f};
#pragma unroll
        for (int k2 = 0; k2 < 2; ++k2) { const bf16x8 a = *(const bf16x8*)(Y + s * 72 + 32 * k2 + 8 * q), bb = *(const bf16x8*)(X + s * 72 + 32 * k2 + 8 * q); acc2 = __builtin_amdgcn_mfma_f32_16x16x32_bf16(a, bb, acc2, 0, 0, 0); }
        f32x4 Nn, NT, Tt;
#pragma unroll
        for (int i = 0; i < 4; ++i) { const int m = 4 * q + i; Nn[i] = (m < s) ? acc2[i] : 0.f; NT[i] = (s < m) ? acc[i] : 0.f; Tt[i] = (m == s ? 1.0f : 0.0f) - NT[i]; }
#pragma unroll
        for (int lev = 0; lev < 3; ++lev) {
            f32x4 N2 = {0.f, 0.f, 0.f, 0.f}, N2T = {0.f, 0.f, 0.f, 0.f};
#pragma unroll
            for (int j = 0; j < 4; ++j) { N2 = __builtin_amdgcn_mfma_f32_16x16x4f32(NT[j], Nn[j], N2, 0, 0, 0); N2T = __builtin_amdgcn_mfma_f32_16x16x4f32(Nn[j], NT[j], N2T, 0, 0, 0); }
            f32x4 Tn = Tt;
#pragma unroll
            for (int j = 0; j < 4; ++j) Tn = __builtin_amdgcn_mfma_f32_16x16x4f32(N2[j], Tt[j], Tn, 0, 0, 0);
            Tt = Tn; Nn = N2; NT = N2T;
        }
#pragma unroll
        for (int i = 0; i < 4; ++i) TT[(4 * q + i) * 16 + s] = f2bf(-Tt[i]);
    }
}
__device__ __forceinline__ void scan2_stageE(unsigned char* lds, int c, int w, int lane, f32x4 (&P)[4], bf16_t* __restrict__ yout, int ystride, int tb, int S, int dir, int cb = 0) {
    const unsigned char* sc = lds + S2_SC + (c % 3) * S2_SC_SZ; const unsigned char* sd = lds + S2_SD + (c & 1) * S2_SD_SZ;
    const bf16_t* KT = (const bf16_t*)sc; const bf16_t* RT = KT + 1152; const bf16_t* BTT = KT + 4608; const bf16_t* KKTT = BTT + 1024; const bf16_t* VT = KKTT + 1024; const float* GL = (const float*)(sc + 15360);
    const bf16_t* AKK = (const bf16_t*)sd; const bf16_t* ABR = AKK + 256; const bf16_t* AKR = ABR + 256; const bf16_t* TT = AKR + 256;
    const int jl = lane & 15, q = lane >> 4;
    const f32x4 zero = {0.f, 0.f, 0.f, 0.f};
    const bf16x8 Pb0 = fragff(P[0], P[1]), Pb1 = fragff(P[2], P[3]);
    f32x4 QT = __builtin_amdgcn_mfma_f32_16x16x32_bf16(frag2(KT + jl * 72 + 4 * q, KT + jl * 72 + 16 + 4 * q), Pb0, zero, 0, 0, 0);
    QT = __builtin_amdgcn_mfma_f32_16x16x32_bf16(frag2(KT + jl * 72 + 32 + 4 * q, KT + jl * 72 + 48 + 4 * q), Pb1, QT, 0, 0, 0);
    f32x4 YT = __builtin_amdgcn_mfma_f32_16x16x32_bf16(frag2(RT + jl * 72 + 4 * q, RT + jl * 72 + 16 + 4 * q), Pb0, zero, 0, 0, 0);
    YT = __builtin_amdgcn_mfma_f32_16x16x32_bf16(frag2(RT + jl * 72 + 32 + 4 * q, RT + jl * 72 + 48 + 4 * q), Pb1, YT, 0, 0, 0);
    const bf16x8 Vb = frag1(VT + (16 * w + jl) * 16 + 4 * q);
    QT = __builtin_amdgcn_mfma_f32_16x16x32_bf16(frag1(AKK + jl * 16 + 4 * q), Vb, QT, 0, 0, 0);
    const f32x4 UT = __builtin_amdgcn_mfma_f32_16x16x32_bf16(frag1(TT + jl * 16 + 4 * q), fragf(QT), zero, 0, 0, 0);
    const bf16x8 Ub = fragf(UT);
    YT = __builtin_amdgcn_mfma_f32_16x16x32_bf16(frag1(ABR + jl * 16 + 4 * q), Ub, YT, 0, 0, 0);
    YT = __builtin_amdgcn_mfma_f32_16x16x32_bf16(frag1(AKR + jl * 16 + 4 * q), Vb, YT, 0, 0, 0);
#pragma unroll
    for (int i = 0; i < 4; ++i) { const int pos = (c + cb) * 16 + 4 * q + i, t = dir ? S - 1 - pos : pos; yout[(size_t)(tb + t) * ystride + 16 * w + jl] = f2bf(YT[i]); }
#pragma unroll
    for (int mt = 0; mt < 4; ++mt) {
        P[mt] = __builtin_amdgcn_mfma_f32_16x16x32_bf16(frag1(BTT + (16 * mt + jl) * 16 + 4 * q), Ub, P[mt], 0, 0, 0);
        P[mt] = __builtin_amdgcn_mfma_f32_16x16x32_bf16(frag1(KKTT + (16 * mt + jl) * 16 + 4 * q), Vb, P[mt], 0, 0, 0);
        const float4 gl = *(const float4*)(GL + 16 * mt + 4 * q);
        P[mt][0] *= gl.x; P[mt][1] *= gl.y; P[mt][2] *= gl.z; P[mt][3] *= gl.w;
    }
}

__device__ __forceinline__ void scan2_stageE1(unsigned char* lds, int c, int w, int lane, f32x4 (&P)[4], f32x4 (&X)[4]) {
    const unsigned char* sc = lds + S2_SC + (c % 3) * S2_SC_SZ; const unsigned char* sd = lds + S2_SD + (c & 1) * S2_SD_SZ;
    const bf16_t* KT = (const bf16_t*)sc; const bf16_t* BTT = KT + 4608; const bf16_t* KKTT = BTT + 1024; const bf16_t* VT = KKTT + 1024; const float* GL = (const float*)(sc + 15360);
    const bf16_t* AKK = (const bf16_t*)sd; const bf16_t* TT = AKK + 768;
    const int jl = lane & 15, q = lane >> 4;
    const f32x4 zero = {0.f, 0.f, 0.f, 0.f};
    const bf16x8 KT0 = frag2(KT + jl * 72 + 4 * q, KT + jl * 72 + 16 + 4 * q), KT1 = frag2(KT + jl * 72 + 32 + 4 * q, KT + jl * 72 + 48 + 4 * q);
    f32x4 QT = __builtin_amdgcn_mfma_f32_16x16x32_bf16(KT0, fragff(P[0], P[1]), zero, 0, 0, 0);
    QT = __builtin_amdgcn_mfma_f32_16x16x32_bf16(KT1, fragff(P[2], P[3]), QT, 0, 0, 0);
    f32x4 QX = __builtin_amdgcn_mfma_f32_16x16x32_bf16(KT0, fragff(X[0], X[1]), zero, 0, 0, 0);
    QX = __builtin_amdgcn_mfma_f32_16x16x32_bf16(KT1, fragff(X[2], X[3]), QX, 0, 0, 0);
    const bf16x8 Vb = frag1(VT + (16 * w + jl) * 16 + 4 * q);
    QT = __builtin_amdgcn_mfma_f32_16x16x32_bf16(frag1(AKK + jl * 16 + 4 * q), Vb, QT, 0, 0, 0);
    const bf16x8 TTf = frag1(TT + jl * 16 + 4 * q);
    const f32x4 UT = __builtin_amdgcn_mfma_f32_16x16x32_bf16(TTf, fragf(QT), zero, 0, 0, 0), UX = __builtin_amdgcn_mfma_f32_16x16x32_bf16(TTf, fragf(QX), zero, 0, 0, 0);
    const bf16x8 Ub = fragf(UT), UXb = fragf(UX);
#pragma unroll
    for (int mt = 0; mt < 4; ++mt) {
        const bf16x8 Bf = frag1(BTT + (16 * mt + jl) * 16 + 4 * q);
        P[mt] = __builtin_amdgcn_mfma_f32_16x16x32_bf16(Bf, Ub, P[mt], 0, 0, 0);
        P[mt] = __builtin_amdgcn_mfma_f32_16x16x32_bf16(frag1(KKTT + (16 * mt + jl) * 16 + 4 * q), Vb, P[mt], 0, 0, 0);
        X[mt] = __builtin_amdgcn_mfma_f32_16x16x32_bf16(Bf, UXb, X[mt], 0, 0, 0);
        const float4 gl = *(const float4*)(GL + 16 * mt + 4 * q);
        P[mt][0] *= gl.x; P[mt][1] *= gl.y; P[mt][2] *= gl.z; P[mt][3] *= gl.w; X[mt][0] *= gl.x; X[mt][1] *= gl.y; X[mt][2] *= gl.z; X[mt][3] *= gl.w;
    }
}

__device__ __forceinline__ void scan2_run(const Params& p, unsigned char* lds, const bool lat, const int b, const int h, const int dir, const int cb, const int nch, const int mode, const int seg) {
    int tid = threadIdx.x; asm volatile("" : "+v"(tid));
    const int wid = __builtin_amdgcn_readfirstlane(tid >> 6), lane = tid & 63;
    unsigned char* ws = p.ws;
    const bf16_t* Z = (const bf16_t*)(ws + WS_Z);
    const int S = lat ? 4096 : 256, tb = lat ? NCTX + b * 4096 : b * 256;
    float* SEG = (float*)(ws + WS_SEG) + (size_t)((b * 8 + h) * 2 + dir) * 3 * 8192;
    { float* CM = (float*)(lds + S2_CONST); bf16_t* CWT = (bf16_t*)(lds + S2_CONST + 2560);
      if (tid < 320) { const int sec = tid >> 6, j = tid & 63; CM[tid] = p.in[I_MU][(sec < 3 ? sec * 512 + h * 64 : (sec == 3 ? 1536 + dir * 64 : 1664 + dir * 64)) + j]; }
      else if (tid < 384) CM[tid] = p.in[I_KK][h * 64 + tid - 320];
      else if (tid < 448) CM[tid] = p.in[I_KA][h * 64 + tid - 384];
      else CM[tid] = p.in[I_RK][h * 64 + tid - 448];
      if (tid < 128) CM[512 + tid] = (tid < 64 ? p.in[I_W0] : p.in[I_A0])[dir * 512 + h * 64 + (tid & 63)];
      for (int e = tid; e < 1024; e += 512) { const int mat = e >> 9, j = (e >> 3) & 63, i8 = e & 7;
          *(u32x4*)(CWT + mat * 4608 + j * 72 + i8 * 8) = *(const u32x4*)((const bf16_t*)(ws + (mat ? WS_A2T : WS_W2T)) + (size_t)dir * 512 * 64 + (size_t)(h * 64 + j) * 64 + i8 * 8); }
      SCAN_BAR(); }
    bf16_t* yout = dir == 0 ? (bf16_t*)(ws + WS_H) + 512 + h * 64 : (bf16_t*)(ws + WS_Y1) + h * 64; const int ystride = dir == 0 ? DM : DRW;
    const int vrow = 16 * (wid & 3) + (lane & 15), q4 = lane >> 4;
    f32x4 P[4];
#pragma unroll
    for (int mt = 0; mt < 4; ++mt) P[mt] = (f32x4){0.f, 0.f, 0.f, 0.f};
    if (mode == 0 && lat) {
        if (wid < 4) {
#pragma unroll
            for (int mt = 0; mt < 4; ++mt) P[mt] = *(const f32x4*)((dir ? p.in[I_SB] : p.in[I_SF]) + ((size_t)(b * 8 + h) * 64 + vrow) * 64 + 16 * mt + 4 * q4);
        }
        float* XL = (float*)(lds + S2_SA);
        for (int jj = 0; jj < seg; ++jj) {
            const float* Xg = SEG + (size_t)jj * 8192; const float* Ng = Xg + 4096;
            for (int e = tid; e < 1024; e += 512) *(float4*)(XL + e * 4) = *(const float4*)(Xg + e * 4);
            SCAN_BAR();
            if (wid < 4) {
                f32x4 Pn[4];
#pragma unroll
                for (int mt = 0; mt < 4; ++mt) { Pn[mt] = *(const f32x4*)(Ng + vrow * 64 + 16 * mt + 4 * q4);
#pragma unroll
                    for (int m2 = 0; m2 < 4; ++m2)
#pragma unroll
                        for (int j = 0; j < 4; ++j) Pn[mt] = __builtin_amdgcn_mfma_f32_16x16x4f32(XL[(16 * m2 + 4 * q4 + j) * 64 + 16 * mt + (lane & 15)], P[m2][j], Pn[mt], 0, 0, 0); }
#pragma unroll
                for (int mt = 0; mt < 4; ++mt) P[mt] = Pn[mt];
            }
            SCAN_BAR();
        }
    }
    if (wid >= 6) {
        Scan2Loads L0, L1; const int pw = wid - 6;
        const bool nr = mode == 0; scan2_issue(L0, Z, tb, S, lat, dir, h, cb, pw, lane, nr); scan2_issue(L1, Z, tb, S, lat, dir, h, cb + 1, pw, lane, nr);
        for (int pd = 0; pd < nch + 4; pd += 2) {
            if (pd < nch) { scan2_stageA(L0, lds, pd, pw, lane, nr); if (pd + 2 < nch) scan2_issue(L0, Z, tb, S, lat, dir, h, cb + pd + 2, pw, lane, nr); }
            SCAN_BAR();
            if (pd + 1 < nch) { scan2_stageA(L1, lds, pd + 1, pw, lane, nr); if (pd + 3 < nch) scan2_issue(L1, Z, tb, S, lat, dir, h, cb + pd + 3, pw, lane, nr); }
            SCAN_BAR();
        }
    } else if (wid >= 4) {
        for (int pd = 0; pd < nch + 4; ++pd) { const int c = pd - 1; if (c >= 0 && c < nch) scan2_stageB(p, lds, c, wid == 5, tb, S, dir, h, lane, cb, mode == 0); SCAN_BAR(); }
    } else if (mode == 0) {
        for (int pd = 0; pd < nch + 4; ++pd) {
            const int cE = pd - 4, cC = pd - 2, cD = pd - 3;
            if (cE >= 0 && cE < nch) scan2_stageE(lds, cE, wid, lane, P, yout, ystride, tb, S, dir, cb);
            if (cC >= 0 && cC < nch) scan2_stageC(lds, cC, wid, lane);
            if (cD >= 0 && cD < nch) scan2_stageD(lds, cD, wid, lane);
            SCAN_BAR();
        }
        if (!lat) {
#pragma unroll
            for (int mt = 0; mt < 4; ++mt) *(f32x4*)(p.out + (size_t)NTOK * DM + (size_t)dir * 524288 + ((size_t)(b * 8 + h) * 64 + vrow) * 64 + 16 * mt + 4 * q4) = P[mt];
        }
    } else {
        f32x4 X[4];
#pragma unroll
        for (int mt = 0; mt < 4; ++mt)
#pragma unroll
            for (int i = 0; i < 4; ++i) X[mt][i] = (16 * mt + 4 * q4 + i == vrow) ? 1.0f : 0.0f;
        for (int pd = 0; pd < nch + 4; ++pd) {
            const int cE = pd - 4, cC = pd - 2, cD = pd - 3;
            if (cE >= 0 && cE < nch) scan2_stageE1(lds, cE, wid, lane, P, X);
            if (cC >= 0 && cC < nch) { if (wid >= 2) { scan2_stageC(lds, cC, wid, lane); scan2_stageC(lds, cC, wid == 2 ? 1 : 0, lane); } }
            if (cD >= 0 && cD < nch && wid < 2) scan2_stageD(lds, cD, wid, lane);
            SCAN_BAR();
        }
        float* Xg = SEG + (size_t)seg * 8192; float* Ng = Xg + 4096;
#pragma unroll
        for (int mt = 0; mt < 4; ++mt) { *(f32x4*)(Xg + vrow * 64 + 16 * mt + 4 * q4) = X[mt]; *(f32x4*)(Ng + vrow * 64 + 16 * mt + 4 * q4) = P[mt]; }
    }
    SCAN_BAR();
}
__device__ __forceinline__ void scan3_pass1(const Params& p, unsigned char* lds) {
    const int bk = blockIdx.x;
    if (bk < 192) { const int it = bk / 3, seg = bk % 3; scan2_run(p, lds, true, it >> 4, (it >> 1) & 7, it & 1, seg * 64, 64, 1, seg); }
}
__device__ __forceinline__ void scan3_pass2(const Params& p, unsigned char* lds) {
    const int bk = blockIdx.x;
    { const int it = bk >> 2, seg = bk & 3; scan2_run(p, lds, true, it >> 4, (it >> 1) & 7, it & 1, seg * 64, 64, 0, seg); }
    { const int ci = bk; scan2_run(p, lds, false, ci >> 4, (ci >> 1) & 7, ci & 1, 0, 16, 0, 0); }
}
__device__ __forceinline__ void scan2_phase(const Params& p, unsigned char* lds) {
    int tid = threadIdx.x; asm volatile("" : "+v"(tid));
    const int wid = __builtin_amdgcn_readfirstlane(tid >> 6), lane = tid & 63;
    unsigned char* ws = p.ws;
    const bf16_t* Z = (const bf16_t*)(ws + WS_Z);
    const int nbk = gridDim.x, bk = blockIdx.x; const bool bal = nbk == 256;
    for (int it = bk; it < 320; it += nbk) {
        const bool lat = it < 64; const int q_ = lat ? it : it - 64;
        const int dir = q_ & 1, h = (q_ >> 1) & 7, b = q_ >> 4;
        const int S = lat ? 4096 : 256, tb = lat ? NCTX + b * 4096 : b * 256, nch = S >> 4;
        { float* CM = (float*)(lds + S2_CONST); bf16_t* CWT = (bf16_t*)(lds + S2_CONST + 2560);
          if (tid < 320) { const int sec = tid >> 6, j = tid & 63; CM[tid] = p.in[I_MU][(sec < 3 ? sec * 512 + h * 64 : (sec == 3 ? 1536 + dir * 64 : 1664 + dir * 64)) + j]; }
          else if (tid < 384) CM[tid] = p.in[I_KK][h * 64 + tid - 320];
          else if (tid < 448) CM[tid] = p.in[I_KA][h * 64 + tid - 384];
          else CM[tid] = p.in[I_RK][h * 64 + tid - 448];
          if (tid < 128) CM[512 + tid] = (tid < 64 ? p.in[I_W0] : p.in[I_A0])[dir * 512 + h * 64 + (tid & 63)];
          for (int e = tid; e < 1024; e += 512) { const int mat = e >> 9, j = (e >> 3) & 63, i8 = e & 7;
              *(u32x4*)(CWT + mat * 4608 + j * 72 + i8 * 8) = *(const u32x4*)((const bf16_t*)(ws + (mat ? WS_A2T : WS_W2T)) + (size_t)dir * 512 * 64 + (size_t)(h * 64 + j) * 64 + i8 * 8); }
          SCAN_BAR(); }
        bf16_t* yout = dir == 0 ? (bf16_t*)(ws + WS_H) + 512 + h * 64 : (bf16_t*)(ws + WS_Y1) + h * 64; const int ystride = dir == 0 ? DM : DRW;
        if (wid >= 6) {
            Scan2Loads L0, L1; const int pw = wid - 6;
            scan2_issue(L0, Z, tb, S, lat, dir, h, 0, pw, lane); scan2_issue(L1, Z, tb, S, lat, dir, h, 1, pw, lane);
            for (int pd = 0; pd < nch + 4; pd += 2) {
                if (pd < nch) { scan2_stageA(L0, lds, pd, pw, lane); if (pd + 2 < nch) scan2_issue(L0, Z, tb, S, lat, dir, h, pd + 2, pw, lane); }
                SCAN_BAR();
                if (pd + 1 < nch) { scan2_stageA(L1, lds, pd + 1, pw, lane); if (pd + 3 < nch) scan2_issue(L1, Z, tb, S, lat, dir, h, pd + 3, pw, lane); }
                SCAN_BAR();
            }
        } else if (wid >= 4) {
            for (int pd = 0; pd < nch + 4; ++pd) { const int c = pd - 1; if (c >= 0 && c < nch) scan2_stageB(p, lds, c, wid == 5, tb, S, dir, h, lane); SCAN_BAR(); }
        } else {
            f32x4 P[4];
#pragma unroll
            for (int mt = 0; mt < 4; ++mt) P[mt] = (f32x4){0.f, 0.f, 0.f, 0.f};
            const int vrow = 16 * wid + (lane & 15);
            if (lat) {
#pragma unroll
                for (int mt = 0; mt < 4; ++mt) P[mt] = *(const f32x4*)((dir ? p.in[I_SB] : p.in[I_SF]) + ((size_t)(b * 8 + h) * 64 + vrow) * 64 + 16 * mt + 4 * (lane >> 4));
            }
            for (int pd = 0; pd < nch + 4; ++pd) {
                const int cE = pd - 4, cC = pd - 2, cD = pd - 3;
                if (cE >= 0 && cE < nch) scan2_stageE(lds, cE, wid, lane, P, yout, ystride, tb, S, dir);
                if (cC >= 0 && cC < nch) scan2_stageC(lds, cC, wid, lane);
                if (cD >= 0 && cD < nch) scan2_stageD(lds, cD, wid, lane);
                SCAN_BAR();
            }
            if (!lat) {
#pragma unroll
                for (int mt = 0; mt < 4; ++mt) *(f32x4*)(p.out + (size_t)NTOK * DM + (size_t)dir * 524288 + ((size_t)(b * 8 + h) * 64 + vrow) * 64 + 16 * mt + 4 * (lane >> 4)) = P[mt];
            }
        }
        SCAN_BAR();
    }
}

__device__ __forceinline__ void finalize_phase(const Params& p, unsigned char* lds) {
    bf16_t* GA = (bf16_t*)lds;
    const int tid = threadIdx.x, wid = tid >> 6, lane = tid & 63;
    unsigned char* ws = p.ws;
    const bf16_t* Z = (const bf16_t*)(ws + WS_Z); bf16_t* MIX = (bf16_t*)(ws + WS_H); const bf16_t* Y1 = (const bf16_t*)(ws + WS_Y1); const float* BON = (const float*)(ws + WS_BONUS);
    const bf16_t* G2T = (const bf16_t*)(ws + WS_G2T); const float* mu = p.in[I_MU];
    bf16x8 bfr[4][4]; float lw[4], lb[4];
#pragma unroll
    for (int nt = 0; nt < 4; ++nt) { const int c = 64 * wid + 16 * nt + (lane & 15); lw[nt] = p.in[I_LNW][c]; lb[nt] = p.in[I_LNB][c];
#pragma unroll
        for (int k4 = 0; k4 < 4; ++k4) bfr[k4][nt] = *(const bf16x8*)(G2T + (size_t)c * 128 + 32 * k4 + 8 * (lane >> 4)); }
    for (int tile = blockIdx.x; tile < 1280; tile += gridDim.x) {
        const int t0 = tile * 16; const bool lat = t0 >= NCTX;
        const int b = lat ? (t0 - NCTX) >> 12 : t0 >> 8, tb = lat ? NCTX + b * 4096 : b * 256, S = lat ? 4096 : 256, tl0 = t0 - tb;
        for (int e = tid; e < 2048; e += 512) { const int tt = e >> 7, j = e & 127, col = 1792 + j; GA[tt * 136 + j] = f2bf(sigm(zshift(Z, tb, tl0 + tt, S, lat, col, mu[col]))); }
        float ys[4][4], vs[4][4], bon[4];
#pragma unroll
        for (int i = 0; i < 4; ++i) {
            const int tl = tl0 + 4 * (lane >> 4) + i, tg = tb + tl;
            bon[i] = BON[(size_t)tg * 16 + wid] + BON[(size_t)tg * 16 + 8 + wid];
#pragma unroll
            for (int nt = 0; nt < 4; ++nt) { const int c = 64 * wid + 16 * nt + (lane & 15);
                ys[i][nt] = bf2f(MIX[(size_t)tg * DM + 512 + c]) + bf2f(Y1[(size_t)tg * DRW + c]);
                vs[i][nt] = zshift(Z, tb, tl, S, lat, 1024 + c, mu[1024 + c]); }
        }
        __syncthreads();
        f32x4 acc[4];
#pragma unroll
        for (int nt = 0; nt < 4; ++nt) acc[nt] = (f32x4){0.f, 0.f, 0.f, 0.f};
#pragma unroll
        for (int k4 = 0; k4 < 4; ++k4) { const bf16x8 a = *(const bf16x8*)(GA + (lane & 15) * 136 + 32 * k4 + 8 * (lane >> 4));
#pragma unroll
            for (int nt = 0; nt < 4; ++nt) acc[nt] = __builtin_amdgcn_mfma_f32_16x16x32_bf16(a, bfr[k4][nt], acc[nt], 0, 0, 0); }
        bf16_t ov[4][4];
#pragma unroll
        for (int i = 0; i < 4; ++i) {
            const float sm = (ys[i][0] + ys[i][1]) + (ys[i][2] + ys[i][3]);
            const float mean = red16(sm) * (1.0f / 64.0f); float sq = 0.f;
#pragma unroll
            for (int nt = 0; nt < 4; ++nt) { const float d = ys[i][nt] - mean; sq += d * d; }
            const float rstd = rsqrtf(red16(sq) * (1.0f / 64.0f) + 64e-5f);
#pragma unroll
            for (int nt = 0; nt < 4; ++nt) ov[i][nt] = f2bf(((ys[i][nt] - mean) * rstd * lw[nt] + lb[nt] + bon[i] * vs[i][nt]) * acc[nt][i]);
        }
#pragma unroll
        for (int i = 0; i < 4; ++i) { const int tg = tb + tl0 + 4 * (lane >> 4) + i;
#pragma unroll
            for (int nt = 0; nt < 4; ++nt) MIX[(size_t)tg * DM + 512 + 64 * wid + 16 * nt + (lane & 15)] = ov[i][nt]; }
        __syncthreads();
    }
}

#ifndef PROBE_DUP
#define PROBE_DUP 0
#endif
__global__ void __launch_bounds__(512, 2) fwd_megakernel(Params p) {
    extern __shared__ __attribute__((aligned(16))) unsigned char shm[];
    cg::grid_group grid = cg::this_grid();
    unsigned* bar = (unsigned*)(p.ws + WS_BAR);
    volatile PG8_LAS unsigned* st = (volatile PG8_LAS unsigned*)((PG8_LAS unsigned char*)shm + (LDS_BYTES - 16));
    if (threadIdx.x == 0) { st[0] = 0u; st[1] = 0u; }
    PG8_LAS unsigned char* lds3 = (PG8_LAS unsigned char*)shm;
    unsigned char* ws = p.ws; float* out = p.out; const float* mod = (const float*)(ws + WS_MOD);
    const char* H = (const char*)(ws + WS_H); const int G = gridDim.x, c = blockIdx.x;

    __syncthreads();
    const XcdBarrier xb = xcd_barrier_post(bar, st);
    if (p.out == nullptr) grid.sync();
    phase0(p, shm);
    xcd_barrier(xb);
#if PROBE_DUP == 3
    phase0(p, shm);
    xcd_barrier(xb);
#endif
    norm_phase(p.in[I_XP], p.in[I_XS], p.in[I_NORMG], mod, 0, 1024, (bf16_t*)(ws + WS_H));
    for (int e = blockIdx.x * 512 + threadIdx.x; e < 10240; e += gridDim.x * 512) { const int which = e / 5120, r = (e % 5120) >> 10, k = e & 1023;
        ((float*)(ws + WS_GP))[e] = p.in[I_NORMG][(1 + which) * 1024 + k] * (1.0f + mod[r * NMOD + (which ? 7168 : 4096) + k]); }
    __syncthreads();
    ffn_conv(p.in[I_WG], p.in[I_WU], p.in[I_WD], (bf16_t*)(ws + WS_W1GU), (bf16_t*)(ws + WS_W1D), (float*)shm, c, G);
    xcd_barrier(xb);
#if PROBE_DUP == 8
    norm_phase(p.in[I_XP], p.in[I_XS], p.in[I_NORMG], mod, 0, 1024, (bf16_t*)(ws + WS_H));
    xcd_barrier(xb);
#endif
    { SchedPlain S{H, (const char*)(ws + WS_W1GU), 80, 22, DM, G, c}; EpiGU E{(bf16_t*)(ws + WS_ACT)}; pg8::gemm_phase(lds3, DM, S, E); }
    xcd_barrier(xb);
#if PROBE_DUP == 5
    { SchedPlain S{H, (const char*)(ws + WS_W1GU), 80, 22, DM, G, c}; EpiGU E{(bf16_t*)(ws + WS_ACT)}; pg8::gemm_phase(lds3, DM, S, E); }
    xcd_barrier(xb);
#endif
    { SchedPlain S{(const char*)(ws + WS_ACT), (const char*)(ws + WS_W1D), 80, 4, DFF, G, c, 2}; EpiResN E{p.in[I_XP], p.in[I_XS], out, ws, 2048, 0.5f, 0}; pg8::gemm_phase(lds3, DFF, S, E); }
    if (G == 256) { if (c >= 64) phase0b(p, shm, c - 64, 192); } else phase0b(p, shm, c, G);
    xcd_barrier(xb);
#if PROBE_DUP == 6
    { SchedPlain S{(const char*)(ws + WS_ACT), (const char*)(ws + WS_W1D), 80, 4, DFF, G, c, 2}; EpiRes E{p.in[I_XP], p.in[I_XS], out, mod, 2048, 0.5f}; pg8::gemm_phase(lds3, DFF, S, E); }
    xcd_barrier(xb);
#endif
    { SchedWin S{H, (const char*)(ws + WS_WZ), (const char*)(ws + WS_WF), G, c}; EpiWinN E{(bf16_t*)(ws + WS_Z), (bf16_t*)(ws + WS_PT), (const float*)(ws + WS_SSQ), (const float*)(ws + WS_CBW)}; pg8::gemm_phase(lds3, DM, S, E); }
    xcd_barrier(xb);
#if PROBE_DUP == 7
    { SchedWin S{H, (const char*)(ws + WS_WZ), (const char*)(ws + WS_WF), G, c}; EpiWin E{(bf16_t*)(ws + WS_Z), (bf16_t*)(ws + WS_PT)}; pg8::gemm_phase(lds3, DM, S, E); }
    xcd_barrier(xb);
#endif
    if (G == 256) {
        scan3_pass1(p, shm);
        __syncthreads();
        { SchedFourSym S{(const char*)(ws + WS_DLAT), (const char*)(ws + WS_PT) + (size_t)4194304 * 2, c >= 192 ? c - 192 : 1000}; EpiFourSym E{(bf16_t*)(ws + WS_H), 1.0f / 512.0f}; pg8::gemm_phase(lds3, 8192, S, E, 4096); }
        fourier_nyquist((const bf16_t*)(ws + WS_PT) + 4194304, (bf16_t*)(ws + WS_H), 1.0f / 512.0f);
        __syncthreads();
        { SchedFourCtx S{(const char*)(ws + WS_DCTX), (const char*)(ws + WS_PT), 1024, c >= 192 && c < 224 ? c - 192 : 1000}; EpiFour E{(bf16_t*)(ws + WS_H), 1.0f / 128.0f}; pg8::gemm_phase(lds3, 512, S, E); }
        xcd_barrier(xb);
        scan3_pass2(p, shm);
        __syncthreads();
    } else {
    scan2_phase(p, shm);
    __syncthreads();
    { SchedFourLat S{(const char*)(ws + WS_DLAT), (const char*)(ws + WS_PT) + (size_t)4194304 * 2, G, c}; EpiFour E{(bf16_t*)(ws + WS_H), 1.0f / 512.0f}; pg8::gemm_phase(lds3, 8192, S, E); }
    __syncthreads();
    }
#if PROBE_DUP == 2
    { SchedFourLat S{(const char*)(ws + WS_DLAT), (const char*)(ws + WS_PT) + (size_t)4194304 * 2, G, c}; EpiFour E{(bf16_t*)(ws + WS_H), 1.0f / 512.0f}; pg8::gemm_phase(lds3, 8192, S, E); }
    __syncthreads();
#endif
    if (G != 256) { SchedFourCtx S{(const char*)(ws + WS_DCTX), (const char*)(ws + WS_PT), G, c}; EpiFour E{(bf16_t*)(ws + WS_H), 1.0f / 128.0f}; pg8::gemm_phase(lds3, 512, S, E); }
    xcd_barrier(xb);
    finalize_phase(p, shm);
    xcd_barrier(xb);
#if PROBE_DUP == 4
    xcd_barrier(xb); xcd_barrier(xb); xcd_barrier(xb); xcd_barrier(xb); xcd_barrier(xb); xcd_barrier(xb); xcd_barrier(xb); xcd_barrier(xb); xcd_barrier(xb); xcd_barrier(xb);
#endif
    { SchedPlain S{H, (const char*)(ws + WS_WOUT), 80, 4, DM, G, c, 2}; EpiResN E{out, out + (size_t)NCTX * DM, out, ws, 5120, 1.0f, 1}; pg8::gemm_phase(lds3, DM, S, E); }
    __syncthreads();
    if (G == 256) { if (c >= 64) ffn_conv(p.in[I_WG] + (size_t)DM * DFF, p.in[I_WU] + (size_t)DM * DFF, p.in[I_WD] + (size_t)DM * DFF, (bf16_t*)(ws + WS_W2GU), (bf16_t*)(ws + WS_W2D), (float*)shm, c - 64, 192); }
    else ffn_conv(p.in[I_WG] + (size_t)DM * DFF, p.in[I_WU] + (size_t)DM * DFF, p.in[I_WD] + (size_t)DM * DFF, (bf16_t*)(ws + WS_W2GU), (bf16_t*)(ws + WS_W2D), (float*)shm, c, G);
    xcd_barrier(xb);
    { SchedPlain S{(const char*)(ws + WS_XG3), (const char*)(ws + WS_W2GU), 80, 22, DM, G, c}; EpiGUN E{(bf16_t*)(ws + WS_ACT), (const float*)(ws + WS_SSQ), (const float*)(ws + WS_CBG)}; pg8::gemm_phase(lds3, DM, S, E); }
    xcd_barrier(xb);
    { SchedPlain S{(const char*)(ws + WS_ACT), (const char*)(ws + WS_W2D), 80, 4, DFF, G, c, 2}; EpiResB16 E{out, out + (size_t)NCTX * DM, (bf16_t*)(ws + WS_XG3), mod, 8192, 0.5f}; pg8::gemm_phase(lds3, DFF, S, E); }
    xcd_barrier(xb);
    final_norm_phase(out, p.in[I_FN], (const bf16_t*)(ws + WS_XG3));
}

extern "C" void kernel_launch(void* const* d_in, const int* in_sizes, int n_in, void* d_out, int out_size, void* d_ws, size_t ws_size, hipStream_t stream) {
    static int grid_blocks = 0;
    if (grid_blocks == 0) {
        if (n_in != 26 || ws_size < WS_END) { fprintf(stderr, "kernel_launch: unexpected n_in %d / ws_size %zu (need %zu)\n", n_in, ws_size, (size_t)WS_END); grid_blocks = -1; return; }
        int dev = 0, cus = 0, per_cu = 0;
        hipGetDevice(&dev);
        hipDeviceGetAttribute(&cus, hipDeviceAttributeMultiprocessorCount, dev);
        if (hipFuncSetAttribute((const void*)fwd_megakernel, hipFuncAttributeMaxDynamicSharedMemorySize, LDS_BYTES) != hipSuccess) { fprintf(stderr, "kernel_launch: hipFuncSetAttribute failed\n"); grid_blocks = -1; return; }
        if (hipOccupancyMaxActiveBlocksPerMultiprocessor(&per_cu, (const void*)fwd_megakernel, 512, LDS_BYTES) != hipSuccess || per_cu < 1) { fprintf(stderr, "kernel_launch: occupancy query failed (%d)\n", per_cu); grid_blocks = -1; return; }
        grid_blocks = cus * per_cu;
    }
    if (grid_blocks < 0) return;
    Params p{};
    for (int i = 0; i < 26; ++i) p.in[i] = (const float*)d_in[i];
    p.out = (float*)d_out; p.ws = (unsigned char*)d_ws;
    void* args[] = {&p};
    if (hipMemsetAsync((unsigned char*)d_ws + WS_BAR, 0, XCD_BAR_WORDS * sizeof(unsigned), stream) != hipSuccess) { fprintf(stderr, "kernel_launch: hipMemsetAsync of the barrier words failed\n"); return; }
    hipError_t e = hipLaunchCooperativeKernel((const void*)fwd_megakernel, dim3(grid_blocks), dim3(512), args, LDS_BYTES, stream);
    if (e != hipSuccess) fprintf(stderr, "cooperative launch failed: %s (grid %d)\n", hipGetErrorString(e), grid_blocks);
}
```

```cpp
#include <hip/hip_runtime.h>
#include <hip/hip_cooperative_groups.h>
#include <cstdio>
namespace cg = cooperative_groups;

namespace pg8 {
#define PG8_LAS __attribute__((address_space(3)))
typedef unsigned short bf16_t;
typedef short bf16x8 __attribute__((ext_vector_type(8)));
typedef float f32x4 __attribute__((ext_vector_type(4)));
typedef unsigned u32x4 __attribute__((ext_vector_type(4)));
typedef unsigned u32x2 __attribute__((ext_vector_type(2)));
constexpr int BM = 256, BK = 64, HALF = 128, HTB = HALF * BK * 2, STAGE_BYTES = 8 * HTB, NXCD = 8, WGM = 4;

__host__ __device__ __forceinline__ int lds_byte(int r, int c) { const int st = (r >> 4) * 2 + (c >> 5), rr = r & 15, cc = c & 31, ob = rr * 64 + cc * 2; return st * 1024 + (ob ^ (((ob >> 9) & 1) << 5)); }
__host__ __device__ __forceinline__ void stage_rc(int b, int& R, int& C) { const int st = b / 1024, sb = b % 1024, swz = sb ^ (((sb >> 9) & 1) << 5); R = (st >> 1) * 16 + swz / 64; C = (st & 1) * 32 + (swz % 64) / 2; }
__host__ __device__ __forceinline__ int perm32(int rho) { const int n = rho >> 4, i = rho & 15; return 8 * (i >> 2) + 4 * n + (i & 3); }

struct Unit { int pm, pn, kind, aux; const char* a; const char* b; };

__device__ __forceinline__ void tile_of(int wgid, int nM, int nN, int& pm, int& pn) {
    const int nwg = nM * nN;
    { const int q = nwg / NXCD, r = nwg % NXCD, xcd = wgid % NXCD, off = wgid / NXCD; wgid = (xcd < r ? xcd * (q + 1) : r * (q + 1) + (xcd - r) * q) + off; }
    const int nig = WGM * nN, gid = wgid / nig, fm = gid * WGM, gsz = (nM - fm) < WGM ? (nM - fm) : WGM;
    pm = fm + ((wgid % nig) % gsz); pn = (wgid % nig) / gsz;
}
typedef __bf16 bf16v2_t __attribute__((ext_vector_type(2)));
__device__ __forceinline__ unsigned cvt_pk_bf16(float lo, float hi) { const bf16v2_t v = {(__bf16)lo, (__bf16)hi}; return __builtin_bit_cast(unsigned, v); }

template <class Epi, class Sched>
__device__ __forceinline__ void gemm_phase(PG8_LAS unsigned char* lds, const int K, const Sched& S, const Epi& E, const int KL = 0) {
    int tid = threadIdx.x; asm volatile("" : "+v"(tid));
    const int wid = __builtin_amdgcn_readfirstlane(tid >> 6), lane = tid & 63, wr = wid >> 2, wc = wid & 3, fr = lane & 15, fq = lane >> 4;
    const int nt = (KL ? KL : K) / BK;
#define PG8_STAMP() do {} while (0)
    PG8_STAMP();
    unsigned voffA[2], voffB[2];
#pragma unroll
    for (int i = 0; i < 2; ++i) { int R, C; stage_rc(tid * 16 + i * 8192, R, C); const int Rb = Epi::PERM ? ((R & ~31) + perm32(R & 31)) : R;
        voffA[i] = (unsigned)(R * K + C) * 2u; voffB[i] = (unsigned)(Rb * K + C) * 2u; }
    const size_t kstep = (size_t)(BK * 2);
    const size_t hstep = (size_t)HALF * K * 2;
    const unsigned ldsw = (unsigned)wid * 1024u;
    const int aoff = lds_byte(wr * 64 + fr, fq * 8), boff = lds_byte(wc * 32 + fr, fq * 8);
#define PG8_SA(b, h) (((b) * 2 + (h)) * HTB)
#define PG8_SB(b, h) ((4 + (b) * 2 + (h)) * HTB)
#define PG8_STAGE(bufoff, gbase, voff) do { _Pragma("unroll") for (int _i = 0; _i < 2; ++_i) \
        __builtin_amdgcn_global_load_lds((const unsigned*)((const char*)(gbase) + (voff)[_i]), (PG8_LAS unsigned*)(lds + (bufoff) + ldsw + _i * 8192), 16, 0, 0); } while (0)
#define PG8_LDA(dst, b, h) do { _Pragma("unroll") for (int m = 0; m < 4; ++m) _Pragma("unroll") for (int k = 0; k < 2; ++k) dst[m][k] = *(const PG8_LAS bf16x8*)(lds + PG8_SA(b, h) + aoff + m * 2048 + k * 1024); } while (0)
#define PG8_LDB(dst, b, h) do { _Pragma("unroll") for (int n = 0; n < 2; ++n) _Pragma("unroll") for (int k = 0; k < 2; ++k) dst[n][k] = *(const PG8_LAS bf16x8*)(lds + PG8_SB(b, h) + boff + n * 2048 + k * 1024); } while (0)
#define PG8_MMA(ai, bj, At, Bt) do { __builtin_amdgcn_s_setprio(1); _Pragma("unroll") for (int m = 0; m < 4; ++m) _Pragma("unroll") for (int n = 0; n < 2; ++n) _Pragma("unroll") for (int k = 0; k < 2; ++k) \
        acc[ai][bj][m][n] = __builtin_amdgcn_mfma_f32_16x16x32_bf16(Bt[n][k], At[m][k], acc[ai][bj][m][n], 0, 0, 0); __builtin_amdgcn_s_setprio(0); } while (0)
#define PG8_WAIT_V(n) asm volatile("s_waitcnt vmcnt(" #n ")" ::: "memory")
#define PG8_WAIT_L(n) asm volatile("s_waitcnt lgkmcnt(" #n ")" ::: "memory")
#define PG8_BAR __builtin_amdgcn_s_barrier()
#define PG8_SCHED __builtin_amdgcn_sched_barrier(0)
    Unit cur, nxt; int ui = 0;
    if (!S.next(0, cur)) return;
    f32x4 acc[2][2][4][2];
#pragma unroll
    for (int a = 0; a < 2; ++a)
#pragma unroll
        for (int b = 0; b < 2; ++b)
#pragma unroll
            for (int m = 0; m < 4; ++m)
#pragma unroll
                for (int n = 0; n < 2; ++n) acc[a][b][m][n] = (f32x4){0.f, 0.f, 0.f, 0.f};
    bf16x8 At[4][2], B0[2][2], B1[2][2];
    const char* cA = cur.a; const char* cB = cur.b;
    PG8_STAGE(PG8_SB(0, 0), cB, voffB); PG8_STAGE(PG8_SA(0, 0), cA, voffA); PG8_STAGE(PG8_SB(0, 1), cB + hstep, voffB); PG8_STAGE(PG8_SA(0, 1), cA + hstep, voffA);
    if (wr == 1) PG8_BAR;
    PG8_WAIT_V(4); PG8_BAR;
    PG8_STAGE(PG8_SB(1, 0), cB + kstep, voffB); PG8_STAGE(PG8_SA(1, 0), cA + kstep, voffA); PG8_STAGE(PG8_SB(1, 1), cB + hstep + kstep, voffB);
    PG8_WAIT_V(6); PG8_BAR;
    PG8_STAMP();
    for (;;) {
        const bool has_next = S.next(ui + 1, nxt);
        const char* nA = has_next ? nxt.a : cA; const char* nB = has_next ? nxt.b : cB;
        for (int t = 0; t < nt; t += 2) {
            const bool last = (t == nt - 2);
            const char* a1 = cA + (size_t)(t + 1) * kstep;
            const char* a2 = last ? nA : cA + (size_t)(t + 2) * kstep; const char* b2 = last ? nB : cB + (size_t)(t + 2) * kstep;
            const char* a3 = a2 + kstep; const char* b3 = b2 + kstep;
            PG8_LDB(B0, 0, 0); PG8_SCHED; PG8_LDA(At, 0, 0); PG8_STAGE(PG8_SA(1, 1), a1 + hstep, voffA);
            PG8_WAIT_L(8); PG8_BAR; PG8_WAIT_L(0); PG8_MMA(0, 0, At, B0); PG8_BAR; PG8_SCHED;
            PG8_LDB(B1, 0, 1); PG8_STAGE(PG8_SB(0, 0), b2, voffB);
            PG8_BAR; PG8_WAIT_L(0); PG8_MMA(0, 1, At, B1); PG8_BAR;
            PG8_LDA(At, 0, 1); PG8_STAGE(PG8_SA(0, 0), a2, voffA);
            PG8_BAR; PG8_WAIT_L(0); PG8_MMA(1, 0, At, B0); PG8_BAR; PG8_SCHED;
            PG8_STAGE(PG8_SB(0, 1), b2 + hstep, voffB);
            PG8_WAIT_V(6); PG8_BAR; PG8_MMA(1, 1, At, B1); PG8_BAR;
            PG8_LDB(B0, 1, 0); PG8_SCHED; PG8_LDA(At, 1, 0); PG8_STAGE(PG8_SA(0, 1), a2 + hstep, voffA);
            PG8_WAIT_L(8); PG8_BAR; PG8_WAIT_L(0); PG8_MMA(0, 0, At, B0); PG8_BAR; PG8_SCHED;
            PG8_LDB(B1, 1, 1); PG8_STAGE(PG8_SB(1, 0), b3, voffB);
            PG8_BAR; PG8_WAIT_L(0); PG8_MMA(0, 1, At, B1); PG8_BAR;
            PG8_LDA(At, 1, 1); PG8_STAGE(PG8_SA(1, 0), a3, voffA);
            PG8_BAR; PG8_WAIT_L(0); PG8_MMA(1, 0, At, B0); PG8_BAR; PG8_SCHED;
            PG8_STAGE(PG8_SB(1, 1), b3 + hstep, voffB);
            PG8_WAIT_V(6); PG8_BAR; PG8_MMA(1, 1, At, B1); PG8_BAR;
        }
        PG8_STAMP();
        { int fr2 = lane & 15, fq2 = lane >> 4; asm volatile("" : "+v"(fr2), "+v"(fq2)); E(acc, cur, wr, wc, fr2, fq2); }
        PG8_STAMP();
        if (!has_next) break;
        if (nxt.kind != 3) {
#pragma unroll
        for (int a = 0; a < 2; ++a)
#pragma unroll
            for (int b = 0; b < 2; ++b)
#pragma unroll
                for (int m = 0; m < 4; ++m)
#pragma unroll
                    for (int n = 0; n < 2; ++n) acc[a][b][m][n] = (f32x4){0.f, 0.f, 0.f, 0.f};
        }
        cur = nxt; cA = nA; cB = nB; ++ui;
    }
    PG8_WAIT_V(0);
    if (wr == 0) PG8_BAR;
    PG8_BAR;
    PG8_STAMP();
#undef PG8_STAMP
#undef PG8_SA
#undef PG8_SB
#undef PG8_STAGE
#undef PG8_LDA
#undef PG8_LDB
#undef PG8_MMA
#undef PG8_WAIT_V
#undef PG8_WAIT_L
#undef PG8_BAR
#undef PG8_SCHED
}
}
#define XB_TMO      128
#define XB_XCNT(j)  (256  + 64 * (j))
#define XB_XSUB(j)  (1280 + 64 * (j))
#define XB_XGEN(j)  (2304 + 64 * (j))
#define XB_TOP      3328
#define XB_TOPGEN   3392
#define XCD_BAR_WORDS 3456
#define XB_SPIN_CAP (1u << 18)
#define LAS PG8_LAS

__device__ __forceinline__ unsigned xb_ld(unsigned* p)              { return __hip_atomic_load(p, __ATOMIC_RELAXED, __HIP_MEMORY_SCOPE_AGENT); }
__device__ __forceinline__ unsigned xb_add(unsigned* p, unsigned v) { return __hip_atomic_fetch_add(p, v, __ATOMIC_RELAXED, __HIP_MEMORY_SCOPE_AGENT); }
__device__ __forceinline__ unsigned xb_xcc_id() { return (unsigned)__builtin_amdgcn_s_getreg((3 << 11) | 20) & 0xFu; }
#define XB_SPIN(cond, bar) do { unsigned _sp = 0; while (cond) { __builtin_amdgcn_s_sleep(1); \
    if ((++_sp & 255u) == 0u) { if (xb_ld(&(bar)[XB_TMO])) break; if (_sp > XB_SPIN_CAP) { atomicAdd(&(bar)[XB_TMO], 1u); break; } } } } while (0)

struct XcdBarrier {
    unsigned* bar; unsigned x;
    volatile LAS unsigned* st;
};

__device__ __forceinline__ XcdBarrier xcd_barrier_post(unsigned* bar, volatile LAS unsigned* st) {
    XcdBarrier b; b.bar = bar; b.x = xb_xcc_id(); b.st = st;
    if (threadIdx.x == 0) (void)xb_add(&bar[XB_XCNT(b.x)], 1u);
    return b;
}
__device__ __forceinline__ void xcd_barrier_complete(unsigned* bar, unsigned x, unsigned& nloc, unsigned& nx) {
    const unsigned G = gridDim.x * gridDim.y * gridDim.z;
    unsigned sum, cnt, mine, sp = 0u;
    for (;;) {
        sum = 0u; cnt = 0u; mine = 0u;
#pragma unroll
        for (unsigned j = 0; j < 16; ++j) { const unsigned c = xb_ld(&bar[XB_XCNT(j)]); sum += c; cnt += (c > 0u) ? 1u : 0u; mine = (j == x) ? c : mine; }
        if (sum == G) break;
        __builtin_amdgcn_s_sleep(1);
        if ((++sp & 255u) == 0u) { if (xb_ld(&bar[XB_TMO])) break; if (sp > XB_SPIN_CAP) { atomicAdd(&bar[XB_TMO], 1u); break; } }
    }
    nloc = mine > 0u ? mine : 1u; nx = cnt > 0u ? cnt : 1u;
}

__device__ __forceinline__ void xcd_barrier(const XcdBarrier& b) {
    asm volatile("s_waitcnt vmcnt(0)" ::: "memory");
    __syncthreads();
    if (threadIdx.x == 0) {
        unsigned* bar = b.bar;
        __builtin_amdgcn_s_waitcnt(0);
        unsigned nloc = b.st[0], nx = b.st[1];
        if (nloc == 0u) { xcd_barrier_complete(bar, b.x, nloc, nx); b.st[0] = nloc; b.st[1] = nx; }
        const unsigned old = xb_add(&bar[XB_XSUB(b.x)], 1u);
        const unsigned gen = old / nloc;
        if (old + 1u == (gen + 1u) * nloc) {
            __builtin_amdgcn_fence(__ATOMIC_RELEASE, "agent");
            asm volatile("s_waitcnt vmcnt(0)" ::: "memory");
            const unsigned og = xb_add(&bar[XB_TOP], 1u);
            const unsigned tg = og / nx;
            if (og + 1u == (tg + 1u) * nx) xb_add(&bar[XB_TOPGEN], 1u);
            else XB_SPIN(xb_ld(&bar[XB_TOPGEN]) == tg, bar);
            __builtin_amdgcn_fence(__ATOMIC_ACQUIRE, "agent");
            xb_add(&bar[XB_XGEN(b.x)], 1u);
            asm volatile("s_waitcnt vmcnt(0)" ::: "memory");
        } else {
            XB_SPIN(xb_ld(&bar[XB_XGEN(b.x)]) == gen, bar);
            __builtin_amdgcn_fence(__ATOMIC_ACQUIRE, "agent");
            asm volatile("s_waitcnt vmcnt(0)" ::: "memory");
        }
    }
    __syncthreads();
}


using pg8::bf16_t; using pg8::bf16x8; using pg8::f32x4; using pg8::u32x4; using pg8::u32x2; using pg8::Unit; using pg8::cvt_pk_bf16;

constexpr int NTOK = 20480, NCTX = 4096, DM = 1024, DFF = 2816, DRW = 512, DZ = 1920, NMOD = 9216;
constexpr int LDS_BYTES = 157440 + 16;
constexpr size_t WS_MOD = 0, WS_BONUS = 262144, WS_W2T = 1572864, WS_A2T = 1703936, WS_G2T = 1835008, WS_DCTX = 1966080, WS_WOUT = 2228224,
    WS_EARLY = 4325376, WS_W1GU = WS_EARLY, WS_W1D = WS_W1GU + 11534336, WS_WZ = WS_W1D + 5767168, WS_WF = WS_WZ + 4194304, WS_Y1 = WS_EARLY,
    WS_H = 27918336, WS_BIG = 69861376, WS_Z = WS_BIG, WS_PT = WS_Z + 78643200, WS_DLAT = WS_PT + 41943040, WS_ACT = WS_BIG,
    WS_W2GU = WS_DLAT, WS_W2D = WS_W2GU + 11534336, WS_BAR = WS_DLAT + 67108864, WS_SEG = WS_BAR + 16384, WS_SSQ = WS_SEG + 6291456, WS_CBW = WS_SSQ + 1310720, WS_CBG = WS_CBW + 61440, WS_GP = WS_CBG + 112640, WS_END = WS_GP + 40960,
    WS_XG3 = WS_DLAT + 20971520;
static_assert(WS_WF + 2097152 <= WS_H && WS_ACT + (size_t)NTOK * DFF * 2 <= WS_DLAT && WS_END <= 268435456, "workspace map");

struct Params { const float* in[26]; float* out; unsigned char* ws; };
enum { I_XP = 0, I_XS, I_SF, I_SB, I_C, I_CCTX, I_WMOD, I_BMOD, I_NORMG, I_WG, I_WU, I_WD, I_WIN, I_MU, I_W0, I_W2, I_A0, I_A2, I_G2, I_KK, I_KA, I_RK, I_LNW, I_LNB, I_WOUT, I_FN };

__device__ __forceinline__ float bf2f(bf16_t v) { return __uint_as_float(((unsigned)v) << 16); }
__device__ __forceinline__ bf16_t f2bf(float f) { unsigned u = __float_as_uint(f); u += 0x7FFFu + ((u >> 16) & 1u); return (bf16_t)(u >> 16); }
__device__ __forceinline__ float sigm(float x) { return __builtin_amdgcn_rcpf(1.0f + __expf(-x)); }
__device__ __forceinline__ float wave_sum(float x) {
#pragma unroll
    for (int o = 32; o > 0; o >>= 1) x += __shfl_xor(x, o);
    return x;
}
template <int CTRL> __device__ __forceinline__ float dpp_mov(float x) { return __int_as_float(__builtin_amdgcn_update_dpp(0, __float_as_int(x), CTRL, 0xF, 0xF, true)); }
__device__ __forceinline__ float red16(float x) { x += dpp_mov<0xB1>(x); x += dpp_mov<0x4E>(x); x += dpp_mov<0x141>(x); x += dpp_mov<0x140>(x); return x; }

__device__ __forceinline__ float zshift(const bf16_t* __restrict__ Z, int tb, int t, int S, bool grid, int col, float mu) {
    const float z0 = bf2f(Z[(size_t)(tb + t) * DZ + col]);
    const int d = col & 3; int tn; bool ok;
    if (!grid) { if (d & 1) { tn = t + 1; ok = tn < S; } else { tn = t - 1; ok = tn >= 0; } }
    else { if (d == 0) { tn = t - 1; ok = (t & 63) != 0; } else if (d == 1) { tn = t + 1; ok = (t & 63) != 63; } else if (d == 2) { tn = t - 64; ok = t >= 64; } else { tn = t + 64; ok = t < S - 64; } }
    const float zn = ok ? bf2f(Z[(size_t)(tb + tn) * DZ + col]) : 0.0f;
    return z0 + mu * (zn - z0);
}

struct SchedPlain { const char* A; const char* B; int nM, nN, K, G, c;
    __device__ __forceinline__ bool next(int i, Unit& u) const { const long L = (long)i * G + c; if (L >= (long)nM * nN) return false;
        pg8::tile_of((int)L, nM, nN, u.pm, u.pn); u.kind = 0; u.aux = 0; u.a = A + (size_t)u.pm * 512 * K; u.b = B + (size_t)u.pn * 512 * K; return true; } };
struct SchedSplitK { const char* A; const char* B; int nM, nN, K, KS, G, c;
    __device__ __forceinline__ bool next(int i, Unit& u) const { const long L = (long)i * G + c; if (L >= (long)nM * nN * KS) return false;
        const int kh = (int)(L % KS); pg8::tile_of((int)(L / KS), nM, nN, u.pm, u.pn); u.kind = 0; u.aux = kh;
        u.a = A + (size_t)u.pm * 512 * K + (size_t)kh * (K / KS) * 2; u.b = B + (size_t)u.pn * 512 * K + (size_t)kh * (K / KS) * 2; return true; } };
struct SchedWin { const char* H; const char* WZ; const char* WF; int G, c;
    __device__ __forceinline__ bool next(int i, Unit& u) const { const long L = (long)i * G + c; if (L >= 960) return false;
        if (L < 640) { pg8::tile_of((int)L, 80, 8, u.pm, u.pn); u.kind = 0; u.a = H + (size_t)u.pm * 524288; u.b = WZ + (size_t)u.pn * 524288; }
        else { pg8::tile_of((int)L - 640, 4, 80, u.pm, u.pn); u.kind = 1; u.a = WF + (size_t)u.pm * 524288; u.b = H + (size_t)u.pn * 524288; }
        u.aux = 0; return true; } };
struct SchedFourLat { const char* D; const char* PT; int G, c;
    __device__ __forceinline__ bool next(int i, Unit& u) const { const long L = (long)i * G + c; if (L >= 128) return false;
        const int b = (int)L >> 5, r = (int)L & 31; u.pm = r & 15; u.pn = r >> 4; u.kind = 0; u.aux = NCTX + b * 4096;
        u.a = D + (size_t)u.pm * 256 * 8192 * 2; u.b = PT + ((size_t)b * 512 + u.pn * 256) * 8192 * 2; return true; } };
struct SchedFourCtx { const char* D; const char* PT; int G, c;
    __device__ __forceinline__ bool next(int i, Unit& u) const { const long L = (long)i * G + c; if (L >= 32) return false;
        const int b = (int)L >> 1; u.pm = 0; u.pn = (int)L & 1; u.kind = 0; u.aux = b * 256;
        u.a = D; u.b = PT + ((size_t)b * 512 + u.pn * 256) * 512 * 2; return true; } };

struct EpiGU {
    static constexpr bool PERM = true; bf16_t* ACT;
    __device__ __forceinline__ void operator()(const f32x4 (&acc)[2][2][4][2], const Unit& u, int wr, int wc, int fr, int fq) const {
        const int row0 = u.pm * 256 + wr * 64 + fr, col0 = u.pn * 128 + wc * 32 + fq * 8;
#pragma unroll
        for (int ai = 0; ai < 2; ++ai)
#pragma unroll
            for (int m = 0; m < 4; ++m) {
                float o[8];
#pragma unroll
                for (int n = 0; n < 2; ++n)
#pragma unroll
                    for (int j = 0; j < 4; ++j) { const float g = acc[ai][0][m][n][j], uu = acc[ai][1][m][n][j]; o[n * 4 + j] = g * sigm(g) * uu; }
                u32x4 w; w.x = cvt_pk_bf16(o[0], o[1]); w.y = cvt_pk_bf16(o[2], o[3]); w.z = cvt_pk_bf16(o[4], o[5]); w.w = cvt_pk_bf16(o[6], o[7]);
                *(u32x4*)(ACT + (size_t)(row0 + ai * 128 + m * 16) * DFF + col0) = w;
            }
    }
};
struct EpiRes {
    static constexpr bool PERM = true; const float* xa; const float* xb; float* out; const float* mod; int goff; float scale;
    __device__ __forceinline__ void operator()(const f32x4 (&acc)[2][2][4][2], const Unit& u, int wr, int wc, int fr, int fq) const {
        const int mi = u.pm < 16 ? 0 : 1 + ((u.pm - 16) >> 4);
        const int row0 = u.pm * 256 + wr * 64 + fr, col0 = u.pn * 256 + wc * 32 + fq * 8;
        f32x4 gv[2][2];
#pragma unroll
        for (int bj = 0; bj < 2; ++bj)
#pragma unroll
            for (int n = 0; n < 2; ++n) gv[bj][n] = *(const f32x4*)(mod + mi * NMOD + goff + col0 + bj * 128 + n * 4) * scale;
        const bool lo = (u.pm * 256) < NCTX;
        const float* sbase = (lo ? xa + (size_t)row0 * DM : xb + (size_t)(row0 - NCTX) * DM) + col0;
        float* obase = out + (size_t)row0 * DM + col0;
        f32x4 xv[2][2], nx[2][2];
#pragma unroll
        for (int bj = 0; bj < 2; ++bj)
#pragma unroll
            for (int n = 0; n < 2; ++n) xv[bj][n] = *(const f32x4*)(sbase + bj * 128 + n * 4);
#pragma unroll
        for (int r = 0; r < 8; ++r) {
            const int ai = r >> 2, m = r & 3;
            if (r < 7) { const int r1 = r + 1; const float* sp = sbase + (size_t)((r1 >> 2) * 128 + (r1 & 3) * 16) * DM;
#pragma unroll
                for (int bj = 0; bj < 2; ++bj)
#pragma unroll
                    for (int n = 0; n < 2; ++n) nx[bj][n] = *(const f32x4*)(sp + bj * 128 + n * 4); }
            float* op = obase + (size_t)(ai * 128 + m * 16) * DM;
#pragma unroll
            for (int bj = 0; bj < 2; ++bj)
#pragma unroll
                for (int n = 0; n < 2; ++n) *(f32x4*)(op + bj * 128 + n * 4) = xv[bj][n] + gv[bj][n] * acc[ai][bj][m][n];
#pragma unroll
            for (int bj = 0; bj < 2; ++bj)
#pragma unroll
                for (int n = 0; n < 2; ++n) xv[bj][n] = nx[bj][n];
        }
    }
};
struct SchedFourSym { const char* D; const char* PT; int pair;
    __device__ __forceinline__ bool next(int i, Unit& u) const { if (pair >= 64 || i >= 2) return false;
        const int b = pair >> 4; u.pm = pair & 7; u.pn = (pair >> 3) & 1; u.kind = 2 + i; u.aux = NCTX + b * 4096;
        u.a = D + (size_t)u.pm * 256 * 8192 * 2 + (size_t)i * 8192; u.b = PT + ((size_t)b * 512 + u.pn * 256) * 8192 * 2 + (size_t)i * 8192; return true; } };
struct EpiFourSym {
    static constexpr bool PERM = true; bf16_t* MIX; float scale;
    __device__ __forceinline__ void operator()(const f32x4 (&acc)[2][2][4][2], const Unit& u, int wr, int wc, int fr, int fq) const {
        const int s0 = u.pm * 256 + wr * 64 + fr, col0 = u.pn * 256 + wc * 32 + fq * 8;
        if (u.kind == 2) {
#pragma unroll
            for (int ai = 0; ai < 2; ++ai)
#pragma unroll
                for (int m = 0; m < 4; ++m) { const int sp = s0 + ai * 128 + m * 16;
                    if (sp > 0) { bf16_t* mp = MIX + (size_t)(u.aux + 4096 - sp) * DM + col0;
#pragma unroll
                        for (int bj = 0; bj < 2; ++bj) { const f32x4 v0 = acc[ai][bj][m][0] * scale, v1 = acc[ai][bj][m][1] * scale;
                            u32x4 w; w.x = cvt_pk_bf16(v0[0], v0[1]); w.y = cvt_pk_bf16(v0[2], v0[3]); w.z = cvt_pk_bf16(v1[0], v1[1]); w.w = cvt_pk_bf16(v1[2], v1[3]);
                            *(u32x4*)(mp + bj * 128) = w; } } }
        } else {
            u32x4 yc[2][4][2];
#pragma unroll
            for (int ai = 0; ai < 2; ++ai)
#pragma unroll
                for (int m = 0; m < 4; ++m) { const int sp = s0 + ai * 128 + m * 16; const bf16_t* mp = MIX + (size_t)(u.aux + (sp > 0 ? 4096 - sp : 0)) * DM + col0;
#pragma unroll
                    for (int bj = 0; bj < 2; ++bj) yc[ai][m][bj] = *(const u32x4*)(mp + bj * 128); }
#pragma unroll
            for (int ai = 0; ai < 2; ++ai)
#pragma unroll
                for (int m = 0; m < 4; ++m) { const int sp = s0 + ai * 128 + m * 16; bf16_t* yp = MIX + (size_t)(u.aux + sp) * DM + col0; bf16_t* mp = MIX + (size_t)(u.aux + 4096 - sp) * DM + col0;
#pragma unroll
                    for (int bj = 0; bj < 2; ++bj) { const f32x4 v0 = acc[ai][bj][m][0] * scale, v1 = acc[ai][bj][m][1] * scale; const u32x4 c = yc[ai][m][bj];
                        u32x4 w; w.x = cvt_pk_bf16(v0[0], v0[1]); w.y = cvt_pk_bf16(v0[2], v0[3]); w.z = cvt_pk_bf16(v1[0], v1[1]); w.w = cvt_pk_bf16(v1[2], v1[3]);
                        *(u32x4*)(yp + bj * 128) = w;
                        if (sp > 0) { u32x4 x;
                            x.x = cvt_pk_bf16(2.0f * __uint_as_float(c.x << 16) - v0[0], 2.0f * __uint_as_float(c.x & 0xFFFF0000u) - v0[1]);
                            x.y = cvt_pk_bf16(2.0f * __uint_as_float(c.y << 16) - v0[2], 2.0f * __uint_as_float(c.y & 0xFFFF0000u) - v0[3]);
                            x.z = cvt_pk_bf16(2.0f * __uint_as_float(c.z << 16) - v1[0], 2.0f * __uint_as_float(c.z & 0xFFFF0000u) - v1[1]);
                            x.w = cvt_pk_bf16(2.0f * __uint_as_float(c.w << 16) - v1[2], 2.0f * __uint_as_float(c.w & 0xFFFF0000u) - v1[3]);
                            *(u32x4*)(mp + bj * 128) = x; } } }
        }
    }
};
__device__ __forceinline__ void fourier_nyquist(const bf16_t* PTlat, bf16_t* MIX, float scale) {
    const int lane = threadIdx.x & 63, gw = blockIdx.x * 8 + (threadIdx.x >> 6), nw = gridDim.x * 8;
    for (int r = gw; r < 2048; r += nw) { const int b = r >> 9, ch = r & 511; const bf16_t* row = PTlat + ((size_t)b * 512 + ch) * 8192;
        float sm = 0.f;
#pragma unroll
        for (int i = 0; i < 8; ++i) { const u32x4 v = *(const u32x4*)(row + (i * 64 + lane) * 8);
            sm += (__uint_as_float(v.x << 16) - __uint_as_float(v.x & 0xFFFF0000u)) + (__uint_as_float(v.y << 16) - __uint_as_float(v.y & 0xFFFF0000u))
                + (__uint_as_float(v.z << 16) - __uint_as_float(v.z & 0xFFFF0000u)) + (__uint_as_float(v.w << 16) - __uint_as_float(v.w & 0xFFFF0000u)); }
        sm = wave_sum(sm);
        if (lane == 0) MIX[(size_t)(NCTX + b * 4096 + 2048) * DM + ch] = f2bf(sm * scale); }
}
struct EpiResB16 {
    static constexpr bool PERM = true; const float* xa; const float* xb; bf16_t* X3; const float* mod; int goff; float scale;
    __device__ __forceinline__ void operator()(const f32x4 (&acc)[2][2][4][2], const Unit& u, int wr, int wc, int fr, int fq) const {
        const int mi = u.pm < 16 ? 0 : 1 + ((u.pm - 16) >> 4);
        const int row0 = u.pm * 256 + wr * 64 + fr, col0 = u.pn * 256 + wc * 32 + fq * 8;
        f32x4 gv[2][2];
#pragma unroll
        for (int bj = 0; bj < 2; ++bj)
#pragma unroll
            for (int n = 0; n < 2; ++n) gv[bj][n] = *(const f32x4*)(mod + mi * NMOD + goff + col0 + bj * 128 + n * 4) * scale;
        const bool lo = (u.pm * 256) < NCTX;
        const float* sbase = (lo ? xa + (size_t)row0 * DM : xb + (size_t)(row0 - NCTX) * DM) + col0;
        bf16_t* obase = X3 + (size_t)row0 * DM + col0;
        f32x4 xv[2][2], nx[2][2];
#pragma unroll
        for (int bj = 0; bj < 2; ++bj)
#pragma unroll
            for (int n = 0; n < 2; ++n) xv[bj][n] = *(const f32x4*)(sbase + bj * 128 + n * 4);
#pragma unroll
        for (int r = 0; r < 8; ++r) {
            const int ai = r >> 2, m = r & 3;
            if (r < 7) { const int r1 = r + 1; const float* sp = sbase + (size_t)((r1 >> 2) * 128 + (r1 & 3) * 16) * DM;
#pragma unroll
                for (int bj = 0; bj < 2; ++bj)
#pragma unroll
                    for (int n = 0; n < 2; ++n) nx[bj][n] = *(const f32x4*)(sp + bj * 128 + n * 4); }
            bf16_t* op = obase + (size_t)(ai * 128 + m * 16) * DM;
#pragma unroll
            for (int bj = 0; bj < 2; ++bj) { const f32x4 v0 = xv[bj][0] + gv[bj][0] * acc[ai][bj][m][0], v1 = xv[bj][1] + gv[bj][1] * acc[ai][bj][m][1];
                u32x4 w; w.x = cvt_pk_bf16(v0[0], v0[1]); w.y = cvt_pk_bf16(v0[2], v0[3]); w.z = cvt_pk_bf16(v1[0], v1[1]); w.w = cvt_pk_bf16(v1[2], v1[3]);
                *(u32x4*)(op + bj * 128) = w; }
#pragma unroll
            for (int bj = 0; bj < 2; ++bj)
#pragma unroll
                for (int n = 0; n < 2; ++n) xv[bj][n] = nx[bj][n];
        }
    }
};
struct EpiResAtomic {
    static constexpr bool PERM = true; float* out; const float* mod; int goff; float scale;
    __device__ __forceinline__ void operator()(const f32x4 (&acc)[2][2][4][2], const Unit& u, int wr, int wc, int fr, int fq) const {
        const int mi = u.pm < 16 ? 0 : 1 + ((u.pm - 16) >> 4);
        const int row0 = u.pm * 256 + wr * 64 + fr, col0 = u.pn * 256 + wc * 32 + fq * 8;
        f32x4 gv[2][2];
#pragma unroll
        for (int bj = 0; bj < 2; ++bj)
#pragma unroll
            for (int n = 0; n < 2; ++n) gv[bj][n] = *(const f32x4*)(mod + mi * NMOD + goff + col0 + bj * 128 + n * 4) * scale;
#pragma unroll
        for (int ai = 0; ai < 2; ++ai)
#pragma unroll
            for (int m = 0; m < 4; ++m) {
                float* op = out + (size_t)(row0 + ai * 128 + m * 16) * DM + col0;
#pragma unroll
                for (int bj = 0; bj < 2; ++bj)
#pragma unroll
                    for (int n = 0; n < 2; ++n) { const f32x4 v = gv[bj][n] * acc[ai][bj][m][n];
#pragma unroll
                        for (int j = 0; j < 4; ++j) unsafeAtomicAdd(op + bj * 128 + n * 4 + j, v[j]); }
            }
    }
};
__device__ __forceinline__ float row_rs(const float* SSQ, int row) {
    const f32x4 a = *(const f32x4*)(SSQ + (size_t)row * 16), b = *(const f32x4*)(SSQ + (size_t)row * 16 + 4), c = *(const f32x4*)(SSQ + (size_t)row * 16 + 8), d = *(const f32x4*)(SSQ + (size_t)row * 16 + 12);
    const f32x4 t = (a + b) + (c + d); return rsqrtf(((t[0] + t[1]) + (t[2] + t[3])) * (1.0f / 1024.0f) + 1e-6f);
}
struct EpiResN {
    static constexpr bool PERM = true; const float* xa; const float* xb; float* out; unsigned char* ws; int goff; float scale; int which;
    __device__ __forceinline__ void operator()(const f32x4 (&acc)[2][2][4][2], const Unit& u, int wr, int wc, int fr, int fq) const {
        const float* mod = (const float*)(ws + WS_MOD); const float* GP = (const float*)(ws + WS_GP) + which * 5120; bf16_t* XG = (bf16_t*)(ws + (which ? WS_XG3 : WS_H)); float* SSQ = (float*)(ws + WS_SSQ);
        const int mi = u.pm < 16 ? 0 : 1 + ((u.pm - 16) >> 4);
        const int row0 = u.pm * 256 + wr * 64 + fr, col0 = u.pn * 256 + wc * 32 + fq * 8;
        f32x4 gv[2][2], gp[2][2];
#pragma unroll
        for (int bj = 0; bj < 2; ++bj)
#pragma unroll
            for (int n = 0; n < 2; ++n) { gv[bj][n] = *(const f32x4*)(mod + mi * NMOD + goff + col0 + bj * 128 + n * 4) * scale; gp[bj][n] = *(const f32x4*)(GP + mi * 1024 + col0 + bj * 128 + n * 4); }
        const bool lo = (u.pm * 256) < NCTX;
        const float* sbase = (lo ? xa + (size_t)row0 * DM : xb + (size_t)(row0 - NCTX) * DM) + col0;
        float* obase = out + (size_t)row0 * DM + col0; bf16_t* xbase = XG + (size_t)row0 * DM + col0;
#pragma unroll
        for (int rp = 0; rp < 4; ++rp) {
            unsigned ro[2]; f32x4 xv[2][2][2];
#pragma unroll
            for (int h2 = 0; h2 < 2; ++h2) { const int r = rp * 2 + h2; ro[h2] = (unsigned)((r >> 2) * 128 + (r & 3) * 16) * DM; asm volatile("" : "+v"(ro[h2]));
#pragma unroll
                for (int bj = 0; bj < 2; ++bj)
#pragma unroll
                    for (int n = 0; n < 2; ++n) xv[h2][bj][n] = *(const f32x4*)(sbase + ro[h2] + bj * 128 + n * 4); }
#pragma unroll
            for (int h2 = 0; h2 < 2; ++h2) { const int r = rp * 2 + h2, ai = r >> 2, m = r & 3;
                float ss = 0.f;
#pragma unroll
                for (int bj = 0; bj < 2; ++bj) {
                    const f32x4 v0 = xv[h2][bj][0] + gv[bj][0] * acc[ai][bj][m][0], v1 = xv[h2][bj][1] + gv[bj][1] * acc[ai][bj][m][1];
                    *(f32x4*)(obase + ro[h2] + bj * 128) = v0; *(f32x4*)(obase + ro[h2] + bj * 128 + 4) = v1;
                    ss += (v0[0] * v0[0] + v0[1] * v0[1]) + (v0[2] * v0[2] + v0[3] * v0[3]) + (v1[0] * v1[0] + v1[1] * v1[1]) + (v1[2] * v1[2] + v1[3] * v1[3]);
                    const f32x4 y0 = v0 * gp[bj][0], y1 = v1 * gp[bj][1];
                    u32x4 w; w.x = cvt_pk_bf16(y0[0], y0[1]); w.y = cvt_pk_bf16(y0[2], y0[3]); w.z = cvt_pk_bf16(y1[0], y1[1]); w.w = cvt_pk_bf16(y1[2], y1[3]);
                    *(u32x4*)(xbase + ro[h2] + bj * 128) = w;
                }
                ss += __shfl_xor(ss, 16); ss += __shfl_xor(ss, 32);
                if (fq == 0) SSQ[(size_t)(row0 + ai * 128 + m * 16) * 16 + u.pn * 4 + wc] = ss; }
        }
    }
};
struct EpiGUN {
    static constexpr bool PERM = true; bf16_t* ACT; const float* SSQ; const float* CB;
    __device__ __forceinline__ void operator()(const f32x4 (&acc)[2][2][4][2], const Unit& u, int wr, int wc, int fr, int fq) const {
        const int mi = u.pm < 16 ? 0 : 1 + ((u.pm - 16) >> 4);
        const int row0 = u.pm * 256 + wr * 64 + fr, col0 = u.pn * 128 + wc * 32 + fq * 8;
        const float* cb = CB + mi * 5632 + u.pn * 256 + wc * 32 + fq * 8;
        const f32x4 cg0 = *(const f32x4*)cb, cg1 = *(const f32x4*)(cb + 4), cu0 = *(const f32x4*)(cb + 128), cu1 = *(const f32x4*)(cb + 132);
        const int laneL = fr + 16 * fq, rowW = u.pm * 256 + wr * 64;
        const float my0 = row_rs(SSQ, rowW + laneL), my1 = row_rs(SSQ, rowW + 128 + laneL);
        float rs[8];
#pragma unroll
        for (int m = 0; m < 4; ++m) { rs[m] = __shfl(my0, m * 16 + fr); rs[4 + m] = __shfl(my1, m * 16 + fr); }
#pragma unroll
        for (int ai = 0; ai < 2; ++ai)
#pragma unroll
            for (int m = 0; m < 4; ++m) {
                int row = row0 + ai * 128 + m * 16; asm volatile("" : "+v"(row)); const float rr = rs[ai * 4 + m];
                const f32x4 g0 = acc[ai][0][m][0] * rr + cg0, g1 = acc[ai][0][m][1] * rr + cg1, u0 = acc[ai][1][m][0] * rr + cu0, u1 = acc[ai][1][m][1] * rr + cu1;
                float o[8];
#pragma unroll
                for (int j = 0; j < 4; ++j) { o[j] = g0[j] * sigm(g0[j]) * u0[j]; o[4 + j] = g1[j] * sigm(g1[j]) * u1[j]; }
                u32x4 w; w.x = cvt_pk_bf16(o[0], o[1]); w.y = cvt_pk_bf16(o[2], o[3]); w.z = cvt_pk_bf16(o[4], o[5]); w.w = cvt_pk_bf16(o[6], o[7]);
                *(u32x4*)(ACT + (size_t)row * DFF + col0) = w;
            }
    }
};
struct EpiWinN {
    static constexpr bool PERM = true; bf16_t* Z; bf16_t* PT; const float* SSQ; const float* CB;
    __device__ __forceinline__ void operator()(const f32x4 (&acc)[2][2][4][2], const Unit& u, int wr, int wc, int fr, int fq) const {
        const int row0 = u.pm * 256 + wr * 64 + fr, cin = wc * 32 + fq * 8;
        if (u.kind == 0) {
            const int mi = u.pm < 16 ? 0 : 1 + ((u.pm - 16) >> 4);
            const float* cb = CB + mi * 3072 + u.pn * 256 + cin;
            f32x4 cv[2][2];
#pragma unroll
            for (int bj = 0; bj < 2; ++bj)
#pragma unroll
                for (int n = 0; n < 2; ++n) cv[bj][n] = *(const f32x4*)(cb + bj * 128 + n * 4);
            const int laneL = fr + 16 * fq, rowW = u.pm * 256 + wr * 64;
            const float my0 = row_rs(SSQ, rowW + laneL), my1 = row_rs(SSQ, rowW + 128 + laneL);
            float rs8[8];
#pragma unroll
            for (int m = 0; m < 4; ++m) { rs8[m] = __shfl(my0, m * 16 + fr); rs8[4 + m] = __shfl(my1, m * 16 + fr); }
#pragma unroll
            for (int ai = 0; ai < 2; ++ai)
#pragma unroll
                for (int m = 0; m < 4; ++m) {
                    const int row = row0 + ai * 128 + m * 16; const float rs = rs8[ai * 4 + m];
#pragma unroll
                    for (int bj = 0; bj < 2; ++bj) { const int col = u.pn * 256 + bj * 128 + cin;
                        const f32x4 v0 = acc[ai][bj][m][0] * rs + cv[bj][0], v1 = acc[ai][bj][m][1] * rs + cv[bj][1];
                        u32x4 w; w.x = cvt_pk_bf16(v0[0], v0[1]); w.y = cvt_pk_bf16(v0[2], v0[3]); w.z = cvt_pk_bf16(v1[0], v1[1]); w.w = cvt_pk_bf16(v1[2], v1[3]);
                        if (col < DZ) *(u32x4*)(Z + (size_t)row * DZ + col) = w; }
                }
        } else {
            const int mi = u.pn < 16 ? 0 : 1 + ((u.pn - 16) >> 4);
            const int lane_ = fr + 16 * fq;
            const float myrs = row_rs(SSQ, u.pn * 256 + (lane_ >> 5) * 128 + wc * 32 + (lane_ & 31));
            float rs[2][8];
#pragma unroll
            for (int bj = 0; bj < 2; ++bj)
#pragma unroll
                for (int e = 0; e < 8; ++e) rs[bj][e] = __shfl(myrs, bj * 32 + fq * 8 + e);
            float cb8[8];
#pragma unroll
            for (int r = 0; r < 8; ++r) cb8[r] = CB[mi * 3072 + 2048 + row0 + (r >> 2) * 128 + (r & 3) * 16];
#pragma unroll
            for (int ai = 0; ai < 2; ++ai)
#pragma unroll
                for (int m = 0; m < 4; ++m) {
                    const int row = row0 + ai * 128 + m * 16, part = row >> 9, ch = row & 511; const float cbv = cb8[ai * 4 + m];
#pragma unroll
                    for (int bj = 0; bj < 2; ++bj) {
                        const f32x4 a0 = acc[ai][bj][m][0], a1 = acc[ai][bj][m][1];
                        u32x4 w; w.x = cvt_pk_bf16(a0[0] * rs[bj][0] + cbv, a0[1] * rs[bj][1] + cbv); w.y = cvt_pk_bf16(a0[2] * rs[bj][2] + cbv, a0[3] * rs[bj][3] + cbv);
                        w.z = cvt_pk_bf16(a1[0] * rs[bj][4] + cbv, a1[1] * rs[bj][5] + cbv); w.w = cvt_pk_bf16(a1[2] * rs[bj][6] + cbv, a1[3] * rs[bj][7] + cbv);
                        const int ct = bj * 128 + cin; bf16_t* dst;
                        if (u.pn < 16) dst = PT + (((size_t)u.pn * 512 + ch) * 2 + part) * 256 + ct;
                        else { const int lt = u.pn - 16, bb = lt >> 4, s0 = (lt & 15) * 256; dst = PT + 4194304 + (((size_t)bb * 512 + ch) * 2 + part) * 4096 + s0 + ct; }
                        *(u32x4*)dst = w; }
                }
        }
    }
};
struct EpiWin {
    static constexpr bool PERM = true; bf16_t* Z; bf16_t* PT;
    __device__ __forceinline__ void operator()(const f32x4 (&acc)[2][2][4][2], const Unit& u, int wr, int wc, int fr, int fq) const {
        const int row0 = u.pm * 256 + wr * 64 + fr, cin = wc * 32 + fq * 8;
#pragma unroll
        for (int ai = 0; ai < 2; ++ai)
#pragma unroll
            for (int m = 0; m < 4; ++m) {
                const int row = row0 + ai * 128 + m * 16;
#pragma unroll
                for (int bj = 0; bj < 2; ++bj) {
                    const f32x4 v0 = acc[ai][bj][m][0], v1 = acc[ai][bj][m][1];
                    u32x4 w; w.x = cvt_pk_bf16(v0[0], v0[1]); w.y = cvt_pk_bf16(v0[2], v0[3]); w.z = cvt_pk_bf16(v1[0], v1[1]); w.w = cvt_pk_bf16(v1[2], v1[3]);
                    const int ct = bj * 128 + cin;
                    if (u.kind == 0) { const int col = u.pn * 256 + ct; if (col < DZ) *(u32x4*)(Z + (size_t)row * DZ + col) = w; }
                    else { const int part = row >> 9, ch = row & 511; bf16_t* dst;
                        if (u.pn < 16) dst = PT + (((size_t)u.pn * 512 + ch) * 2 + part) * 256 + ct;
                        else { const int lt = u.pn - 16, bb = lt >> 4, s0 = (lt & 15) * 256; dst = PT + 4194304 + (((size_t)bb * 512 + ch) * 2 + part) * 4096 + s0 + ct; }
                        *(u32x4*)dst = w; }
                }
            }
    }
};
struct EpiFour {
    static constexpr bool PERM = true; bf16_t* MIX; float scale;
    __device__ __forceinline__ void operator()(const f32x4 (&acc)[2][2][4][2], const Unit& u, int wr, int wc, int fr, int fq) const {
        const int row0 = u.aux + u.pm * 256 + wr * 64 + fr, col0 = u.pn * 256 + wc * 32 + fq * 8;
#pragma unroll
        for (int ai = 0; ai < 2; ++ai)
#pragma unroll
            for (int m = 0; m < 4; ++m)
#pragma unroll
                for (int bj = 0; bj < 2; ++bj) {
                    const f32x4 v0 = acc[ai][bj][m][0] * scale, v1 = acc[ai][bj][m][1] * scale;
                    u32x4 w; w.x = cvt_pk_bf16(v0[0], v0[1]); w.y = cvt_pk_bf16(v0[2], v0[3]); w.z = cvt_pk_bf16(v1[0], v1[1]); w.w = cvt_pk_bf16(v1[2], v1[3]);
                    *(u32x4*)(MIX + (size_t)(row0 + ai * 128 + m * 16) * DM + col0 + bj * 128) = w;
                }
    }
};

__device__ __forceinline__ void tconv_load(const float* __restrict__ src, int ld, int k0, int n0, float* tile) {
    const int tid = threadIdx.x;
#pragma unroll
    for (int r = 0; r < 2; ++r) { const int idx = tid + 512 * r, i = idx >> 4, j4 = idx & 15; const float4 v = *(const float4*)(src + (size_t)(k0 + i) * ld + n0 + 4 * j4);
        float* t = tile + i * 65 + 4 * j4; t[0] = v.x; t[1] = v.y; t[2] = v.z; t[3] = v.w; }
}
__device__ __forceinline__ void tconv_tile(const float* __restrict__ src, int ld, int k0, int n0, bf16_t* __restrict__ dst, int ldd, int drow0, float* tile) {
    const int tid = threadIdx.x;
    tconv_load(src, ld, k0, n0, tile);
    __syncthreads();
    { const int j = tid >> 3, ic = tid & 7; const float* t = tile + (ic * 8) * 65 + j; u32x4 w;
      w.x = cvt_pk_bf16(t[0], t[65]); w.y = cvt_pk_bf16(t[130], t[195]); w.z = cvt_pk_bf16(t[260], t[325]); w.w = cvt_pk_bf16(t[390], t[455]);
      *(u32x4*)(dst + (size_t)(drow0 + j) * ldd + k0 + ic * 8) = w; }
    __syncthreads();
}
__device__ __forceinline__ void ffn_conv(const float* wg, const float* wu, const float* wd, bf16_t* WGU, bf16_t* WD, float* tile, int bid, int nb) {
    for (int t = bid; t < 2112; t += nb) {
        int u = t;
        if (u < 1408) { const bool up = u >= 704; if (up) u -= 704; const int k0 = (u / 44) * 64, n0 = (u % 44) * 64;
            tconv_tile(up ? wu : wg, DFF, k0, n0, WGU, DM, (n0 >> 7) * 256 + (n0 & 127) + (up ? 128 : 0), tile); }
        else { u -= 1408; const int k0 = (u >> 4) * 64, n0 = (u & 15) * 64; tconv_tile(wd, DM, k0, n0, WD, DFF, n0, tile); }
    }
}

__device__ __forceinline__ void phase0(const Params& p, unsigned char* lds) {
    float* tile = (float*)lds; float* cos64 = (float*)(lds + 16640); float* T = (float*)(lds + 16896); float* sil = (float*)(lds + 33280); float* red = (float*)(lds + 53760);
    const int tid = threadIdx.x, bid = blockIdx.x, nb = gridDim.x;
    unsigned char* ws = p.ws;
    for (int i = tid; i < 4096; i += 512) T[i] = cospif((float)i * (1.0f / 2048.0f));
    if (tid < 64) cos64[tid] = cospif((float)tid * (1.0f / 32.0f));
    for (int i = tid; i < 5120; i += 512) { const int r = i >> 10, k = i & 1023; const float c = r == 0 ? p.in[I_CCTX][k] : p.in[I_C][(r - 1) * 1024 + k]; sil[i] = c * sigm(c); }
    __syncthreads();
    for (int it = bid; it < 288; it += nb) {
        const int jj = tid & 31, kg = tid >> 5, j = it * 32 + jj; const float* wp = p.in[I_WMOD] + (size_t)(kg * 64) * NMOD + j; const float* sp = sil + kg * 64;
        float a0 = 0.f, a1 = 0.f, a2 = 0.f, a3 = 0.f, a4 = 0.f;
#pragma unroll 32
        for (int k = 0; k < 64; ++k) { const float w = wp[(size_t)k * NMOD]; a0 += sp[k] * w; a1 += sp[1024 + k] * w; a2 += sp[2048 + k] * w; a3 += sp[3072 + k] * w; a4 += sp[4096 + k] * w; }
        float* rp = red + kg * 160 + jj; rp[0] = a0; rp[32] = a1; rp[64] = a2; rp[96] = a3; rp[128] = a4;
        __syncthreads();
        if (tid < 160) { float s = 0.f;
#pragma unroll
            for (int g = 0; g < 16; ++g) s += red[g * 160 + tid];
            const int i = tid >> 5; ((float*)(ws + WS_MOD))[i * NMOD + it * 32 + (tid & 31)] = s + p.in[I_BMOD][it * 32 + (tid & 31)]; }
        __syncthreads();
    }
}
__device__ __forceinline__ void phase0b(const Params& p, unsigned char* lds, const int bid, const int nb) {
    float* tile = (float*)lds; float* cos64 = (float*)(lds + 16640); float* T = (float*)(lds + 16896);
    const int tid = threadIdx.x;
    unsigned char* ws = p.ws;
    __syncthreads();
    for (int i = tid; i < 4096; i += 512) T[i] = cospif((float)i * (1.0f / 2048.0f));
    if (tid < 64) cos64[tid] = cospif((float)tid * (1.0f / 32.0f));
    __syncthreads();
    for (int t = bid; t < 784; t += nb) {
        int u = t;
        if (u < 480) { const int k0 = (u / 30) * 64, n0 = (u % 30) * 64; tconv_tile(p.in[I_WIN] + 512, 2432, k0, n0, (bf16_t*)(ws + WS_WZ), DM, n0, tile); }
        else if ((u -= 480) < 256) { const int k0 = (u >> 4) * 64, n0 = (u & 15) * 64; tconv_tile(p.in[I_WOUT], DM, k0, n0, (bf16_t*)(ws + WS_WOUT), DM, n0, tile); }
        else if ((u -= 256) < 16) { const int d = u >> 3, n0 = (u & 7) * 64; tconv_tile(p.in[I_W2] + d * 64 * 512, 512, 0, n0, (bf16_t*)(ws + WS_W2T) + d * 512 * 64, 64, n0, tile); }
        else if ((u -= 16) < 16) { const int d = u >> 3, n0 = (u & 7) * 64; tconv_tile(p.in[I_A2] + d * 64 * 512, 512, 0, n0, (bf16_t*)(ws + WS_A2T) + d * 512 * 64, 64, n0, tile); }
        else { u -= 16; const int k0 = (u >> 3) * 64, n0 = (u & 7) * 64; tconv_tile(p.in[I_G2], 512, k0, n0, (bf16_t*)(ws + WS_G2T), 128, n0, tile); }
    }
    for (int t = bid; t < 128; t += nb) {
        const int kt = t >> 3, g = t & 7;
        tconv_load(p.in[I_WIN], 2432, kt * 64, g * 64, tile);
        __syncthreads();
        { const int j = tid >> 3, ic = tid & 7; float ac[8], as[8];
#pragma unroll
          for (int e = 0; e < 8; ++e) { ac[e] = 0.f; as[e] = 0.f; }
          for (int c = 0; c < 64; ++c) { const float cs = cos64[(c * j) & 63], sn = cos64[(c * j - 16) & 63];
#pragma unroll
              for (int e = 0; e < 8; ++e) { const float w = tile[(ic * 8 + e) * 65 + c]; ac[e] += w * cs; as[e] += w * sn; } }
          u32x4 w; bf16_t* WF = (bf16_t*)(ws + WS_WF);
          w.x = cvt_pk_bf16(ac[0], ac[1]); w.y = cvt_pk_bf16(ac[2], ac[3]); w.z = cvt_pk_bf16(ac[4], ac[5]); w.w = cvt_pk_bf16(ac[6], ac[7]);
          *(u32x4*)(WF + (size_t)(g * 64 + j) * DM + kt * 64 + ic * 8) = w;
          w.x = cvt_pk_bf16(as[0], as[1]); w.y = cvt_pk_bf16(as[2], as[3]); w.z = cvt_pk_bf16(as[4], as[5]); w.w = cvt_pk_bf16(as[6], as[7]);
          *(u32x4*)(WF + (size_t)(512 + g * 64 + j) * DM + kt * 64 + ic * 8) = w; }
        __syncthreads();
    }
    { float* v2 = (float*)(lds + 33280); float* v3 = (float*)(lds + 53760); float* red = (float*)(lds + 74240); float* tb5 = (float*)(lds + 84480);
      const float* mod = (const float*)(ws + WS_MOD); float* CBW = (float*)(ws + WS_CBW); float* CBG = (float*)(ws + WS_CBG);
      for (int i = tid; i < 5120; i += 512) { const int r = i >> 10, k = i & 1023; v2[i] = mod[r * NMOD + 3072 + k]; v3[i] = mod[r * NMOD + 6144 + k]; }
      __syncthreads();
      for (int it = bid; it < 252; it += nb) {
          const bool isu = it >= 60 && it < 76; if (isu && (it & 1)) continue;
          for (int half = 0; half < (isu ? 2 : 1); ++half) {
              const float* W; int ld, colw; const float* vp;
              if (it < 60) { W = p.in[I_WIN]; ld = 2432; colw = 512 + it * 32; vp = v2; }
              else if (isu) { W = p.in[I_WIN]; ld = 2432; colw = (it - 60 + half) * 32; vp = v2; }
              else { const int u = it - 76; W = (u < 88 ? p.in[I_WG] : p.in[I_WU]) + (size_t)DM * DFF; ld = DFF; colw = (u % 88) * 32; vp = v3; }
              const int jj = tid & 31, kg = tid >> 5; const float* wp = W + (size_t)(kg * 64) * ld + colw + jj; const float* sp = vp + kg * 64;
              float a0 = 0.f, a1 = 0.f, a2 = 0.f, a3 = 0.f, a4 = 0.f;
#pragma unroll 4
              for (int k = 0; k < 64; ++k) { const float w = wp[(size_t)k * ld]; a0 += sp[k] * w; a1 += sp[1024 + k] * w; a2 += sp[2048 + k] * w; a3 += sp[3072 + k] * w; a4 += sp[4096 + k] * w; }
              float* rp = red + kg * 160 + jj; rp[0] = a0; rp[32] = a1; rp[64] = a2; rp[96] = a3; rp[128] = a4;
              __syncthreads();
              if (tid < 160) { float sm = 0.f;
#pragma unroll
                  for (int g = 0; g < 16; ++g) sm += red[g * 160 + tid];
                  const int i = tid >> 5, j5 = tid & 31;
                  if (it < 60) CBW[i * 3072 + it * 32 + j5] = sm;
                  else if (isu) tb5[i * 64 + half * 32 + j5] = sm;
                  else { const int u = it - 76, cgu = (u % 88) * 32 + j5; CBG[i * 5632 + (cgu >> 7) * 256 + (u < 88 ? 0 : 128) + (cgu & 127)] = sm; } }
              __syncthreads();
          }
          if (isu) { const int g = (it - 60) >> 1;
              for (int e = tid; e < 640; e += 512) { const int i = e >> 7, part = (e >> 6) & 1, cp = e & 63; float sm = 0.f;
                  for (int c = 0; c < 64; ++c) sm += tb5[i * 64 + c] * cos64[(c * cp - (part ? 16 : 0)) & 63];
                  CBW[i * 3072 + 2048 + part * 512 + g * 64 + cp] = sm; }
              __syncthreads(); }
      }
      for (int e = bid * 512 + tid; e < 640; e += nb * 512) CBW[(e >> 7) * 3072 + 1920 + (e & 127)] = 0.f; }
    const size_t gt = (size_t)bid * 512 + tid, ngt = (size_t)nb * 512;
    for (size_t i = gt; i < 16384; i += ngt) ((u32x4*)(ws + WS_WZ + (size_t)1920 * DM * 2))[i] = (u32x4){0u, 0u, 0u, 0u};
    for (size_t i = gt; i < (size_t)(gridDim.x == 256 ? 2048 : 4096) * 1024; i += ngt) {
        const int sp = (int)(i >> 10), k0 = ((int)i & 1023) * 8, part = k0 >> 12, kk0 = k0 & 4095; float v[8];
#pragma unroll
        for (int e = 0; e < 8; ++e) { const int j = (sp * (kk0 + e)) & 4095; v[e] = part ? -T[(j - 1024) & 4095] : T[j]; }
        u32x4 w; w.x = cvt_pk_bf16(v[0], v[1]); w.y = cvt_pk_bf16(v[2], v[3]); w.z = cvt_pk_bf16(v[4], v[5]); w.w = cvt_pk_bf16(v[6], v[7]);
        ((u32x4*)(ws + WS_DLAT))[i] = w;
    }
    for (size_t i = gt; i < (size_t)256 * 64; i += ngt) {
        const int sp = (int)(i >> 6), k0 = ((int)i & 63) * 8, part = k0 >> 8, kk0 = k0 & 255; float v[8];
#pragma unroll
        for (int e = 0; e < 8; ++e) { const int j = ((sp * (kk0 + e)) & 255) * 16; v[e] = part ? -T[(j - 1024) & 4095] : T[j]; }
        u32x4 w; w.x = cvt_pk_bf16(v[0], v[1]); w.y = cvt_pk_bf16(v[2], v[3]); w.z = cvt_pk_bf16(v[4], v[5]); w.w = cvt_pk_bf16(v[6], v[7]);
        ((u32x4*)(ws + WS_DCTX))[i] = w;
    }
}

__device__ __forceinline__ void norm_phase(const float* xa, const float* xb, const float* gamma, const float* mod, int sh_off, int sc_off, bf16_t* H, float* xcopy = nullptr) {
    const int lane = threadIdx.x & 63, gw = blockIdx.x * 8 + (threadIdx.x >> 6), nw = gridDim.x * 8;
    for (int row0 = gw * 4; row0 < NTOK; row0 += nw * 4) {
        float4 v[4][4]; float ss[4];
#pragma unroll
        for (int r = 0; r < 4; ++r) { const int row = row0 + r; const float* x = row < NCTX ? xa + (size_t)row * DM : xb + (size_t)(row - NCTX) * DM;
#pragma unroll
            for (int i = 0; i < 4; ++i) v[r][i] = ((const float4*)x)[lane + 64 * i]; }
#pragma unroll
        for (int r = 0; r < 4; ++r) { float s_ = 0.f;
#pragma unroll
            for (int i = 0; i < 4; ++i) s_ += v[r][i].x * v[r][i].x + v[r][i].y * v[r][i].y + v[r][i].z * v[r][i].z + v[r][i].w * v[r][i].w;
            ss[r] = wave_sum(s_); }
        const float* mp = mod + (row0 < NCTX ? 0 : 1 + ((row0 - NCTX) >> 12)) * NMOD;
#pragma unroll
        for (int i = 0; i < 4; ++i) { const int col = 4 * (lane + 64 * i);
            const float4 g = *(const float4*)(gamma + col), sc = *(const float4*)(mp + sc_off + col), sh = *(const float4*)(mp + sh_off + col);
#pragma unroll
            for (int r = 0; r < 4; ++r) { const float rs = rsqrtf(ss[r] * (1.0f / 1024.0f) + 1e-6f); const float4 x = v[r][i];
                u32x2 w; w.x = cvt_pk_bf16(x.x * rs * g.x * (1.0f + sc.x) + sh.x, x.y * rs * g.y * (1.0f + sc.y) + sh.y);
                w.y = cvt_pk_bf16(x.z * rs * g.z * (1.0f + sc.z) + sh.z, x.w * rs * g.w * (1.0f + sc.w) + sh.w);
                *(u32x2*)(H + (size_t)(row0 + r) * DM + col) = w; } }
    }
}
__device__ __forceinline__ void final_norm_phase(float* out, const float* gamma, const bf16_t* X3) {
    const int lane = threadIdx.x & 63, gw = blockIdx.x * 8 + (threadIdx.x >> 6), nw = gridDim.x * 8;
    for (int row0 = gw * 4; row0 < NTOK; row0 += nw * 4) {
        float4 v[4][4]; float ss[4];
#pragma unroll
        for (int r = 0; r < 4; ++r)
#pragma unroll
            for (int i = 0; i < 4; ++i) { const u32x2 pw = ((const u32x2*)(X3 + (size_t)(row0 + r) * DM))[lane + 64 * i];
                v[r][i] = make_float4(__uint_as_float(pw.x << 16), __uint_as_float(pw.x & 0xFFFF0000u), __uint_as_float(pw.y << 16), __uint_as_float(pw.y & 0xFFFF0000u)); }
#pragma unroll
        for (int r = 0; r < 4; ++r) { float s_ = 0.f;
#pragma unroll
            for (int i = 0; i < 4; ++i) s_ += v[r][i].x * v[r][i].x + v[r][i].y * v[r][i].y + v[r][i].z * v[r][i].z + v[r][i].w * v[r][i].w;
            ss[r] = wave_sum(s_); }
#pragma unroll
        for (int i = 0; i < 4; ++i) { const float4 g = ((const float4*)gamma)[lane + 64 * i];
#pragma unroll
            for (int r = 0; r < 4; ++r) { const float rs = rsqrtf(ss[r] * (1.0f / 1024.0f) + 1e-6f); const float4 x = v[r][i];
                ((float4*)(out + (size_t)(row0 + r) * DM))[lane + 64 * i] = make_float4(x.x * rs * g.x, x.y * rs * g.y, x.z * rs * g.z, x.w * rs * g.w); } }
    }
}

typedef float f32x2 __attribute__((ext_vector_type(2)));
constexpr int SC_CH = 32, SC_BUF = 43008, SC_TW = 86016, SC_YC = 104448, SC_CONST = 120832;

struct ScanLoads { u32x4 z0[5]; unsigned nb[5][4][2]; };

__device__ __forceinline__ void scan_issue(ScanLoads& L, const bf16_t* __restrict__ Z, int tb, int S, bool lat, int dir, int h, int c, int pw, int lane) {
    const int pos = c * SC_CH + 8 * pw + (lane >> 3), t = dir ? S - 1 - pos : pos, cg = lane & 7;
    int tn[4]; bool ok[4];
    tn[0] = t - 1; tn[1] = t + 1;
    if (lat) { ok[0] = (t & 63) != 0; ok[1] = (t & 63) != 63; tn[2] = t - 64; ok[2] = t >= 64; tn[3] = t + 64; ok[3] = t < S - 64; }
    else { ok[0] = t > 0; ok[1] = t < S - 1; tn[2] = tn[0]; ok[2] = ok[0]; tn[3] = tn[1]; ok[3] = ok[1]; }
    const bf16_t* zr = Z + (size_t)(tb + t) * DZ + cg * 8;
#pragma unroll
    for (int d = 0; d < 4; ++d) tn[d] = ok[d] ? (tn[d] - t) * DZ : 0;
#pragma unroll
    for (int sec = 0; sec < 5; ++sec) {
        const int col0 = sec < 3 ? sec * 512 + h * 64 : (sec == 3 ? 1536 + dir * 64 : 1664 + dir * 64);
        L.z0[sec] = *(const u32x4*)(zr + col0);
#pragma unroll
        for (int d = 0; d < 4; ++d) { const unsigned* np = (const unsigned*)(zr + col0 + tn[d]) + (d >> 1); const unsigned a = np[0], b = np[2]; L.nb[sec][d][0] = ok[d] ? a : 0u; L.nb[sec][d][1] = ok[d] ? b : 0u; }
    }
}
__device__ __forceinline__ float bfsel(const u32x4& v, int e) { const unsigned w = v[e >> 1]; return __uint_as_float((e & 1) ? (w & 0xFFFF0000u) : (w << 16)); }
__device__ __forceinline__ float bfhalf(unsigned w, int hi) { return __uint_as_float(hi ? (w & 0xFFFF0000u) : (w << 16)); }
template <int CTRL> __device__ __forceinline__ float dpp_add(float x) { return x + dpp_mov<CTRL>(x); }
__device__ __forceinline__ float red8(float x) { x = dpp_add<0xB1>(x); x = dpp_add<0x4E>(x); x = dpp_add<0x141>(x); return x; }

__device__ __forceinline__ void scan_prepA(const ScanLoads& L, unsigned char* lds, int buf, int quarter, int pw, int lane, float (&rv)[8], float (&kv)[8]) {
    float* R = (float*)(lds + buf * SC_BUF); float* W = R + 2048; float* BB = W + 2048; float* KD = BB + 2048; float* KK = KD + 2048; float* V = KK + 2048;
    bf16_t* TW = (bf16_t*)(lds + SC_TW + pw * 4608); bf16_t* TA = TW + 1152;
    const int p8 = lane >> 3, cg = lane & 7, pp = 8 * pw + p8;
    const float* CM = (const float*)(lds + SC_CONST); const bf16_t* CWT = (const bf16_t*)(lds + SC_CONST + 2560);
#pragma unroll
    for (int sec = 0; sec < 5; ++sec) {
        const float4 m0 = *(const float4*)(CM + sec * 64 + cg * 8), m1 = *(const float4*)(CM + sec * 64 + cg * 8 + 4);
        const float mu[8] = {m0.x, m0.y, m0.z, m0.w, m1.x, m1.y, m1.z, m1.w};
        float val[8];
#pragma unroll
        for (int e = 0; e < 8; ++e) { const float z0 = bfsel(L.z0[sec], e), zn = bfhalf(L.nb[sec][e & 3][e >> 2], e & 1); val[e] = z0 + mu[e] * (zn - z0); }
        if (sec == 0) {
#pragma unroll
            for (int e = 0; e < 8; ++e) rv[e] = val[e];
            *(float4*)(R + pp * 64 + cg * 8) = make_float4(val[0], val[1], val[2], val[3]); *(float4*)(R + pp * 64 + cg * 8 + 4) = make_float4(val[4], val[5], val[6], val[7]);
        } else if (sec == 1) {
#pragma unroll
            for (int e = 0; e < 8; ++e) kv[e] = val[e];
        } else if (sec == 2) {
            if ((cg >> 1) == quarter) { *(float4*)(V + pp * 16 + (cg & 1) * 8) = make_float4(val[0], val[1], val[2], val[3]); *(float4*)(V + pp * 16 + (cg & 1) * 8 + 4) = make_float4(val[4], val[5], val[6], val[7]); }
        } else {
            if (sec == 3) {
#pragma unroll
                for (int e = 0; e < 8; ++e) val[e] = 1.0f - 2.0f * __builtin_amdgcn_rcpf(1.0f + __expf(2.0f * val[e]));
            }
            u32x4 w; w.x = cvt_pk_bf16(val[0], val[1]); w.y = cvt_pk_bf16(val[2], val[3]); w.z = cvt_pk_bf16(val[4], val[5]); w.w = cvt_pk_bf16(val[6], val[7]);
            if (sec == 3) { *(u32x4*)(TW + p8 * 136 + cg * 8) = w; *(u32x4*)(TW + p8 * 136 + 64 + cg * 8) = (u32x4){0u, 0u, 0u, 0u}; }
            else { *(u32x4*)(TW + (p8 + 8) * 136 + 64 + cg * 8) = w; *(u32x4*)(TW + (p8 + 8) * 136 + cg * 8) = (u32x4){0u, 0u, 0u, 0u}; }
        }
    }
}
__device__ __forceinline__ void scan_prepB(const Params& p, unsigned char* lds, int buf, int tb, int S, int dir, int h, int quarter, int c, int pw, int lane, const float (&rv)[8], const float (&kv)[8]) {
    unsigned char* ws = p.ws;
    float* R = (float*)(lds + buf * SC_BUF); float* W = R + 2048; float* BB = W + 2048; float* KD = BB + 2048; float* KK = KD + 2048;
    bf16_t* TW = (bf16_t*)(lds + SC_TW + pw * 4608); bf16_t* TA = TW + 1152;
    const int p8 = lane >> 3, cg = lane & 7, pp = 8 * pw + p8;
    const float* CM = (const float*)(lds + SC_CONST); const bf16_t* CWT = (const bf16_t*)(lds + SC_CONST + 2560);
    __builtin_amdgcn_wave_barrier();
    { f32x4 acc[4];
#pragma unroll
      for (int nt = 0; nt < 4; ++nt) acc[nt] = (f32x4){0.f, 0.f, 0.f, 0.f};
#pragma unroll
      for (int k4 = 0; k4 < 4; ++k4) { const bf16x8 a = *(const bf16x8*)(TW + (lane & 15) * 136 + 32 * k4 + 8 * (lane >> 4));
#pragma unroll
          for (int nt = 0; nt < 4; ++nt) { const bf16x8 bb = *(const bf16x8*)(CWT + (16 * nt + (lane & 15)) * 136 + 32 * k4 + 8 * (lane >> 4)); acc[nt] = __builtin_amdgcn_mfma_f32_16x16x32_bf16(a, bb, acc[nt], 0, 0, 0); } }
      const int q4 = lane >> 4, isa = q4 >> 1; float* dst = isa ? BB : W;
#pragma unroll
      for (int nt = 0; nt < 4; ++nt) { const int j = 16 * nt + (lane & 15); const float bias = CM[512 + isa * 64 + j];
#pragma unroll
          for (int i = 0; i < 4; ++i) { const int q = 8 * pw + 4 * (q4 & 1) + i; const float sg = sigm(acc[nt][i] + bias);
              dst[q * 64 + j] = isa ? sg : __expf(-0.60653066f * sg); } } }
    __builtin_amdgcn_wave_barrier();
    { const float4 a0 = *(const float4*)(BB + pp * 64 + cg * 8), a1 = *(const float4*)(BB + pp * 64 + cg * 8 + 4);
      const float4 kw0 = *(const float4*)(CM + 320 + cg * 8), kw1 = *(const float4*)(CM + 324 + cg * 8), ka0 = *(const float4*)(CM + 384 + cg * 8), ka1 = *(const float4*)(CM + 388 + cg * 8),
                   rk0 = *(const float4*)(CM + 448 + cg * 8), rk1 = *(const float4*)(CM + 452 + cg * 8);
      const float a[8] = {a0.x, a0.y, a0.z, a0.w, a1.x, a1.y, a1.z, a1.w}, kw[8] = {kw0.x, kw0.y, kw0.z, kw0.w, kw1.x, kw1.y, kw1.z, kw1.w},
                  ka[8] = {ka0.x, ka0.y, ka0.z, ka0.w, ka1.x, ka1.y, ka1.z, ka1.w}, rk[8] = {rk0.x, rk0.y, rk0.z, rk0.w, rk1.x, rk1.y, rk1.z, rk1.w};
      float kkr[8], kd[8], n2 = 0.f, bon = 0.f;
#pragma unroll
      for (int e = 0; e < 8; ++e) { kkr[e] = kv[e] * kw[e]; n2 += kkr[e] * kkr[e]; kd[e] = kv[e] * (1.0f + (a[e] - 1.0f) * ka[e]); bon += rv[e] * kd[e] * rk[e]; }
      n2 = red8(n2); bon = red8(bon);
      const float inv = 1.0f / fmaxf(sqrtf(n2), 1e-12f);
      float kk[8];
#pragma unroll
      for (int e = 0; e < 8; ++e) kk[e] = kkr[e] * inv;
      *(float4*)(KK + pp * 64 + cg * 8) = make_float4(kk[0], kk[1], kk[2], kk[3]); *(float4*)(KK + pp * 64 + cg * 8 + 4) = make_float4(kk[4], kk[5], kk[6], kk[7]);
      *(float4*)(KD + pp * 64 + cg * 8) = make_float4(kd[0], kd[1], kd[2], kd[3]); *(float4*)(KD + pp * 64 + cg * 8 + 4) = make_float4(kd[4], kd[5], kd[6], kd[7]);
      *(float4*)(BB + pp * 64 + cg * 8) = make_float4(kk[0] * a[0], kk[1] * a[1], kk[2] * a[2], kk[3] * a[3]); *(float4*)(BB + pp * 64 + cg * 8 + 4) = make_float4(kk[4] * a[4], kk[5] * a[5], kk[6] * a[6], kk[7] * a[7]);
      if (quarter == 0 && cg == 0) { const int pos = c * SC_CH + pp, t = dir ? S - 1 - pos : pos; ((float*)(ws + WS_BONUS))[(size_t)(tb + t) * 16 + dir * 8 + h] = bon; } }
}

#define SCAN_BAR() do { asm volatile("s_waitcnt lgkmcnt(0)" ::: "memory"); __builtin_amdgcn_s_barrier(); asm volatile("" ::: "memory"); } while (0)

__device__ __forceinline__ void scan_phase(const Params& p, unsigned char* lds) {
    int tid = threadIdx.x; asm volatile("" : "+v"(tid));
    const int wid = __builtin_amdgcn_readfirstlane(tid >> 6), lane = tid & 63;
    unsigned char* ws = p.ws;
    const bf16_t* Z = (const bf16_t*)(ws + WS_Z); bf16_t* MIX = (bf16_t*)(ws + WS_H); bf16_t* Y1 = (bf16_t*)(ws + WS_Y1);
    float* YC = (float*)(lds + SC_YC);
    const bool bal = gridDim.x == 256; const int nbk = gridDim.x, bk = blockIdx.x;
    const int nitems = bal ? (bk < 128 ? 4 : 6) : (1280 - bk + nbk - 1) / nbk;
    for (int ii = 0; ii < nitems; ++ii) {
        int it;
        if (!bal) it = bk + ii * nbk;
        else if (ii == 0) it = bk;
        else it = 256 + (bk < 128 ? bk * 3 + (ii - 1) : 384 + (bk - 128) * 5 + (ii - 1));
        const bool lat = it < 256; const int q = lat ? it : it - 256;
        const int quarter = q & 3, dir = (q >> 2) & 1, h = (q >> 3) & 7, b = q >> 6;
        const int S = lat ? 4096 : 256, tb = lat ? NCTX + b * 4096 : b * 256, nch = S / SC_CH;
        const bool cons = (wid & 1) == 0;
        const int rl = (wid >> 1) * 4 + ((tid >> 4) & 3), ks = tid & 15, row = quarter * 16 + rl, pw = wid >> 1;
        f32x2 s01 = {0.f, 0.f}, s23 = {0.f, 0.f};
        ScanLoads L;
        { float* CM = (float*)(lds + SC_CONST); bf16_t* CWT = (bf16_t*)(lds + SC_CONST + 2560);
          if (tid < 320) { const int sec = tid >> 6, j = tid & 63; CM[tid] = p.in[I_MU][(sec < 3 ? sec * 512 + h * 64 : (sec == 3 ? 1536 + dir * 64 : 1664 + dir * 64)) + j]; }
          else if (tid < 384) CM[tid] = p.in[I_KK][h * 64 + tid - 320];
          else if (tid < 448) CM[tid] = p.in[I_KA][h * 64 + tid - 384];
          else CM[tid] = p.in[I_RK][h * 64 + tid - 448];
          if (tid < 128) CM[512 + tid] = (tid < 64 ? p.in[I_W0] : p.in[I_A0])[dir * 512 + h * 64 + (tid & 63)];
          for (int e = tid; e < 1024; e += 512) { const int mat = e >> 9, j = (e >> 3) & 63, i8 = e & 7;
              *(u32x4*)(CWT + j * 136 + mat * 64 + i8 * 8) = *(const u32x4*)((const bf16_t*)(ws + (mat ? WS_A2T : WS_W2T)) + (size_t)dir * 512 * 64 + (size_t)(h * 64 + j) * 64 + i8 * 8); }
          SCAN_BAR(); }
        if (cons) { if (lat) { const float4 v = *(const float4*)((dir ? p.in[I_SB] : p.in[I_SF]) + ((size_t)(b * 8 + h) * 64 + row) * 64 + ks * 4); s01 = (f32x2){v.x, v.y}; s23 = (f32x2){v.z, v.w}; } }
        else { float rv[8], kv[8]; scan_issue(L, Z, tb, S, lat, dir, h, 0, pw, lane); scan_prepA(L, lds, 0, quarter, pw, lane, rv, kv); scan_issue(L, Z, tb, S, lat, dir, h, 1, pw, lane);
               scan_prepB(p, lds, 0, tb, S, dir, h, quarter, 0, pw, lane, rv, kv); }
        SCAN_BAR();
        for (int c = 0; c < nch; ++c) {
            if (cons) {
                const unsigned char* bufp = lds + (c & 1) * SC_BUF;
                const float4* R4 = (const float4*)bufp; const float4* W4 = R4 + 512; const float4* B4 = W4 + 512; const float4* KD4 = B4 + 512; const float4* KK4 = KD4 + 512; const float* V = (const float*)(KK4 + 512);
                float* yc = YC + (c & 1) * 2048 + rl * 4 + (ks >> 2);
                float4 kkA, wA, bA, kdA, rA, kkB, wB, bB, kdB, rB; float vA, vB;
#define SC_LOAD(X, pp_) do { kk##X = KK4[(pp_) * 16 + ks]; w##X = W4[(pp_) * 16 + ks]; b##X = B4[(pp_) * 16 + ks]; kd##X = KD4[(pp_) * 16 + ks]; r##X = R4[(pp_) * 16 + ks]; v##X = V[(pp_) * 16 + rl]; } while (0)
#define SC_STEP(X, pp_) do { \
                    f32x2 d = s01 * (f32x2){kk##X.x, kk##X.y}; d = __builtin_elementwise_fma(s23, (f32x2){kk##X.z, kk##X.w}, d); \
                    const float sa = -red16(d.x + d.y); \
                    const f32x2 sa2 = {sa, sa}, vv2 = {v##X, v##X}; \
                    f32x2 t01 = vv2 * (f32x2){kd##X.x, kd##X.y}, t23 = vv2 * (f32x2){kd##X.z, kd##X.w}; \
                    t01 = __builtin_elementwise_fma(sa2, (f32x2){b##X.x, b##X.y}, t01); t23 = __builtin_elementwise_fma(sa2, (f32x2){b##X.z, b##X.w}, t23); \
                    s01 = __builtin_elementwise_fma(s01, (f32x2){w##X.x, w##X.y}, t01); s23 = __builtin_elementwise_fma(s23, (f32x2){w##X.z, w##X.w}, t23); \
                    f32x2 y2 = s01 * (f32x2){r##X.x, r##X.y}; y2 = __builtin_elementwise_fma(s23, (f32x2){r##X.z, r##X.w}, y2); \
                    float yp = y2.x + y2.y; yp = dpp_add<0xB1>(yp); yp = dpp_add<0x4E>(yp); yc[(pp_) * 64] = yp; } while (0)
                SC_LOAD(A, 0);
#pragma unroll 8
                for (int pp = 0; pp < SC_CH; pp += 2) {
                    SC_LOAD(B, pp + 1); __builtin_amdgcn_sched_barrier(0);
                    SC_STEP(A, pp); __builtin_amdgcn_sched_barrier(0);
                    SC_LOAD(A, (pp + 2) & (SC_CH - 1)); __builtin_amdgcn_sched_barrier(0);
                    SC_STEP(B, pp + 1); __builtin_amdgcn_sched_barrier(0);
                }
#undef SC_LOAD
#undef SC_STEP
            } else if (c + 1 < nch) {
                float rv[8], kv[8];
                scan_prepA(L, lds, (c + 1) & 1, quarter, pw, lane, rv, kv);
                if (c + 2 < nch) scan_issue(L, Z, tb, S, lat, dir, h, c + 2, pw, lane);
                __builtin_amdgcn_sched_barrier(0);
                scan_prepB(p, lds, (c + 1) & 1, tb, S, dir, h, quarter, c + 1, pw, lane, rv, kv);
            }
            SCAN_BAR();
            { const int pp = tid >> 4, r_ = tid & 15, pos = c * SC_CH + pp, t = dir ? S - 1 - pos : pos; const float4 y4 = *(const float4*)(YC + (c & 1) * 2048 + tid * 4); const bf16_t yv = f2bf((y4.x + y4.y) + (y4.z + y4.w));
              if (dir == 0) MIX[(size_t)(tb + t) * DM + 512 + h * 64 + quarter * 16 + r_] = yv; else Y1[(size_t)(tb + t) * DRW + h * 64 + quarter * 16 + r_] = yv; }
        }
        if (!lat && cons) *(float4*)(p.out + (size_t)NTOK * DM + (size_t)dir * 524288 + ((size_t)(b * 8 + h) * 64 + row) * 64 + ks * 4) = make_float4(s01.x, s01.y, s23.x, s23.y);
        SCAN_BAR();
    }
}


constexpr int S2_SA = 0, S2_SA_SZ = 16896, S2_SB = 50688, S2_SB_SZ = 16384, S2_SC = 83456, S2_SC_SZ = 15616, S2_SD = 130304, S2_SD_SZ = 3072, S2_CONST = 136448;
typedef short bf16x4 __attribute__((ext_vector_type(4)));

__device__ __forceinline__ bf16x8 frag2(const bf16_t* p0, const bf16_t* p1) { const u32x2 a = *(const u32x2*)p0, b = *(const u32x2*)p1; const u32x4 w = {a.x, a.y, b.x, b.y}; return __builtin_bit_cast(bf16x8, w); }
__device__ __forceinline__ bf16x8 frag1(const bf16_t* p0) { const u32x2 a = *(const u32x2*)p0; const u32x4 w = {a.x, a.y, 0u, 0u}; return __builtin_bit_cast(bf16x8, w); }
__device__ __forceinline__ bf16x8 fragf(const f32x4& lo) { const u32x4 w = {cvt_pk_bf16(lo[0], lo[1]), cvt_pk_bf16(lo[2], lo[3]), 0u, 0u}; return __builtin_bit_cast(bf16x8, w); }
__device__ __forceinline__ bf16x8 fragff(const f32x4& lo, const f32x4& hi) { const u32x4 w = {cvt_pk_bf16(lo[0], lo[1]), cvt_pk_bf16(lo[2], lo[3]), cvt_pk_bf16(hi[0], hi[1]), cvt_pk_bf16(hi[2], hi[3])}; return __builtin_bit_cast(bf16x8, w); }

struct Scan2Loads { u32x4 z0[5]; unsigned nb[5][4][2]; };
__device__ __forceinline__ void scan2_issue(Scan2Loads& L, const bf16_t* __restrict__ Z, int tb, int S, bool lat, int dir, int h, int c, int pw, int lane, bool need_r = true) {
    const int pos = c * 16 + 8 * pw + (lane >> 3), t = dir ? S - 1 - pos : pos, cg = lane & 7;
    int tn[4]; bool ok[4];
    tn[0] = t - 1; tn[1] = t + 1;
    if (lat) { ok[0] = (t & 63) != 0; ok[1] = (t & 63) != 63; tn[2] = t - 64; ok[2] = t >= 64; tn[3] = t + 64; ok[3] = t < S - 64; }
    else { ok[0] = t > 0; ok[1] = t < S - 1; tn[2] = tn[0]; ok[2] = ok[0]; tn[3] = tn[1]; ok[3] = ok[1]; }
    const bf16_t* zr = Z + (size_t)(tb + t) * DZ + cg * 8;
#pragma unroll
    for (int d = 0; d < 4; ++d) tn[d] = ok[d] ? (tn[d] - t) * DZ : 0;
#pragma unroll
    for (int sec = 0; sec < 5; ++sec) {
        const int col0 = sec < 3 ? sec * 512 + h * 64 : (sec == 3 ? 1536 + dir * 64 : 1664 + dir * 64);
        if (sec == 0 && !need_r) continue;
        L.z0[sec] = *(const u32x4*)(zr + col0);
#pragma unroll
        for (int d = 0; d < 4; ++d) { const unsigned* np = (const unsigned*)(zr + col0 + tn[d]) + (d >> 1); const unsigned a = np[0], b = np[2]; L.nb[sec][d][0] = ok[d] ? a : 0u; L.nb[sec][d][1] = ok[d] ? b : 0u; }
    }
}
__device__ __forceinline__ void scan2_stageA(const Scan2Loads& L, unsigned char* lds, int c, int pw, int lane, bool need_r = true) {
    unsigned char* sa = lds + S2_SA + (c % 3) * S2_SA_SZ;
    float* RR = (float*)sa; float* KR = RR + 1024; float* VR = KR + 1024; bf16_t* TWA = (bf16_t*)(sa + 12288); bf16_t* TAA = TWA + 1152;
    const float* CM = (const float*)(lds + S2_CONST);
    const int cg = lane & 7, pp = 8 * pw + (lane >> 3);
#pragma unroll
    for (int sec = 0; sec < 5; ++sec) {
        if (sec == 0 && !need_r) continue;
        const float4 m0 = *(const float4*)(CM + sec * 64 + cg * 8), m1 = *(const float4*)(CM + sec * 64 + cg * 8 + 4);
        const float mu[8] = {m0.x, m0.y, m0.z, m0.w, m1.x, m1.y, m1.z, m1.w};
        float val[8];
#pragma unroll
        for (int e = 0; e < 8; ++e) { const float z0 = bfsel(L.z0[sec], e), zn = bfhalf(L.nb[sec][e & 3][e >> 2], e & 1); val[e] = z0 + mu[e] * (zn - z0); }
        if (sec < 3) { float* D = sec == 0 ? RR : (sec == 1 ? KR : VR);
            *(float4*)(D + pp * 64 + cg * 8) = make_float4(val[0], val[1], val[2], val[3]); *(float4*)(D + pp * 64 + cg * 8 + 4) = make_float4(val[4], val[5], val[6], val[7]); }
        else {
            if (sec == 3) {
#pragma unroll
                for (int e = 0; e < 8; ++e) val[e] = 1.0f - 2.0f * __builtin_amdgcn_rcpf(1.0f + __expf(2.0f * val[e]));
            }
            u32x4 w; w.x = cvt_pk_bf16(val[0], val[1]); w.y = cvt_pk_bf16(val[2], val[3]); w.z = cvt_pk_bf16(val[4], val[5]); w.w = cvt_pk_bf16(val[6], val[7]);
            *(u32x4*)((sec == 3 ? TWA : TAA) + pp * 72 + cg * 8) = w;
        }
    }
}
__device__ __forceinline__ void scan2_stageB(const Params& p, unsigned char* lds, int c, bool iclr, int tb, int S, int dir, int h, int lane, int cb = 0, bool wbon = true) {
    unsigned char* sa = lds + S2_SA + (c % 3) * S2_SA_SZ; unsigned char* sb = lds + S2_SB + (c & 1) * S2_SB_SZ;
    const float* RR = (const float*)sa; const float* KR = RR + 1024; const bf16_t* TX = (const bf16_t*)(sa + 12288) + (iclr ? 1152 : 0);
    float* G = (float*)sb; float* KAP = G + 1024; float* BET = KAP + 1024; float* KDD = BET + 1024;
    const float* CM = (const float*)(lds + S2_CONST); const bf16_t* WT = (const bf16_t*)(lds + S2_CONST + 2560) + (iclr ? 4608 : 0);
    const int jl = lane & 15, q = lane >> 4;
    f32x4 acc[4];
#pragma unroll
    for (int nt = 0; nt < 4; ++nt) acc[nt] = (f32x4){0.f, 0.f, 0.f, 0.f};
#pragma unroll
    for (int k2 = 0; k2 < 2; ++k2) { const bf16x8 a = *(const bf16x8*)(TX + jl * 72 + 32 * k2 + 8 * q);
#pragma unroll
        for (int nt = 0; nt < 4; ++nt) { const bf16x8 bb = *(const bf16x8*)(WT + (16 * nt + jl) * 72 + 32 * k2 + 8 * q); acc[nt] = __builtin_amdgcn_mfma_f32_16x16x32_bf16(a, bb, acc[nt], 0, 0, 0); } }
    if (!iclr) {
#pragma unroll
        for (int nt = 0; nt < 4; ++nt) { const int j = 16 * nt + jl; const float bias = CM[512 + j]; float cs[4]; float run = 0.f;
#pragma unroll
            for (int i = 0; i < 4; ++i) { run += 0.60653066f * sigm(acc[nt][i] + bias); cs[i] = run; }
            const float t1 = __shfl(run, lane - 16), t2 = __shfl(run, lane - 32), t3 = __shfl(run, lane - 48);
            const float off = (q >= 1 ? t1 : 0.f) + (q >= 2 ? t2 : 0.f) + (q >= 3 ? t3 : 0.f);
#pragma unroll
            for (int i = 0; i < 4; ++i) G[(4 * q + i) * 64 + j] = __expf(-(off + cs[i])); }
    } else {
        float a[4][4], kkr[4][4], kv[4][4], rv[4][4], n2[4] = {0.f, 0.f, 0.f, 0.f}, bon[4] = {0.f, 0.f, 0.f, 0.f};
#pragma unroll
        for (int nt = 0; nt < 4; ++nt) { const int j = 16 * nt + jl; const float bias = CM[576 + j], kw = CM[320 + j], ka = CM[384 + j], rk = CM[448 + j];
#pragma unroll
            for (int i = 0; i < 4; ++i) { const int t = 4 * q + i; a[nt][i] = sigm(acc[nt][i] + bias); const float k = KR[t * 64 + j], r = wbon ? RR[t * 64 + j] : 0.f;
                kkr[nt][i] = k * kw; n2[i] += kkr[nt][i] * kkr[nt][i]; kv[nt][i] = k * (1.0f + (a[nt][i] - 1.0f) * ka); bon[i] += r * kv[nt][i] * rk; } }
#pragma unroll
        for (int i = 0; i < 4; ++i) { n2[i] = red16(n2[i]); bon[i] = red16(bon[i]); n2[i] = 1.0f / fmaxf(sqrtf(n2[i]), 1e-12f); }
#pragma unroll
        for (int nt = 0; nt < 4; ++nt) { const int j = 16 * nt + jl;
#pragma unroll
            for (int i = 0; i < 4; ++i) { const int t = 4 * q + i; const float kap = kkr[nt][i] * n2[i]; KAP[t * 64 + j] = kap; BET[t * 64 + j] = kap * a[nt][i]; KDD[t * 64 + j] = kv[nt][i]; } }
        if (jl == 0 && wbon) {
#pragma unroll
            for (int i = 0; i < 4; ++i) { const int pos = (c + cb) * 16 + 4 * q + i, t = dir ? S - 1 - pos : pos; ((float*)(p.ws + WS_BONUS))[(size_t)(tb + t) * 16 + dir * 8 + h] = bon[i]; } }
    }
}
__device__ __forceinline__ void scan2_stageC(unsigned char* lds, int c, int w, int lane) {
    const unsigned char* sa = lds + S2_SA + (c % 3) * S2_SA_SZ; const unsigned char* sb = lds + S2_SB + (c & 1) * S2_SB_SZ; unsigned char* sc = lds + S2_SC + (c % 3) * S2_SC_SZ;
    const float* RR = (const float*)sa; const float* VR = RR + 2048; const float* G = (const float*)sb; const float* KAP = G + 1024; const float* BET = KAP + 1024; const float* KDD = BET + 1024;
    bf16_t* KT = (bf16_t*)sc; bf16_t* RT = KT + 1152; bf16_t* BT = RT + 1152; bf16_t* KKT = BT + 1152; bf16_t* BTT = KKT + 1152; bf16_t* KKTT = BTT + 1024; bf16_t* VT = KKTT + 1024; float* GL = (float*)(sc + 15360);
    const int t = lane >> 2, k0 = 16 * w + 4 * (lane & 3), o = t * 64 + k0;
    const float4 g = *(const float4*)(G + o), gm = t > 0 ? *(const float4*)(G + o - 64) : make_float4(1.f, 1.f, 1.f, 1.f);
    const float4 kap = *(const float4*)(KAP + o), bet = *(const float4*)(BET + o), kdd = *(const float4*)(KDD + o), r = *(const float4*)(RR + o), v = *(const float4*)(VR + o);
    const float4 gi = make_float4(__builtin_amdgcn_rcpf(g.x), __builtin_amdgcn_rcpf(g.y), __builtin_amdgcn_rcpf(g.z), __builtin_amdgcn_rcpf(g.w));
    const float bt[4] = {bet.x * gi.x, bet.y * gi.y, bet.z * gi.z, bet.w * gi.w}, kt[4] = {kdd.x * gi.x, kdd.y * gi.y, kdd.z * gi.z, kdd.w * gi.w}, vv[4] = {v.x, v.y, v.z, v.w};
    u32x2 x;
    x.x = cvt_pk_bf16(kap.x * gm.x, kap.y * gm.y); x.y = cvt_pk_bf16(kap.z * gm.z, kap.w * gm.w); *(u32x2*)(KT + t * 72 + k0) = x;
    x.x = cvt_pk_bf16(r.x * g.x, r.y * g.y); x.y = cvt_pk_bf16(r.z * g.z, r.w * g.w); *(u32x2*)(RT + t * 72 + k0) = x;
    x.x = cvt_pk_bf16(bt[0], bt[1]); x.y = cvt_pk_bf16(bt[2], bt[3]); *(u32x2*)(BT + t * 72 + k0) = x;
    x.x = cvt_pk_bf16(kt[0], kt[1]); x.y = cvt_pk_bf16(kt[2], kt[3]); *(u32x2*)(KKT + t * 72 + k0) = x;
#pragma unroll
    for (int e = 0; e < 4; ++e) { BTT[(k0 + e) * 16 + t] = f2bf(bt[e]); KKTT[(k0 + e) * 16 + t] = f2bf(kt[e]); VT[(k0 + e) * 16 + t] = f2bf(vv[e]); }
    if (t == 15) *(float4*)(GL + k0) = g;
}
__device__ __forceinline__ void scan2_stageD(unsigned char* lds, int c, int w, int lane) {
    const unsigned char* sc = lds + S2_SC + (c % 3) * S2_SC_SZ; unsigned char* sd = lds + S2_SD + (c & 1) * S2_SD_SZ;
    const bf16_t* X = (const bf16_t*)sc + ((w & 2) ? 1152 : 0); const bf16_t* Y = (const bf16_t*)sc + 2304 + ((w & 1) ? 1152 : 0);
    bf16_t* AKK = (bf16_t*)sd; bf16_t* ABR = AKK + 256; bf16_t* AKR = ABR + 256; bf16_t* TT = AKR + 256; float* AF = (float*)(sd + 2048);
    const int s = lane & 15, q = lane >> 4;
    f32x4 acc = {0.f, 0.f, 0.f, 0.f};
#pragma unroll
    for (int k2 = 0; k2 < 2; ++k2) { const bf16x8 a = *(const bf16x8*)(X + s * 72 + 32 * k2 + 8 * q), bb = *(const bf16x8*)(Y + s * 72 + 32 * k2 + 8 * q); acc = __builtin_amdgcn_mfma_f32_16x16x32_bf16(a, bb, acc, 0, 0, 0); }
    if (w != 0) {
#pragma unroll
        for (int i = 0; i < 4; ++i) { const int t = 4 * q + i; const bool keep = (w & 2) ? (s <= t) : (s < t); (w == 1 ? AKK : (w == 2 ? ABR : AKR))[t * 16 + s] = f2bf(keep ? acc[i] : 0.f); }
    } else {
        f32x4 acc2 = {0.f, 0.f, 0.f, 0.f};
#pragma unroll
        for (int k2 = 0; k2 < 2; ++k2) { const bf16x8 a = *(const bf16x8*)(Y + s * 72 + 32 * k2 + 8 * q), bb = *(const bf16x8*)(X + s * 72 + 32 * k2 + 8 * q); acc2 = __builtin_amdgcn_mfma_f32_16x16x32_bf16(a, bb, acc2, 0, 0, 0); }
        f32x4 Nn, NT, Tt;
#pragma unroll
        for (int i = 0; i < 4; ++i) { const int m = 4 * q + i; Nn[i] = (m < s) ? acc2[i] : 0.f; NT[i] = (s < m) ? acc[i] : 0.f; Tt[i] = (m == s ? 1.0f : 0.0f) - NT[i]; }
#pragma unroll
        for (int lev = 0; lev < 3; ++lev) {
            f32x4 N2 = {0.f, 0.f, 0.f, 0.f}, N2T = {0.f, 0.f, 0.f, 0.f};
#pragma unroll
            for (int j = 0; j < 4; ++j) { N2 = __builtin_amdgcn_mfma_f32_16x16x4f32(NT[j], Nn[j], N2, 0, 0, 0); N2T = __builtin_amdgcn_mfma_f32_16x16x4f32(Nn[j], NT[j], N2T, 0, 0, 0); }
            f32x4 Tn = Tt;
#pragma unroll
            for (int j = 0; j < 4; ++j) Tn = __builtin_amdgcn_mfma_f32_16x16x4f32(N2[j], Tt[j], Tn, 0, 0, 0);
            Tt = Tn; Nn = N2; NT = N2T;
        }
#pragma unroll
        for (int i = 0; i < 4; ++i) TT[(4 * q + i) * 16 + s] = f2bf(-Tt[i]);
    }
}
__device__ __forceinline__ void scan2_stageE(unsigned char* lds, int c, int w, int lane, f32x4 (&P)[4], bf16_t* __restrict__ yout, int ystride, int tb, int S, int dir, int cb = 0) {
    const unsigned char* sc = lds + S2_SC + (c % 3) * S2_SC_SZ; const unsigned char* sd = lds + S2_SD + (c & 1) * S2_SD_SZ;
    const bf16_t* KT = (const bf16_t*)sc; const bf16_t* RT = KT + 1152; const bf16_t* BTT = KT + 4608; const bf16_t* KKTT = BTT + 1024; const bf16_t* VT = KKTT + 1024; const float* GL = (const float*)(sc + 15360);
    const bf16_t* AKK = (const bf16_t*)sd; const bf16_t* ABR = AKK + 256; const bf16_t* AKR = ABR + 256; const bf16_t* TT = AKR + 256;
    const int jl = lane & 15, q = lane >> 4;
    const f32x4 zero = {0.f, 0.f, 0.f, 0.f};
    const bf16x8 Pb0 = fragff(P[0], P[1]), Pb1 = fragff(P[2], P[3]);
    f32x4 QT = __builtin_amdgcn_mfma_f32_16x16x32_bf16(frag2(KT + jl * 72 + 4 * q, KT + jl * 72 + 16 + 4 * q), Pb0, zero, 0, 0, 0);
    QT = __builtin_amdgcn_mfma_f32_16x16x32_bf16(frag2(KT + jl * 72 + 32 + 4 * q, KT + jl * 72 + 48 + 4 * q), Pb1, QT, 0, 0, 0);
    f32x4 YT = __builtin_amdgcn_mfma_f32_16x16x32_bf16(frag2(RT + jl * 72 + 4 * q, RT + jl * 72 + 16 + 4 * q), Pb0, zero, 0, 0, 0);
    YT = __builtin_amdgcn_mfma_f32_16x16x32_bf16(frag2(RT + jl * 72 + 32 + 4 * q, RT + jl * 72 + 48 + 4 * q), Pb1, YT, 0, 0, 0);
    const bf16x8 Vb = frag1(VT + (16 * w + jl) * 16 + 4 * q);
    QT = __builtin_amdgcn_mfma_f32_16x16x32_bf16(frag1(AKK + jl * 16 + 4 * q), Vb, QT, 0, 0, 0);
    const f32x4 UT = __builtin_amdgcn_mfma_f32_16x16x32_bf16(frag1(TT + jl * 16 + 4 * q), fragf(QT), zero, 0, 0, 0);
    const bf16x8 Ub = fragf(UT);
    YT = __builtin_amdgcn_mfma_f32_16x16x32_bf16(frag1(ABR + jl * 16 + 4 * q), Ub, YT, 0, 0, 0);
    YT = __builtin_amdgcn_mfma_f32_16x16x32_bf16(frag1(AKR + jl * 16 + 4 * q), Vb, YT, 0, 0, 0);
#pragma unroll
    for (int i = 0; i < 4; ++i) { const int pos = (c + cb) * 16 + 4 * q + i, t = dir ? S - 1 - pos : pos; yout[(size_t)(tb + t) * ystride + 16 * w + jl] = f2bf(YT[i]); }
#pragma unroll
    for (int mt = 0; mt < 4; ++mt) {
        P[mt] = __builtin_amdgcn_mfma_f32_16x16x32_bf16(frag1(BTT + (16 * mt + jl) * 16 + 4 * q), Ub, P[mt], 0, 0, 0);
        P[mt] = __builtin_amdgcn_mfma_f32_16x16x32_bf16(frag1(KKTT + (16 * mt + jl) * 16 + 4 * q), Vb, P[mt], 0, 0, 0);
        const float4 gl = *(const float4*)(GL + 16 * mt + 4 * q);
        P[mt][0] *= gl.x; P[mt][1] *= gl.y; P[mt][2] *= gl.z; P[mt][3] *= gl.w;
    }
}

__device__ __forceinline__ void scan2_stageE1(unsigned char* lds, int c, int w, int lane, f32x4 (&P)[4], f32x4 (&X)[4]) {
    const unsigned char* sc = lds + S2_SC + (c % 3) * S2_SC_SZ; const unsigned char* sd = lds + S2_SD + (c & 1) * S2_SD_SZ;
    const bf16_t* KT = (const bf16_t*)sc; const bf16_t* BTT = KT + 4608; const bf16_t* KKTT = BTT + 1024; const bf16_t* VT = KKTT + 1024; const float* GL = (const float*)(sc + 15360);
    const bf16_t* AKK = (const bf16_t*)sd; const bf16_t* TT = AKK + 768;
    const int jl = lane & 15, q = lane >> 4;
    const f32x4 zero = {0.f, 0.f, 0.f, 0.f};
    const bf16x8 KT0 = frag2(KT + jl * 72 + 4 * q, KT + jl * 72 + 16 + 4 * q), KT1 = frag2(KT + jl * 72 + 32 + 4 * q, KT + jl * 72 + 48 + 4 * q);
    f32x4 QT = __builtin_amdgcn_mfma_f32_16x16x32_bf16(KT0, fragff(P[0], P[1]), zero, 0, 0, 0);
    QT = __builtin_amdgcn_mfma_f32_16x16x32_bf16(KT1, fragff(P[2], P[3]), QT, 0, 0, 0);
    f32x4 QX = __builtin_amdgcn_mfma_f32_16x16x32_bf16(KT0, fragff(X[0], X[1]), zero, 0, 0, 0);
    QX = __builtin_amdgcn_mfma_f32_16x16x32_bf16(KT1, fragff(X[2], X[3]), QX, 0, 0, 0);
    const bf16x8 Vb = frag1(VT + (16 * w + jl) * 16 + 4 * q);
    QT = __builtin_amdgcn_mfma_f32_16x16x32_bf16(frag1(AKK + jl * 16 + 4 * q), Vb, QT, 0, 0, 0);
    const bf16x8 TTf = frag1(TT + jl * 16 + 4 * q);
    const f32x4 UT = __builtin_amdgcn_mfma_f32_16x16x32_bf16(TTf, fragf(QT), zero, 0, 0, 0), UX = __builtin_amdgcn_mfma_f32_16x16x32_bf16(TTf, fragf(QX), zero, 0, 0, 0);
    const bf16x8 Ub = fragf(UT), UXb = fragf(UX);
#pragma unroll
    for (int mt = 0; mt < 4; ++mt) {
        const bf16x8 Bf = frag1(BTT + (16 * mt + jl) * 16 + 4 * q);
        P[mt] = __builtin_amdgcn_mfma_f32_16x16x32_bf16(Bf, Ub, P[mt], 0, 0, 0);
        P[mt] = __builtin_amdgcn_mfma_f32_16x16x32_bf16(frag1(KKTT + (16 * mt + jl) * 16 + 4 * q), Vb, P[mt], 0, 0, 0);
        X[mt] = __builtin_amdgcn_mfma_f32_16x16x32_bf16(Bf, UXb, X[mt], 0, 0, 0);
        const float4 gl = *(const float4*)(GL + 16 * mt + 4 * q);
        P[mt][0] *= gl.x; P[mt][1] *= gl.y; P[mt][2] *= gl.z; P[mt][3] *= gl.w; X[mt][0] *= gl.x; X[mt][1] *= gl.y; X[mt][2] *= gl.z; X[mt][3] *= gl.w;
    }
}

__device__ __forceinline__ void scan2_run(const Params& p, unsigned char* lds, const bool lat, const int b, const int h, const int dir, const int cb, const int nch, const int mode, const int seg) {
    int tid = threadIdx.x; asm volatile("" : "+v"(tid));
    const int wid = __builtin_amdgcn_readfirstlane(tid >> 6), lane = tid & 63;
    unsigned char* ws = p.ws;
    const bf16_t* Z = (const bf16_t*)(ws + WS_Z);
    const int S = lat ? 4096 : 256, tb = lat ? NCTX + b * 4096 : b * 256;
    float* SEG = (float*)(ws + WS_SEG) + (size_t)((b * 8 + h) * 2 + dir) * 3 * 8192;
    { float* CM = (float*)(lds + S2_CONST); bf16_t* CWT = (bf16_t*)(lds + S2_CONST + 2560);
      if (tid < 320) { const int sec = tid >> 6, j = tid & 63; CM[tid] = p.in[I_MU][(sec < 3 ? sec * 512 + h * 64 : (sec == 3 ? 1536 + dir * 64 : 1664 + dir * 64)) + j]; }
      else if (tid < 384) CM[tid] = p.in[I_KK][h * 64 + tid - 320];
      else if (tid < 448) CM[tid] = p.in[I_KA][h * 64 + tid - 384];
      else CM[tid] = p.in[I_RK][h * 64 + tid - 448];
      if (tid < 128) CM[512 + tid] = (tid < 64 ? p.in[I_W0] : p.in[I_A0])[dir * 512 + h * 64 + (tid & 63)];
      for (int e = tid; e < 1024; e += 512) { const int mat = e >> 9, j = (e >> 3) & 63, i8 = e & 7;
          *(u32x4*)(CWT + mat * 4608 + j * 72 + i8 * 8) = *(const u32x4*)((const bf16_t*)(ws + (mat ? WS_A2T : WS_W2T)) + (size_t)dir * 512 * 64 + (size_t)(h * 64 + j) * 64 + i8 * 8); }
      SCAN_BAR(); }
    bf16_t* yout = dir == 0 ? (bf16_t*)(ws + WS_H) + 512 + h * 64 : (bf16_t*)(ws + WS_Y1) + h * 64; const int ystride = dir == 0 ? DM : DRW;
    const int vrow = 16 * (wid & 3) + (lane & 15), q4 = lane >> 4;
    f32x4 P[4];
#pragma unroll
    for (int mt = 0; mt < 4; ++mt) P[mt] = (f32x4){0.f, 0.f, 0.f, 0.f};
    if (mode == 0 && lat) {
        if (wid < 4) {
#pragma unroll
            for (int mt = 0; mt < 4; ++mt) P[mt] = *(const f32x4*)((dir ? p.in[I_SB] : p.in[I_SF]) + ((size_t)(b * 8 + h) * 64 + vrow) * 64 + 16 * mt + 4 * q4);
        }
        float* XL = (float*)(lds + S2_SA);
        for (int jj = 0; jj < seg; ++jj) {
            const float* Xg = SEG + (size_t)jj * 8192; const float* Ng = Xg + 4096;
            for (int e = tid; e < 1024; e += 512) *(float4*)(XL + e * 4) = *(const float4*)(Xg + e * 4);
            SCAN_BAR();
            if (wid < 4) {
                f32x4 Pn[4];
#pragma unroll
                for (int mt = 0; mt < 4; ++mt) { Pn[mt] = *(const f32x4*)(Ng + vrow * 64 + 16 * mt + 4 * q4);
#pragma unroll
                    for (int m2 = 0; m2 < 4; ++m2)
#pragma unroll
                        for (int j = 0; j < 4; ++j) Pn[mt] = __builtin_amdgcn_mfma_f32_16x16x4f32(XL[(16 * m2 + 4 * q4 + j) * 64 + 16 * mt + (lane & 15)], P[m2][j], Pn[mt], 0, 0, 0); }
#pragma unroll
                for (int mt = 0; mt < 4; ++mt) P[mt] = Pn[mt];
            }
            SCAN_BAR();
        }
    }
    if (wid >= 6) {
        Scan2Loads L0, L1; const int pw = wid - 6;
        const bool nr = mode == 0; scan2_issue(L0, Z, tb, S, lat, dir, h, cb, pw, lane, nr); scan2_issue(L1, Z, tb, S, lat, dir, h, cb + 1, pw, lane, nr);
        for (int pd = 0; pd < nch + 4; pd += 2) {
            if (pd < nch) { scan2_stageA(L0, lds, pd, pw, lane, nr); if (pd + 2 < nch) scan2_issue(L0, Z, tb, S, lat, dir, h, cb + pd + 2, pw, lane, nr); }
            SCAN_BAR();
            if (pd + 1 < nch) { scan2_stageA(L1, lds, pd + 1, pw, lane, nr); if (pd + 3 < nch) scan2_issue(L1, Z, tb, S, lat, dir, h, cb + pd + 3, pw, lane, nr); }
            SCAN_BAR();
        }
    } else if (wid >= 4) {
        for (int pd = 0; pd < nch + 4; ++pd) { const int c = pd - 1; if (c >= 0 && c < nch) scan2_stageB(p, lds, c, wid == 5, tb, S, dir, h, lane, cb, mode == 0); SCAN_BAR(); }
    } else if (mode == 0) {
        for (int pd = 0; pd < nch + 4; ++pd) {
            const int cE = pd - 4, cC = pd - 2, cD = pd - 3;
            if (cE >= 0 && cE < nch) scan2_stageE(lds, cE, wid, lane, P, yout, ystride, tb, S, dir, cb);
            if (cC >= 0 && cC < nch) scan2_stageC(lds, cC, wid, lane);
            if (cD >= 0 && cD < nch) scan2_stageD(lds, cD, wid, lane);
            SCAN_BAR();
        }
        if (!lat) {
#pragma unroll
            for (int mt = 0; mt < 4; ++mt) *(f32x4*)(p.out + (size_t)NTOK * DM + (size_t)dir * 524288 + ((size_t)(b * 8 + h) * 64 + vrow) * 64 + 16 * mt + 4 * q4) = P[mt];
        }
    } else {
        f32x4 X[4];
#pragma unroll
        for (int mt = 0; mt < 4; ++mt)
#pragma unroll
            for (int i = 0; i < 4; ++i) X[mt][i] = (16 * mt + 4 * q4 + i == vrow) ? 1.0f : 0.0f;
        for (int pd = 0; pd < nch + 4; ++pd) {
            const int cE = pd - 4, cC = pd - 2, cD = pd - 3;
            if (cE >= 0 && cE < nch) scan2_stageE1(lds, cE, wid, lane, P, X);
            if (cC >= 0 && cC < nch) { if (wid >= 2) { scan2_stageC(lds, cC, wid, lane); scan2_stageC(lds, cC, wid == 2 ? 1 : 0, lane); } }
            if (cD >= 0 && cD < nch && wid < 2) scan2_stageD(lds, cD, wid, lane);
            SCAN_BAR();
        }
        float* Xg = SEG + (size_t)seg * 8192; float* Ng = Xg + 4096;
#pragma unroll
        for (int mt = 0; mt < 4; ++mt) { *(f32x4*)(Xg + vrow * 64 + 16 * mt + 4 * q4) = X[mt]; *(f32x4*)(Ng + vrow * 64 + 16 * mt + 4 * q4) = P[mt]; }
    }
    SCAN_BAR();
}
__device__ __forceinline__ void scan3_pass1(const Params& p, unsigned char* lds) {
    const int bk = blockIdx.x;
    if (bk < 192) { const int it = bk / 3, seg = bk % 3; scan2_run(p, lds, true, it >> 4, (it >> 1) & 7, it & 1, seg * 64, 64, 1, seg); }
}
__device__ __forceinline__ void scan3_pass2(const Params& p, unsigned char* lds) {
    const int bk = blockIdx.x;
    { const int it = bk >> 2, seg = bk & 3; scan2_run(p, lds, true, it >> 4, (it >> 1) & 7, it & 1, seg * 64, 64, 0, seg); }
    { const int ci = bk; scan2_run(p, lds, false, ci >> 4, (ci >> 1) & 7, ci & 1, 0, 16, 0, 0); }
}
__device__ __forceinline__ void scan2_phase(const Params& p, unsigned char* lds) {
    int tid = threadIdx.x; asm volatile("" : "+v"(tid));
    const int wid = __builtin_amdgcn_readfirstlane(tid >> 6), lane = tid & 63;
    unsigned char* ws = p.ws;
    const bf16_t* Z = (const bf16_t*)(ws + WS_Z);
    const int nbk = gridDim.x, bk = blockIdx.x; const bool bal = nbk == 256;
    for (int it = bk; it < 320; it += nbk) {
        const bool lat = it < 64; const int q_ = lat ? it : it - 64;
        const int dir = q_ & 1, h = (q_ >> 1) & 7, b = q_ >> 4;
        const int S = lat ? 4096 : 256, tb = lat ? NCTX + b * 4096 : b * 256, nch = S >> 4;
        { float* CM = (float*)(lds + S2_CONST); bf16_t* CWT = (bf16_t*)(lds + S2_CONST + 2560);
          if (tid < 320) { const int sec = tid >> 6, j = tid & 63; CM[tid] = p.in[I_MU][(sec < 3 ? sec * 512 + h * 64 : (sec == 3 ? 1536 + dir * 64 : 1664 + dir * 64)) + j]; }
          else if (tid < 384) CM[tid] = p.in[I_KK][h * 64 + tid - 320];
          else if (tid < 448) CM[tid] = p.in[I_KA][h * 64 + tid - 384];
          else CM[tid] = p.in[I_RK][h * 64 + tid - 448];
          if (tid < 128) CM[512 + tid] = (tid < 64 ? p.in[I_W0] : p.in[I_A0])[dir * 512 + h * 64 + (tid & 63)];
          for (int e = tid; e < 1024; e += 512) { const int mat = e >> 9, j = (e >> 3) & 63, i8 = e & 7;
              *(u32x4*)(CWT + mat * 4608 + j * 72 + i8 * 8) = *(const u32x4*)((const bf16_t*)(ws + (mat ? WS_A2T : WS_W2T)) + (size_t)dir * 512 * 64 + (size_t)(h * 64 + j) * 64 + i8 * 8); }
          SCAN_BAR(); }
        bf16_t* yout = dir == 0 ? (bf16_t*)(ws + WS_H) + 512 + h * 64 : (bf16_t*)(ws + WS_Y1) + h * 64; const int ystride = dir == 0 ? DM : DRW;
        if (wid >= 6) {
            Scan2Loads L0, L1; const int pw = wid - 6;
            scan2_issue(L0, Z, tb, S, lat, dir, h, 0, pw, lane); scan2_issue(L1, Z, tb, S, lat, dir, h, 1, pw, lane);
            for (int pd = 0; pd < nch + 4; pd += 2) {
                if (pd < nch) { scan2_stageA(L0, lds, pd, pw, lane); if (pd + 2 < nch) scan2_issue(L0, Z, tb, S, lat, dir, h, pd + 2, pw, lane); }
                SCAN_BAR();
                if (pd + 1 < nch) { scan2_stageA(L1, lds, pd + 1, pw, lane); if (pd + 3 < nch) scan2_issue(L1, Z, tb, S, lat, dir, h, pd + 3, pw, lane); }
                SCAN_BAR();
            }
        } else if (wid >= 4) {
            for (int pd = 0; pd < nch + 4; ++pd) { const int c = pd - 1; if (c >= 0 && c < nch) scan2_stageB(p, lds, c, wid == 5, tb, S, dir, h, lane); SCAN_BAR(); }
        } else {
            f32x4 P[4];
#pragma unroll
            for (int mt = 0; mt < 4; ++mt) P[mt] = (f32x4){0.f, 0.f, 0.f, 0.f};
            const int vrow = 16 * wid + (lane & 15);
            if (lat) {
#pragma unroll
                for (int mt = 0; mt < 4; ++mt) P[mt] = *(const f32x4*)((dir ? p.in[I_SB] : p.in[I_SF]) + ((size_t)(b * 8 + h) * 64 + vrow) * 64 + 16 * mt + 4 * (lane >> 4));
            }
            for (int pd = 0; pd < nch + 4; ++pd) {
                const int cE = pd - 4, cC = pd - 2, cD = pd - 3;
                if (cE >= 0 && cE < nch) scan2_stageE(lds, cE, wid, lane, P, yout, ystride, tb, S, dir);
                if (cC >= 0 && cC < nch) scan2_stageC(lds, cC, wid, lane);
                if (cD >= 0 && cD < nch) scan2_stageD(lds, cD, wid, lane);
                SCAN_BAR();
            }
            if (!lat) {
#pragma unroll
                for (int mt = 0; mt < 4; ++mt) *(f32x4*)(p.out + (size_t)NTOK * DM + (size_t)dir * 524288 + ((size_t)(b * 8 + h) * 64 + vrow) * 64 + 16 * mt + 4 * (lane >> 4)) = P[mt];
            }
        }
        SCAN_BAR();
    }
}

__device__ __forceinline__ void finalize_phase(const Params& p, unsigned char* lds) {
    bf16_t* GA = (bf16_t*)lds;
    const int tid = threadIdx.x, wid = tid >> 6, lane = tid & 63;
    unsigned char* ws = p.ws;
    const bf16_t* Z = (const bf16_t*)(ws + WS_Z); bf16_t* MIX = (bf16_t*)(ws + WS_H); const bf16_t* Y1 = (const bf16_t*)(ws + WS_Y1); const float* BON = (const float*)(ws + WS_BONUS);
    const bf16_t* G2T = (const bf16_t*)(ws + WS_G2T); const float* mu = p.in[I_MU];
    bf16x8 bfr[4][4]; float lw[4], lb[4];
#pragma unroll
    for (int nt = 0; nt < 4; ++nt) { const int c = 64 * wid + 16 * nt + (lane & 15); lw[nt] = p.in[I_LNW][c]; lb[nt] = p.in[I_LNB][c];
#pragma unroll
        for (int k4 = 0; k4 < 4; ++k4) bfr[k4][nt] = *(const bf16x8*)(G2T + (size_t)c * 128 + 32 * k4 + 8 * (lane >> 4)); }
    for (int tile = blockIdx.x; tile < 1280; tile += gridDim.x) {
        const int t0 = tile * 16; const bool lat = t0 >= NCTX;
        const int b = lat ? (t0 - NCTX) >> 12 : t0 >> 8, tb = lat ? NCTX + b * 4096 : b * 256, S = lat ? 4096 : 256, tl0 = t0 - tb;
        for (int e = tid; e < 2048; e += 512) { const int tt = e >> 7, j = e & 127, col = 1792 + j; GA[tt * 136 + j] = f2bf(sigm(zshift(Z, tb, tl0 + tt, S, lat, col, mu[col]))); }
        float ys[4][4], vs[4][4], bon[4];
#pragma unroll
        for (int i = 0; i < 4; ++i) {
            const int tl = tl0 + 4 * (lane >> 4) + i, tg = tb + tl;
            bon[i] = BON[(size_t)tg * 16 + wid] + BON[(size_t)tg * 16 + 8 + wid];
#pragma unroll
            for (int nt = 0; nt < 4; ++nt) { const int c = 64 * wid + 16 * nt + (lane & 15);
                ys[i][nt] = bf2f(MIX[(size_t)tg * DM + 512 + c]) + bf2f(Y1[(size_t)tg * DRW + c]);
                vs[i][nt] = zshift(Z, tb, tl, S, lat, 1024 + c, mu[1024 + c]); }
        }
        __syncthreads();
        f32x4 acc[4];
#pragma unroll
        for (int nt = 0; nt < 4; ++nt) acc[nt] = (f32x4){0.f, 0.f, 0.f, 0.f};
#pragma unroll
        for (int k4 = 0; k4 < 4; ++k4) { const bf16x8 a = *(const bf16x8*)(GA + (lane & 15) * 136 + 32 * k4 + 8 * (lane >> 4));
#pragma unroll
            for (int nt = 0; nt < 4; ++nt) acc[nt] = __builtin_amdgcn_mfma_f32_16x16x32_bf16(a, bfr[k4][nt], acc[nt], 0, 0, 0); }
        bf16_t ov[4][4];
#pragma unroll
        for (int i = 0; i < 4; ++i) {
            const float sm = (ys[i][0] + ys[i][1]) + (ys[i][2] + ys[i][3]);
            const float mean = red16(sm) * (1.0f / 64.0f); float sq = 0.f;
#pragma unroll
            for (int nt = 0; nt < 4; ++nt) { const float d = ys[i][nt] - mean; sq += d * d; }
            const float rstd = rsqrtf(red16(sq) * (1.0f / 64.0f) + 64e-5f);
#pragma unroll
            for (int nt = 0; nt < 4; ++nt) ov[i][nt] = f2bf(((ys[i][nt] - mean) * rstd * lw[nt] + lb[nt] + bon[i] * vs[i][nt]) * acc[nt][i]);
        }
#pragma unroll
        for (int i = 0; i < 4; ++i) { const int tg = tb + tl0 + 4 * (lane >> 4) + i;
#pragma unroll
            for (int nt = 0; nt < 4; ++nt) MIX[(size_t)tg * DM + 512 + 64 * wid + 16 * nt + (lane & 15)] = ov[i][nt]; }
        __syncthreads();
    }
}

#ifndef PROBE_DUP
#define PROBE_DUP 0
#endif
__global__ void __launch_bounds__(512, 2) fwd_megakernel(Params p) {
    extern __shared__ __attribute__((aligned(16))) unsigned char shm[];
    cg::grid_group grid = cg::this_grid();
    unsigned* bar = (unsigned*)(p.ws + WS_BAR);
    volatile PG8_LAS unsigned* st = (volatile PG8_LAS unsigned*)((PG8_LAS unsigned char*)shm + (LDS_BYTES - 16));
    if (threadIdx.x == 0) { st[0] = 0u; st[1] = 0u; }
    PG8_LAS unsigned char* lds3 = (PG8_LAS unsigned char*)shm;
    unsigned char* ws = p.ws; float* out = p.out; const float* mod = (const float*)(ws + WS_MOD);
    const char* H = (const char*)(ws + WS_H); const int G = gridDim.x, c = blockIdx.x;

    __syncthreads();
    const XcdBarrier xb = xcd_barrier_post(bar, st);
    if (p.out == nullptr) grid.sync();
    phase0(p, shm);
    xcd_barrier(xb);
#if PROBE_DUP == 3
    phase0(p, shm);
    xcd_barrier(xb);
#endif
    norm_phase(p.in[I_XP], p.in[I_XS], p.in[I_NORMG], mod, 0, 1024, (bf16_t*)(ws + WS_H));
    for (int e = blockIdx.x * 512 + threadIdx.x; e < 10240; e += gridDim.x * 512) { const int which = e / 5120, r = (e % 5120) >> 10, k = e & 1023;
        ((float*)(ws + WS_GP))[e] = p.in[I_NORMG][(1 + which) * 1024 + k] * (1.0f + mod[r * NMOD + (which ? 7168 : 4096) + k]); }
    __syncthreads();
    ffn_conv(p.in[I_WG], p.in[I_WU], p.in[I_WD], (bf16_t*)(ws + WS_W1GU), (bf16_t*)(ws + WS_W1D), (float*)shm, c, G);
    xcd_barrier(xb);
#if PROBE_DUP == 8
    norm_phase(p.in[I_XP], p.in[I_XS], p.in[I_NORMG], mod, 0, 1024, (bf16_t*)(ws + WS_H));
    xcd_barrier(xb);
#endif
    { SchedPlain S{H, (const char*)(ws + WS_W1GU), 80, 22, DM, G, c}; EpiGU E{(bf16_t*)(ws + WS_ACT)}; pg8::gemm_phase(lds3, DM, S, E); }
    xcd_barrier(xb);
#if PROBE_DUP == 5
    { SchedPlain S{H, (const char*)(ws + WS_W1GU), 80, 22, DM, G, c}; EpiGU E{(bf16_t*)(ws + WS_ACT)}; pg8::gemm_phase(lds3, DM, S, E); }
    xcd_barrier(xb);
#endif
    { SchedPlain S{(const char*)(ws + WS_ACT), (const char*)(ws + WS_W1D), 80, 4, DFF, G, c}; EpiResN E{p.in[I_XP], p.in[I_XS], out, ws, 2048, 0.5f, 0}; pg8::gemm_phase(lds3, DFF, S, E); }
    if (G == 256) { if (c >= 64) phase0b(p, shm, c - 64, 192); } else phase0b(p, shm, c, G);
    xcd_barrier(xb);
#if PROBE_DUP == 6
    { SchedPlain S{(const char*)(ws + WS_ACT), (const char*)(ws + WS_W1D), 80, 4, DFF, G, c}; EpiRes E{p.in[I_XP], p.in[I_XS], out, mod, 2048, 0.5f}; pg8::gemm_phase(lds3, DFF, S, E); }
    xcd_barrier(xb);
#endif
    { SchedWin S{H, (const char*)(ws + WS_WZ), (const char*)(ws + WS_WF), G, c}; EpiWinN E{(bf16_t*)(ws + WS_Z), (bf16_t*)(ws + WS_PT), (const float*)(ws + WS_SSQ), (const float*)(ws + WS_CBW)}; pg8::gemm_phase(lds3, DM, S, E); }
    xcd_barrier(xb);
#if PROBE_DUP == 7
    { SchedWin S{H, (const char*)(ws + WS_WZ), (const char*)(ws + WS_WF), G, c}; EpiWin E{(bf16_t*)(ws + WS_Z), (bf16_t*)(ws + WS_PT)}; pg8::gemm_phase(lds3, DM, S, E); }
    xcd_barrier(xb);
#endif
    if (G == 256) {
        scan3_pass1(p, shm);
        __syncthreads();
        { SchedFourSym S{(const char*)(ws + WS_DLAT), (const char*)(ws + WS_PT) + (size_t)4194304 * 2, c >= 192 ? c - 192 : 1000}; EpiFourSym E{(bf16_t*)(ws + WS_H), 1.0f / 512.0f}; pg8::gemm_phase(lds3, 8192, S, E, 4096); }
        fourier_nyquist((const bf16_t*)(ws + WS_PT) + 4194304, (bf16_t*)(ws + WS_H), 1.0f / 512.0f);
        __syncthreads();
        { SchedFourCtx S{(const char*)(ws + WS_DCTX), (const char*)(ws + WS_PT), 1024, c >= 192 && c < 224 ? c - 192 : 1000}; EpiFour E{(bf16_t*)(ws + WS_H), 1.0f / 128.0f}; pg8::gemm_phase(lds3, 512, S, E); }
        xcd_barrier(xb);
        scan3_pass2(p, shm);
        __syncthreads();
    } else {
    scan2_phase(p, shm);
    __syncthreads();
    { SchedFourLat S{(const char*)(ws + WS_DLAT), (const char*)(ws + WS_PT) + (size_t)4194304 * 2, G, c}; EpiFour E{(bf16_t*)(ws + WS_H), 1.0f / 512.0f}; pg8::gemm_phase(lds3, 8192, S, E); }
    __syncthreads();
    }
#if PROBE_DUP == 2
    { SchedFourLat S{(const char*)(ws + WS_DLAT), (const char*)(ws + WS_PT) + (size_t)4194304 * 2, G, c}; EpiFour E{(bf16_t*)(ws + WS_H), 1.0f / 512.0f}; pg8::gemm_phase(lds3, 8192, S, E); }
    __syncthreads();
#endif
    if (G != 256) { SchedFourCtx S{(const char*)(ws + WS_DCTX), (const char*)(ws + WS_PT), G, c}; EpiFour E{(bf16_t*)(ws + WS_H), 1.0f / 128.0f}; pg8::gemm_phase(lds3, 512, S, E); }
    xcd_barrier(xb);
    finalize_phase(p, shm);
    xcd_barrier(xb);
#if PROBE_DUP == 4
    xcd_barrier(xb); xcd_barrier(xb); xcd_barrier(xb); xcd_barrier(xb); xcd_barrier(xb); xcd_barrier(xb); xcd_barrier(xb); xcd_barrier(xb); xcd_barrier(xb); xcd_barrier(xb);
#endif
    { SchedPlain S{H, (const char*)(ws + WS_WOUT), 80, 4, DM, G, c}; EpiResN E{out, out + (size_t)NCTX * DM, out, ws, 5120, 1.0f, 1}; pg8::gemm_phase(lds3, DM, S, E); }
    __syncthreads();
    if (G == 256) { if (c >= 64) ffn_conv(p.in[I_WG] + (size_t)DM * DFF, p.in[I_WU] + (size_t)DM * DFF, p.in[I_WD] + (size_t)DM * DFF, (bf16_t*)(ws + WS_W2GU), (bf16_t*)(ws + WS_W2D), (float*)shm, c - 64, 192); }
    else ffn_conv(p.in[I_WG] + (size_t)DM * DFF, p.in[I_WU] + (size_t)DM * DFF, p.in[I_WD] + (size_t)DM * DFF, (bf16_t*)(ws + WS_W2GU), (bf16_t*)(ws + WS_W2D), (float*)shm, c, G);
    xcd_barrier(xb);
    { SchedPlain S{(const char*)(ws + WS_XG3), (const char*)(ws + WS_W2GU), 80, 22, DM, G, c}; EpiGUN E{(bf16_t*)(ws + WS_ACT), (const float*)(ws + WS_SSQ), (const float*)(ws + WS_CBG)}; pg8::gemm_phase(lds3, DM, S, E); }
    xcd_barrier(xb);
    { SchedPlain S{(const char*)(ws + WS_ACT), (const char*)(ws + WS_W2D), 80, 4, DFF, G, c}; EpiResB16 E{out, out + (size_t)NCTX * DM, (bf16_t*)(ws + WS_XG3), mod, 8192, 0.5f}; pg8::gemm_phase(lds3, DFF, S, E); }
    xcd_barrier(xb);
    final_norm_phase(out, p.in[I_FN], (const bf16_t*)(ws + WS_XG3));
}

extern "C" void kernel_launch(void* const* d_in, const int* in_sizes, int n_in, void* d_out, int out_size, void* d_ws, size_t ws_size, hipStream_t stream) {
    static int grid_blocks = 0;
    if (grid_blocks == 0) {
        if (n_in != 26 || ws_size < WS_END) { fprintf(stderr, "kernel_launch: unexpected n_in %d / ws_size %zu (need %zu)\n", n_in, ws_size, (size_t)WS_END); grid_blocks = -1; return; }
        int dev = 0, cus = 0, per_cu = 0;
        hipGetDevice(&dev);
        hipDeviceGetAttribute(&cus, hipDeviceAttributeMultiprocessorCount, dev);
        if (hipFuncSetAttribute((const void*)fwd_megakernel, hipFuncAttributeMaxDynamicSharedMemorySize, LDS_BYTES) != hipSuccess) { fprintf(stderr, "kernel_launch: hipFuncSetAttribute failed\n"); grid_blocks = -1; return; }
        if (hipOccupancyMaxActiveBlocksPerMultiprocessor(&per_cu, (const void*)fwd_megakernel, 512, LDS_BYTES) != hipSuccess || per_cu < 1) { fprintf(stderr, "kernel_launch: occupancy query failed (%d)\n", per_cu); grid_blocks = -1; return; }
        grid_blocks = cus * per_cu;
    }
    if (grid_blocks < 0) return;
    Params p{};
    for (int i = 0; i < 26; ++i) p.in[i] = (const float*)d_in[i];
    p.out = (float*)d_out; p.ws = (unsigned char*)d_ws;
    void* args[] = {&p};
    if (hipMemsetAsync((unsigned char*)d_ws + WS_BAR, 0, XCD_BAR_WORDS * sizeof(unsigned), stream) != hipSuccess) { fprintf(stderr, "kernel_launch: hipMemsetAsync of the barrier words failed\n"); return; }
    hipError_t e = hipLaunchCooperativeKernel((const void*)fwd_megakernel, dim3(grid_blocks), dim3(512), args, LDS_BYTES, stream);
    if (e != hipSuccess) fprintf(stderr, "cooperative launch failed: %s (grid %d)\n", hipGetErrorString(e), grid_blocks);
}
```

```cpp
#include <hip/hip_runtime.h>
#include <hip/hip_cooperative_groups.h>
#include <cstdio>
namespace cg = cooperative_groups;

namespace pg8 {
#define PG8_LAS __attribute__((address_space(3)))
typedef unsigned short bf16_t;
typedef short bf16x8 __attribute__((ext_vector_type(8)));
typedef float f32x4 __attribute__((ext_vector_type(4)));
typedef unsigned u32x4 __attribute__((ext_vector_type(4)));
typedef unsigned u32x2 __attribute__((ext_vector_type(2)));
constexpr int BM = 256, BK = 64, HALF = 128, HTB = HALF * BK * 2, STAGE_BYTES = 8 * HTB, NXCD = 8, WGM = 4;

__host__ __device__ __forceinline__ int lds_byte(int r, int c) { const int st = (r >> 4) * 2 + (c >> 5), rr = r & 15, cc = c & 31, ob = rr * 64 + cc * 2; return st * 1024 + (ob ^ (((ob >> 9) & 1) << 5)); }
__host__ __device__ __forceinline__ void stage_rc(int b, int& R, int& C) { const int st = b / 1024, sb = b % 1024, swz = sb ^ (((sb >> 9) & 1) << 5); R = (st >> 1) * 16 + swz / 64; C = (st & 1) * 32 + (swz % 64) / 2; }
__host__ __device__ __forceinline__ int perm32(int rho) { const int n = rho >> 4, i = rho & 15; return 8 * (i >> 2) + 4 * n + (i & 3); }

struct Unit { int pm, pn, kind, aux; const char* a; const char* b; };

__device__ __forceinline__ void tile_of(int wgid, int nM, int nN, int& pm, int& pn) {
    const int nwg = nM * nN;
    { const int q = nwg / NXCD, r = nwg % NXCD, xcd = wgid % NXCD, off = wgid / NXCD; wgid = (xcd < r ? xcd * (q + 1) : r * (q + 1) + (xcd - r) * q) + off; }
    const int nig = WGM * nN, gid = wgid / nig, fm = gid * WGM, gsz = (nM - fm) < WGM ? (nM - fm) : WGM;
    pm = fm + ((wgid % nig) % gsz); pn = (wgid % nig) / gsz;
}
typedef __bf16 bf16v2_t __attribute__((ext_vector_type(2)));
__device__ __forceinline__ unsigned cvt_pk_bf16(float lo, float hi) { const bf16v2_t v = {(__bf16)lo, (__bf16)hi}; return __builtin_bit_cast(unsigned, v); }

template <class Epi, class Sched>
__device__ __forceinline__ void gemm_phase(PG8_LAS unsigned char* lds, const int K, const Sched& S, const Epi& E, const int KL = 0) {
    int tid = threadIdx.x; asm volatile("" : "+v"(tid));
    const int wid = __builtin_amdgcn_readfirstlane(tid >> 6), lane = tid & 63, wr = wid >> 2, wc = wid & 3, fr = lane & 15, fq = lane >> 4;
    const int nt = (KL ? KL : K) / BK;
#define PG8_STAMP() do {} while (0)
    PG8_STAMP();
    unsigned voffA[2], voffB[2];
#pragma unroll
    for (int i = 0; i < 2; ++i) { int R, C; stage_rc(tid * 16 + i * 8192, R, C); const int Rb = Epi::PERM ? ((R & ~31) + perm32(R & 31)) : R;
        voffA[i] = (unsigned)(R * K + C) * 2u; voffB[i] = (unsigned)(Rb * K + C) * 2u; }
    const size_t kstep = (size_t)(BK * 2);
    const size_t hstep = (size_t)HALF * K * 2;
    const unsigned ldsw = (unsigned)wid * 1024u;
    const int aoff = lds_byte(wr * 64 + fr, fq * 8), boff = lds_byte(wc * 32 + fr, fq * 8);
#define PG8_SA(b, h) (((b) * 2 + (h)) * HTB)
#define PG8_SB(b, h) ((4 + (b) * 2 + (h)) * HTB)
#define PG8_STAGE(bufoff, gbase, voff) do { _Pragma("unroll") for (int _i = 0; _i < 2; ++_i) \
        __builtin_amdgcn_global_load_lds((const unsigned*)((const char*)(gbase) + (voff)[_i]), (PG8_LAS unsigned*)(lds + (bufoff) + ldsw + _i * 8192), 16, 0, 0); } while (0)
#define PG8_LDA(dst, b, h) do { _Pragma("unroll") for (int m = 0; m < 4; ++m) _Pragma("unroll") for (int k = 0; k < 2; ++k) dst[m][k] = *(const PG8_LAS bf16x8*)(lds + PG8_SA(b, h) + aoff + m * 2048 + k * 1024); } while (0)
#define PG8_LDB(dst, b, h) do { _Pragma("unroll") for (int n = 0; n < 2; ++n) _Pragma("unroll") for (int k = 0; k < 2; ++k) dst[n][k] = *(const PG8_LAS bf16x8*)(lds + PG8_SB(b, h) + boff + n * 2048 + k * 1024); } while (0)
#define PG8_MMA(ai, bj, At, Bt) do { __builtin_amdgcn_s_setprio(1); _Pragma("unroll") for (int m = 0; m < 4; ++m) _Pragma("unroll") for (int n = 0; n < 2; ++n) _Pragma("unroll") for (int k = 0; k < 2; ++k) \
        acc[ai][bj][m][n] = __builtin_amdgcn_mfma_f32_16x16x32_bf16(Bt[n][k], At[m][k], acc[ai][bj][m][n], 0, 0, 0); __builtin_amdgcn_s_setprio(0); } while (0)
#define PG8_WAIT_V(n) asm volatile("s_waitcnt vmcnt(" #n ")" ::: "memory")
#define PG8_WAIT_L(n) asm volatile("s_waitcnt lgkmcnt(" #n ")" ::: "memory")
#define PG8_BAR __builtin_amdgcn_s_barrier()
#define PG8_SCHED __builtin_amdgcn_sched_barrier(0)
    Unit cur, nxt; int ui = 0;
    if (!S.next(0, cur)) return;
    f32x4 acc[2][2][4][2];
#pragma unroll
    for (int a = 0; a < 2; ++a)
#pragma unroll
        for (int b = 0; b < 2; ++b)
#pragma unroll
            for (int m = 0; m < 4; ++m)
#pragma unroll
                for (int n = 0; n < 2; ++n) acc[a][b][m][n] = (f32x4){0.f, 0.f, 0.f, 0.f};
    bf16x8 At[4][2], B0[2][2], B1[2][2];
    const char* cA = cur.a; const char* cB = cur.b;
    PG8_STAGE(PG8_SB(0, 0), cB, voffB); PG8_STAGE(PG8_SA(0, 0), cA, voffA); PG8_STAGE(PG8_SB(0, 1), cB + hstep, voffB); PG8_STAGE(PG8_SA(0, 1), cA + hstep, voffA);
    if (wr == 1) PG8_BAR;
    PG8_WAIT_V(4); PG8_BAR;
    PG8_STAGE(PG8_SB(1, 0), cB + kstep, voffB); PG8_STAGE(PG8_SA(1, 0), cA + kstep, voffA); PG8_STAGE(PG8_SB(1, 1), cB + hstep + kstep, voffB);
    PG8_WAIT_V(6); PG8_BAR;
    PG8_STAMP();
    for (;;) {
        const bool has_next = S.next(ui + 1, nxt);
        const char* nA = has_next ? nxt.a : cA; const char* nB = has_next ? nxt.b : cB;
        for (int t = 0; t < nt; t += 2) {
            const bool last = (t == nt - 2);
            const char* a1 = cA + (size_t)(t + 1) * kstep;
            const char* a2 = last ? nA : cA + (size_t)(t + 2) * kstep; const char* b2 = last ? nB : cB + (size_t)(t + 2) * kstep;
            const char* a3 = a2 + kstep; const char* b3 = b2 + kstep;
            PG8_LDB(B0, 0, 0); PG8_SCHED; PG8_LDA(At, 0, 0); PG8_STAGE(PG8_SA(1, 1), a1 + hstep, voffA);
            PG8_WAIT_L(8); PG8_BAR; PG8_WAIT_L(0); PG8_MMA(0, 0, At, B0); PG8_BAR; PG8_SCHED;
            PG8_LDB(B1, 0, 1); PG8_STAGE(PG8_SB(0, 0), b2, voffB);
            PG8_BAR; PG8_WAIT_L(0); PG8_MMA(0, 1, At, B1); PG8_BAR;
            PG8_LDA(At, 0, 1); PG8_STAGE(PG8_SA(0, 0), a2, voffA);
            PG8_BAR; PG8_WAIT_L(0); PG8_MMA(1, 0, At, B0); PG8_BAR; PG8_SCHED;
            PG8_STAGE(PG8_SB(0, 1), b2 + hstep, voffB);
            PG8_WAIT_V(6); PG8_BAR; PG8_MMA(1, 1, At, B1); PG8_BAR;
            PG8_LDB(B0, 1, 0); PG8_SCHED; PG8_LDA(At, 1, 0); PG8_STAGE(PG8_SA(0, 1), a2 + hstep, voffA);
            PG8_WAIT_L(8); PG8_BAR; PG8_WAIT_L(0); PG8_MMA(0, 0, At, B0); PG8_BAR; PG8_SCHED;
            PG8_LDB(B1, 1, 1); PG8_STAGE(PG8_SB(1, 0), b3, voffB);
            PG8_BAR; PG8_WAIT_L(0); PG8_MMA(0, 1, At, B1); PG8_BAR;
            PG8_LDA(At, 1, 1); PG8_STAGE(PG8_SA(1, 0), a3, voffA);
            PG8_BAR; PG8_WAIT_L(0); PG8_MMA(1, 0, At, B0); PG8_BAR; PG8_SCHED;
            PG8_STAGE(PG8_SB(1, 1), b3 + hstep, voffB);
            PG8_WAIT_V(6); PG8_BAR; PG8_MMA(1, 1, At, B1); PG8_BAR;
        }
        PG8_STAMP();
        { int fr2 = lane & 15, fq2 = lane >> 4; asm volatile("" : "+v"(fr2), "+v"(fq2)); E(acc, cur, wr, wc, fr2, fq2); }
        PG8_STAMP();
        if (!has_next) break;
        if (nxt.kind != 3) {
#pragma unroll
        for (int a = 0; a < 2; ++a)
#pragma unroll
            for (int b = 0; b < 2; ++b)
#pragma unroll
                for (int m = 0; m < 4; ++m)
#pragma unroll
                    for (int n = 0; n < 2; ++n) acc[a][b][m][n] = (f32x4){0.f, 0.f, 0.f, 0.f};
        }
        cur = nxt; cA = nA; cB = nB; ++ui;
    }
    PG8_WAIT_V(0);
    if (wr == 0) PG8_BAR;
    PG8_BAR;
    PG8_STAMP();
#undef PG8_STAMP
#undef PG8_SA
#undef PG8_SB
#undef PG8_STAGE
#undef PG8_LDA
#undef PG8_LDB
#undef PG8_MMA
#undef PG8_WAIT_V
#undef PG8_WAIT_L
#undef PG8_BAR
#undef PG8_SCHED
}
}
#define XB_TMO      128
#define XB_XCNT(j)  (256  + 64 * (j))
#define XB_XSUB(j)  (1280 + 64 * (j))
#define XB_XGEN(j)  (2304 + 64 * (j))
#define XB_TOP      3328
#define XB_TOPGEN   3392
#define XCD_BAR_WORDS 3456
#define XB_SPIN_CAP (1u << 18)
#define LAS PG8_LAS

__device__ __forceinline__ unsigned xb_ld(unsigned* p)              { return __hip_atomic_load(p, __ATOMIC_RELAXED, __HIP_MEMORY_SCOPE_AGENT); }
__device__ __forceinline__ unsigned xb_add(unsigned* p, unsigned v) { return __hip_atomic_fetch_add(p, v, __ATOMIC_RELAXED, __HIP_MEMORY_SCOPE_AGENT); }
__device__ __forceinline__ unsigned xb_xcc_id() { return (unsigned)__builtin_amdgcn_s_getreg((3 << 11) | 20) & 0xFu; }
#define XB_SPIN(cond, bar) do { unsigned _sp = 0; while (cond) { __builtin_amdgcn_s_sleep(1); \
    if ((++_sp & 255u) == 0u) { if (xb_ld(&(bar)[XB_TMO])) break; if (_sp > XB_SPIN_CAP) { atomicAdd(&(bar)[XB_TMO], 1u); break; } } } } while (0)

struct XcdBarrier {
    unsigned* bar; unsigned x;
    volatile LAS unsigned* st;
};

__device__ __forceinline__ XcdBarrier xcd_barrier_post(unsigned* bar, volatile LAS unsigned* st) {
    XcdBarrier b; b.bar = bar; b.x = xb_xcc_id(); b.st = st;
    if (threadIdx.x == 0) (void)xb_add(&bar[XB_XCNT(b.x)], 1u);
    return b;
}
__device__ __forceinline__ void xcd_barrier_complete(unsigned* bar, unsigned x, unsigned& nloc, unsigned& nx) {
    const unsigned G = gridDim.x * gridDim.y * gridDim.z;
    unsigned sum, cnt, mine, sp = 0u;
    for (;;) {
        sum = 0u; cnt = 0u; mine = 0u;
#pragma unroll
        for (unsigned j = 0; j < 16; ++j) { const unsigned c = xb_ld(&bar[XB_XCNT(j)]); sum += c; cnt += (c > 0u) ? 1u : 0u; mine = (j == x) ? c : mine; }
        if (sum == G) break;
        __builtin_amdgcn_s_sleep(1);
        if ((++sp & 255u) == 0u) { if (xb_ld(&bar[XB_TMO])) break; if (sp > XB_SPIN_CAP) { atomicAdd(&bar[XB_TMO], 1u); break; } }
    }
    nloc = mine > 0u ? mine : 1u; nx = cnt > 0u ? cnt : 1u;
}

__device__ __forceinline__ void xcd_barrier(const XcdBarrier& b) {
    asm volatile("s_waitcnt vmcnt(0)" ::: "memory");
    __syncthreads();
    if (threadIdx.x == 0) {
        unsigned* bar = b.bar;
        __builtin_amdgcn_s_waitcnt(0);
        unsigned nloc = b.st[0], nx = b.st[1];
        if (nloc == 0u) { xcd_barrier_complete(bar, b.x, nloc, nx); b.st[0] = nloc; b.st[1] = nx; }
        const unsigned old = xb_add(&bar[XB_XSUB(b.x)], 1u);
        const unsigned gen = old / nloc;
        if (old + 1u == (gen + 1u) * nloc) {
            __builtin_amdgcn_fence(__ATOMIC_RELEASE, "agent");
            asm volatile("s_waitcnt vmcnt(0)" ::: "memory");
            const unsigned og = xb_add(&bar[XB_TOP], 1u);
            const unsigned tg = og / nx;
            if (og + 1u == (tg + 1u) * nx) xb_add(&bar[XB_TOPGEN], 1u);
            else XB_SPIN(xb_ld(&bar[XB_TOPGEN]) == tg, bar);
            __builtin_amdgcn_fence(__ATOMIC_ACQUIRE, "agent");
            xb_add(&bar[XB_XGEN(b.x)], 1u);
            asm volatile("s_waitcnt vmcnt(0)" ::: "memory");
        } else {
            XB_SPIN(xb_ld(&bar[XB_XGEN(b.x)]) == gen, bar);
            __builtin_amdgcn_fence(__ATOMIC_ACQUIRE, "agent");
            asm volatile("s_waitcnt vmcnt(0)" ::: "memory");
        }
    }
    __syncthreads();
}


using pg8::bf16_t; using pg8::bf16x8; using pg8::f32x4; using pg8::u32x4; using pg8::u32x2; using pg8::Unit; using pg8::cvt_pk_bf16;

constexpr int NTOK = 20480, NCTX = 4096, DM = 1024, DFF = 2816, DRW = 512, DZ = 1920, NMOD = 9216;
constexpr int LDS_BYTES = 157440 + 16;
constexpr size_t WS_MOD = 0, WS_BONUS = 262144, WS_W2T = 1572864, WS_A2T = 1703936, WS_G2T = 1835008, WS_DCTX = 1966080, WS_WOUT = 2228224,
    WS_EARLY = 4325376, WS_W1GU = WS_EARLY, WS_W1D = WS_W1GU + 11534336, WS_WZ = WS_W1D + 5767168, WS_WF = WS_WZ + 4194304, WS_Y1 = WS_EARLY,
    WS_H = 27918336, WS_BIG = 69861376, WS_Z = WS_BIG, WS_PT = WS_Z + 78643200, WS_DLAT = WS_PT + 41943040, WS_ACT = WS_BIG,
    WS_W2GU = WS_DLAT, WS_W2D = WS_W2GU + 11534336, WS_BAR = WS_DLAT + 67108864, WS_SEG = WS_BAR + 16384, WS_SSQ = WS_SEG + 6291456, WS_CBW = WS_SSQ + 1310720, WS_CBG = WS_CBW + 61440, WS_GP = WS_CBG + 112640, WS_END = WS_GP + 40960,
    WS_XG3 = WS_DLAT + 20971520;
static_assert(WS_WF + 2097152 <= WS_H && WS_ACT + (size_t)NTOK * DFF * 2 <= WS_DLAT && WS_END <= 268435456, "workspace map");

struct Params { const float* in[26]; float* out; unsigned char* ws; };
enum { I_XP = 0, I_XS, I_SF, I_SB, I_C, I_CCTX, I_WMOD, I_BMOD, I_NORMG, I_WG, I_WU, I_WD, I_WIN, I_MU, I_W0, I_W2, I_A0, I_A2, I_G2, I_KK, I_KA, I_RK, I_LNW, I_LNB, I_WOUT, I_FN };

__device__ __forceinline__ float bf2f(bf16_t v) { return __uint_as_float(((unsigned)v) << 16); }
__device__ __forceinline__ bf16_t f2bf(float f) { unsigned u = __float_as_uint(f); u += 0x7FFFu + ((u >> 16) & 1u); return (bf16_t)(u >> 16); }
__device__ __forceinline__ float sigm(float x) { return __builtin_amdgcn_rcpf(1.0f + __expf(-x)); }
__device__ __forceinline__ float wave_sum(float x) {
#pragma unroll
    for (int o = 32; o > 0; o >>= 1) x += __shfl_xor(x, o);
    return x;
}
template <int CTRL> __device__ __forceinline__ float dpp_mov(float x) { return __int_as_float(__builtin_amdgcn_update_dpp(0, __float_as_int(x), CTRL, 0xF, 0xF, true)); }
__device__ __forceinline__ float red16(float x) { x += dpp_mov<0xB1>(x); x += dpp_mov<0x4E>(x); x += dpp_mov<0x141>(x); x += dpp_mov<0x140>(x); return x; }

__device__ __forceinline__ float zshift(const bf16_t* __restrict__ Z, int tb, int t, int S, bool grid, int col, float mu) {
    const float z0 = bf2f(Z[(size_t)(tb + t) * DZ + col]);
    const int d = col & 3; int tn; bool ok;
    if (!grid) { if (d & 1) { tn = t + 1; ok = tn < S; } else { tn = t - 1; ok = tn >= 0; } }
    else { if (d == 0) { tn = t - 1; ok = (t & 63) != 0; } else if (d == 1) { tn = t + 1; ok = (t & 63) != 63; } else if (d == 2) { tn = t - 64; ok = t >= 64; } else { tn = t + 64; ok = t < S - 64; } }
    const float zn = ok ? bf2f(Z[(size_t)(tb + tn) * DZ + col]) : 0.0f;
    return z0 + mu * (zn - z0);
}

struct SchedPlain { const char* A; const char* B; int nM, nN, K, G, c;
    __device__ __forceinline__ bool next(int i, Unit& u) const { const long L = (long)i * G + c; if (L >= (long)nM * nN) return false;
        pg8::tile_of((int)L, nM, nN, u.pm, u.pn); u.kind = 0; u.aux = 0; u.a = A + (size_t)u.pm * 512 * K; u.b = B + (size_t)u.pn * 512 * K; return true; } };
struct SchedSplitK { const char* A; const char* B; int nM, nN, K, KS, G, c;
    __device__ __forceinline__ bool next(int i, Unit& u) const { const long L = (long)i * G + c; if (L >= (long)nM * nN * KS) return false;
        const int kh = (int)(L % KS); pg8::tile_of((int)(L / KS), nM, nN, u.pm, u.pn); u.kind = 0; u.aux = kh;
        u.a = A + (size_t)u.pm * 512 * K + (size_t)kh * (K / KS) * 2; u.b = B + (size_t)u.pn * 512 * K + (size_t)kh * (K / KS) * 2; return true; } };
struct SchedWin { const char* H; const char* WZ; const char* WF; int G, c;
    __device__ __forceinline__ bool next(int i, Unit& u) const { const long L = (long)i * G + c; if (L >= 960) return false;
        if (L < 640) { pg8::tile_of((int)L, 80, 8, u.pm, u.pn); u.kind = 0; u.a = H + (size_t)u.pm * 524288; u.b = WZ + (size_t)u.pn * 524288; }
        else { pg8::tile_of((int)L - 640, 4, 80, u.pm, u.pn); u.kind = 1; u.a = WF + (size_t)u.pm * 524288; u.b = H + (size_t)u.pn * 524288; }
        u.aux = 0; return true; } };
struct SchedFourLat { const char* D; const char* PT; int G, c;
    __device__ __forceinline__ bool next(int i, Unit& u) const { const long L = (long)i * G + c; if (L >= 128) return false;
        const int b = (int)L >> 5, r = (int)L & 31; u.pm = r & 15; u.pn = r >> 4; u.kind = 0; u.aux = NCTX + b * 4096;
        u.a = D + (size_t)u.pm * 256 * 8192 * 2; u.b = PT + ((size_t)b * 512 + u.pn * 256) * 8192 * 2; return true; } };
struct SchedFourCtx { const char* D; const char* PT; int G, c;
    __device__ __forceinline__ bool next(int i, Unit& u) const { const long L = (long)i * G + c; if (L >= 32) return false;
        const int b = (int)L >> 1; u.pm = 0; u.pn = (int)L & 1; u.kind = 0; u.aux = b * 256;
        u.a = D; u.b = PT + ((size_t)b * 512 + u.pn * 256) * 512 * 2; return true; } };

struct EpiGU {
    static constexpr bool PERM = true; bf16_t* ACT;
    __device__ __forceinline__ void operator()(const f32x4 (&acc)[2][2][4][2], const Unit& u, int wr, int wc, int fr, int fq) const {
        const int row0 = u.pm * 256 + wr * 64 + fr, col0 = u.pn * 128 + wc * 32 + fq * 8;
#pragma unroll
        for (int ai = 0; ai < 2; ++ai)
#pragma unroll
            for (int m = 0; m < 4; ++m) {
                float o[8];
#pragma unroll
                for (int n = 0; n < 2; ++n)
#pragma unroll
                    for (int j = 0; j < 4; ++j) { const float g = acc[ai][0][m][n][j], uu = acc[ai][1][m][n][j]; o[n * 4 + j] = g * sigm(g) * uu; }
                u32x4 w; w.x = cvt_pk_bf16(o[0], o[1]); w.y = cvt_pk_bf16(o[2], o[3]); w.z = cvt_pk_bf16(o[4], o[5]); w.w = cvt_pk_bf16(o[6], o[7]);
                *(u32x4*)(ACT + (size_t)(row0 + ai * 128 + m * 16) * DFF + col0) = w;
            }
    }
};
struct EpiRes {
    static constexpr bool PERM = true; const float* xa; const float* xb; float* out; const float* mod; int goff; float scale;
    __device__ __forceinline__ void operator()(const f32x4 (&acc)[2][2][4][2], const Unit& u, int wr, int wc, int fr, int fq) const {
        const int mi = u.pm < 16 ? 0 : 1 + ((u.pm - 16) >> 4);
        const int row0 = u.pm * 256 + wr * 64 + fr, col0 = u.pn * 256 + wc * 32 + fq * 8;
        f32x4 gv[2][2];
#pragma unroll
        for (int bj = 0; bj < 2; ++bj)
#pragma unroll
            for (int n = 0; n < 2; ++n) gv[bj][n] = *(const f32x4*)(mod + mi * NMOD + goff + col0 + bj * 128 + n * 4) * scale;
        const bool lo = (u.pm * 256) < NCTX;
        const float* sbase = (lo ? xa + (size_t)row0 * DM : xb + (size_t)(row0 - NCTX) * DM) + col0;
        float* obase = out + (size_t)row0 * DM + col0;
        f32x4 xv[2][2], nx[2][2];
#pragma unroll
        for (int bj = 0; bj < 2; ++bj)
#pragma unroll
            for (int n = 0; n < 2; ++n) xv[bj][n] = *(const f32x4*)(sbase + bj * 128 + n * 4);
#pragma unroll
        for (int r = 0; r < 8; ++r) {
            const int ai = r >> 2, m = r & 3;
            if (r < 7) { const int r1 = r + 1; const float* sp = sbase + (size_t)((r1 >> 2) * 128 + (r1 & 3) * 16) * DM;
#pragma unroll
                for (int bj = 0; bj < 2; ++bj)
#pragma unroll
                    for (int n = 0; n < 2; ++n) nx[bj][n] = *(const f32x4*)(sp + bj * 128 + n * 4); }
            float* op = obase + (size_t)(ai * 128 + m * 16) * DM;
#pragma unroll
            for (int bj = 0; bj < 2; ++bj)
#pragma unroll
                for (int n = 0; n < 2; ++n) *(f32x4*)(op + bj * 128 + n * 4) = xv[bj][n] + gv[bj][n] * acc[ai][bj][m][n];
#pragma unroll
            for (int bj = 0; bj < 2; ++bj)
#pragma unroll
                for (int n = 0; n < 2; ++n) xv[bj][n] = nx[bj][n];
        }
    }
};
struct SchedFourSym { const char* D; const char* PT; int pair;
    __device__ __forceinline__ bool next(int i, Unit& u) const { if (pair >= 64 || i >= 2) return false;
        const int b = pair >> 4; u.pm = pair & 7; u.pn = (pair >> 3) & 1; u.kind = 2 + i; u.aux = NCTX + b * 4096;
        u.a = D + (size_t)u.pm * 256 * 8192 * 2 + (size_t)i * 8192; u.b = PT + ((size_t)b * 512 + u.pn * 256) * 8192 * 2 + (size_t)i * 8192; return true; } };
struct EpiFourSym {
    static constexpr bool PERM = true; bf16_t* MIX; float scale;
    __device__ __forceinline__ void operator()(const f32x4 (&acc)[2][2][4][2], const Unit& u, int wr, int wc, int fr, int fq) const {
        const int s0 = u.pm * 256 + wr * 64 + fr, col0 = u.pn * 256 + wc * 32 + fq * 8;
        if (u.kind == 2) {
#pragma unroll
            for (int ai = 0; ai < 2; ++ai)
#pragma unroll
                for (int m = 0; m < 4; ++m) { const int sp = s0 + ai * 128 + m * 16;
                    if (sp > 0) { bf16_t* mp = MIX + (size_t)(u.aux + 4096 - sp) * DM + col0;
#pragma unroll
                        for (int bj = 0; bj < 2; ++bj) { const f32x4 v0 = acc[ai][bj][m][0] * scale, v1 = acc[ai][bj][m][1] * scale;
                            u32x4 w; w.x = cvt_pk_bf16(v0[0], v0[1]); w.y = cvt_pk_bf16(v0[2], v0[3]); w.z = cvt_pk_bf16(v1[0], v1[1]); w.w = cvt_pk_bf16(v1[2], v1[3]);
                            *(u32x4*)(mp + bj * 128) = w; } } }
        } else {
            u32x4 yc[2][4][2];
#pragma unroll
            for (int ai = 0; ai < 2; ++ai)
#pragma unroll
                for (int m = 0; m < 4; ++m) { const int sp = s0 + ai * 128 + m * 16; const bf16_t* mp = MIX + (size_t)(u.aux + (sp > 0 ? 4096 - sp : 0)) * DM + col0;
#pragma unroll
                    for (int bj = 0; bj < 2; ++bj) yc[ai][m][bj] = *(const u32x4*)(mp + bj * 128); }
#pragma unroll
            for (int ai = 0; ai < 2; ++ai)
#pragma unroll
                for (int m = 0; m < 4; ++m) { const int sp = s0 + ai * 128 + m * 16; bf16_t* yp = MIX + (size_t)(u.aux + sp) * DM + col0; bf16_t* mp = MIX + (size_t)(u.aux + 4096 - sp) * DM + col0;
#pragma unroll
                    for (int bj = 0; bj < 2; ++bj) { const f32x4 v0 = acc[ai][bj][m][0] * scale, v1 = acc[ai][bj][m][1] * scale; const u32x4 c = yc[ai][m][bj];
                        u32x4 w; w.x = cvt_pk_bf16(v0[0], v0[1]); w.y = cvt_pk_bf16(v0[2], v0[3]); w.z = cvt_pk_bf16(v1[0], v1[1]); w.w = cvt_pk_bf16(v1[2], v1[3]);
                        *(u32x4*)(yp + bj * 128) = w;
                        if (sp > 0) { u32x4 x;
                            x.x = cvt_pk_bf16(2.0f * __uint_as_float(c.x << 16) - v0[0], 2.0f * __uint_as_float(c.x & 0xFFFF0000u) - v0[1]);
                            x.y = cvt_pk_bf16(2.0f * __uint_as_float(c.y << 16) - v0[2], 2.0f * __uint_as_float(c.y & 0xFFFF0000u) - v0[3]);
                            x.z = cvt_pk_bf16(2.0f * __uint_as_float(c.z << 16) - v1[0], 2.0f * __uint_as_float(c.z & 0xFFFF0000u) - v1[1]);
                            x.w = cvt_pk_bf16(2.0f * __uint_as_float(c.w << 16) - v1[2], 2.0f * __uint_as_float(c.w & 0xFFFF0000u) - v1[3]);
                            *(u32x4*)(mp + bj * 128) = x; } } }
        }
    }
};
__device__ __forceinline__ void fourier_nyquist(const bf16_t* PTlat, bf16_t* MIX, float scale) {
    const int lane = threadIdx.x & 63, gw = blockIdx.x * 8 + (threadIdx.x >> 6), nw = gridDim.x * 8;
    for (int r = gw; r < 2048; r += nw) { const int b = r >> 9, ch = r & 511; const bf16_t* row = PTlat + ((size_t)b * 512 + ch) * 8192;
        float sm = 0.f;
#pragma unroll
        for (int i = 0; i < 8; ++i) { const u32x4 v = *(const u32x4*)(row + (i * 64 + lane) * 8);
            sm += (__uint_as_float(v.x << 16) - __uint_as_float(v.x & 0xFFFF0000u)) + (__uint_as_float(v.y << 16) - __uint_as_float(v.y & 0xFFFF0000u))
                + (__uint_as_float(v.z << 16) - __uint_as_float(v.z & 0xFFFF0000u)) + (__uint_as_float(v.w << 16) - __uint_as_float(v.w & 0xFFFF0000u)); }
        sm = wave_sum(sm);
        if (lane == 0) MIX[(size_t)(NCTX + b * 4096 + 2048) * DM + ch] = f2bf(sm * scale); }
}
struct EpiResB16 {
    static constexpr bool PERM = true; const float* xa; const float* xb; bf16_t* X3; const float* mod; int goff; float scale;
    __device__ __forceinline__ void operator()(const f32x4 (&acc)[2][2][4][2], const Unit& u, int wr, int wc, int fr, int fq) const {
        const int mi = u.pm < 16 ? 0 : 1 + ((u.pm - 16) >> 4);
        const int row0 = u.pm * 256 + wr * 64 + fr, col0 = u.pn * 256 + wc * 32 + fq * 8;
        f32x4 gv[2][2];
#pragma unroll
        for (int bj = 0; bj < 2; ++bj)
#pragma unroll
            for (int n = 0; n < 2; ++n) gv[bj][n] = *(const f32x4*)(mod + mi * NMOD + goff + col0 + bj * 128 + n * 4) * scale;
        const bool lo = (u.pm * 256) < NCTX;
        const float* sbase = (lo ? xa + (size_t)row0 * DM : xb + (size_t)(row0 - NCTX) * DM) + col0;
        bf16_t* obase = X3 + (size_t)row0 * DM + col0;
        f32x4 xv[2][2], nx[2][2];
#pragma unroll
        for (int bj = 0; bj < 2; ++bj)
#pragma unroll
            for (int n = 0; n < 2; ++n) xv[bj][n] = *(const f32x4*)(sbase + bj * 128 + n * 4);
#pragma unroll
        for (int r = 0; r < 8; ++r) {
            const int ai = r >> 2, m = r & 3;
            if (r < 7) { const int r1 = r + 1; const float* sp = sbase + (size_t)((r1 >> 2) * 128 + (r1 & 3) * 16) * DM;
#pragma unroll
                for (int bj = 0; bj < 2; ++bj)
#pragma unroll
                    for (int n = 0; n < 2; ++n) nx[bj][n] = *(const f32x4*)(sp + bj * 128 + n * 4); }
            bf16_t* op = obase + (size_t)(ai * 128 + m * 16) * DM;
#pragma unroll
            for (int bj = 0; bj < 2; ++bj) { const f32x4 v0 = xv[bj][0] + gv[bj][0] * acc[ai][bj][m][0], v1 = xv[bj][1] + gv[bj][1] * acc[ai][bj][m][1];
                u32x4 w; w.x = cvt_pk_bf16(v0[0], v0[1]); w.y = cvt_pk_bf16(v0[2], v0[3]); w.z = cvt_pk_bf16(v1[0], v1[1]); w.w = cvt_pk_bf16(v1[2], v1[3]);
                *(u32x4*)(op + bj * 128) = w; }
#pragma unroll
            for (int bj = 0; bj < 2; ++bj)
#pragma unroll
                for (int n = 0; n < 2; ++n) xv[bj][n] = nx[bj][n];
        }
    }
};
struct EpiResAtomic {
    static constexpr bool PERM = true; float* out; const float* mod; int goff; float scale;
    __device__ __forceinline__ void operator()(const f32x4 (&acc)[2][2][4][2], const Unit& u, int wr, int wc, int fr, int fq) const {
        const int mi = u.pm < 16 ? 0 : 1 + ((u.pm - 16) >> 4);
        const int row0 = u.pm * 256 + wr * 64 + fr, col0 = u.pn * 256 + wc * 32 + fq * 8;
        f32x4 gv[2][2];
#pragma unroll
        for (int bj = 0; bj < 2; ++bj)
#pragma unroll
            for (int n = 0; n < 2; ++n) gv[bj][n] = *(const f32x4*)(mod + mi * NMOD + goff + col0 + bj * 128 + n * 4) * scale;
#pragma unroll
        for (int ai = 0; ai < 2; ++ai)
#pragma unroll
            for (int m = 0; m < 4; ++m) {
                float* op = out + (size_t)(row0 + ai * 128 + m * 16) * DM + col0;
#pragma unroll
                for (int bj = 0; bj < 2; ++bj)
#pragma unroll
                    for (int n = 0; n < 2; ++n) { const f32x4 v = gv[bj][n] * acc[ai][bj][m][n];
#pragma unroll
                        for (int j = 0; j < 4; ++j) unsafeAtomicAdd(op + bj * 128 + n * 4 + j, v[j]); }
            }
    }
};
__device__ __forceinline__ float row_rs(const float* SSQ, int row) {
    const f32x4 a = *(const f32x4*)(SSQ + (size_t)row * 16), b = *(const f32x4*)(SSQ + (size_t)row * 16 + 4), c = *(const f32x4*)(SSQ + (size_t)row * 16 + 8), d = *(const f32x4*)(SSQ + (size_t)row * 16 + 12);
    const f32x4 t = (a + b) + (c + d); return rsqrtf(((t[0] + t[1]) + (t[2] + t[3])) * (1.0f / 1024.0f) + 1e-6f);
}
struct EpiResN {
    static constexpr bool PERM = true; const float* xa; const float* xb; float* out; unsigned char* ws; int goff; float scale; int which;
    __device__ __forceinline__ void operator()(const f32x4 (&acc)[2][2][4][2], const Unit& u, int wr, int wc, int fr, int fq) const {
        const float* mod = (const float*)(ws + WS_MOD); const float* GP = (const float*)(ws + WS_GP) + which * 5120; bf16_t* XG = (bf16_t*)(ws + (which ? WS_XG3 : WS_H)); float* SSQ = (float*)(ws + WS_SSQ);
        const int mi = u.pm < 16 ? 0 : 1 + ((u.pm - 16) >> 4);
        const int row0 = u.pm * 256 + wr * 64 + fr, col0 = u.pn * 256 + wc * 32 + fq * 8;
        f32x4 gv[2][2], gp[2][2];
#pragma unroll
        for (int bj = 0; bj < 2; ++bj)
#pragma unroll
            for (int n = 0; n < 2; ++n) { gv[bj][n] = *(const f32x4*)(mod + mi * NMOD + goff + col0 + bj * 128 + n * 4) * scale; gp[bj][n] = *(const f32x4*)(GP + mi * 1024 + col0 + bj * 128 + n * 4); }
        const bool lo = (u.pm * 256) < NCTX;
        const float* sbase = (lo ? xa + (size_t)row0 * DM : xb + (size_t)(row0 - NCTX) * DM) + col0;
        float* obase = out + (size_t)row0 * DM + col0; bf16_t* xbase = XG + (size_t)row0 * DM + col0;
#pragma unroll
        for (int rp = 0; rp < 4; ++rp) {
            unsigned ro[2]; f32x4 xv[2][2][2];
#pragma unroll
            for (int h2 = 0; h2 < 2; ++h2) { const int r = rp * 2 + h2; ro[h2] = (unsigned)((r >> 2) * 128 + (r & 3) * 16) * DM; asm volatile("" : "+v"(ro[h2]));
#pragma unroll
                for (int bj = 0; bj < 2; ++bj)
#pragma unroll
                    for (int n = 0; n < 2; ++n) xv[h2][bj][n] = *(const f32x4*)(sbase + ro[h2] + bj * 128 + n * 4); }
#pragma unroll
            for (int h2 = 0; h2 < 2; ++h2) { const int r = rp * 2 + h2, ai = r >> 2, m = r & 3;
                float ss = 0.f;
#pragma unroll
                for (int bj = 0; bj < 2; ++bj) {
                    const f32x4 v0 = xv[h2][bj][0] + gv[bj][0] * acc[ai][bj][m][0], v1 = xv[h2][bj][1] + gv[bj][1] * acc[ai][bj][m][1];
                    *(f32x4*)(obase + ro[h2] + bj * 128) = v0; *(f32x4*)(obase + ro[h2] + bj * 128 + 4) = v1;
                    ss += (v0[0] * v0[0] + v0[1] * v0[1]) + (v0[2] * v0[2] + v0[3] * v0[3]) + (v1[0] * v1[0] + v1[1] * v1[1]) + (v1[2] * v1[2] + v1[3] * v1[3]);
                    const f32x4 y0 = v0 * gp[bj][0], y1 = v1 * gp[bj][1];
                    u32x4 w; w.x = cvt_pk_bf16(y0[0], y0[1]); w.y = cvt_pk_bf16(y0[2], y0[3]); w.z = cvt_pk_bf16(y1[0], y1[1]); w.w = cvt_pk_bf16(y1[2], y1[3]);
                    *(u32x4*)(xbase + ro[h2] + bj * 128) = w;
                }
                ss += __shfl_xor(ss, 16); ss += __shfl_xor(ss, 32);
                if (fq == 0) SSQ[(size_t)(row0 + ai * 128 + m * 16) * 16 + u.pn * 4 + wc] = ss; }
        }
    }
};
struct EpiGUN {
    static constexpr bool PERM = true; bf16_t* ACT; const float* SSQ; const float* CB;
    __device__ __forceinline__ void operator()(const f32x4 (&acc)[2][2][4][2], const Unit& u, int wr, int wc, int fr, int fq) const {
        const int mi = u.pm < 16 ? 0 : 1 + ((u.pm - 16) >> 4);
        const int row0 = u.pm * 256 + wr * 64 + fr, col0 = u.pn * 128 + wc * 32 + fq * 8;
        const float* cb = CB + mi * 5632 + u.pn * 256 + wc * 32 + fq * 8;
        const f32x4 cg0 = *(const f32x4*)cb, cg1 = *(const f32x4*)(cb + 4), cu0 = *(const f32x4*)(cb + 128), cu1 = *(const f32x4*)(cb + 132);
        const int laneL = fr + 16 * fq, rowW = u.pm * 256 + wr * 64;
        const float my0 = row_rs(SSQ, rowW + laneL), my1 = row_rs(SSQ, rowW + 128 + laneL);
        float rs[8];
#pragma unroll
        for (int m = 0; m < 4; ++m) { rs[m] = __shfl(my0, m * 16 + fr); rs[4 + m] = __shfl(my1, m * 16 + fr); }
#pragma unroll
        for (int ai = 0; ai < 2; ++ai)
#pragma unroll
            for (int m = 0; m < 4; ++m) {
                int row = row0 + ai * 128 + m * 16; asm volatile("" : "+v"(row)); const float rr = rs[ai * 4 + m];
                const f32x4 g0 = acc[ai][0][m][0] * rr + cg0, g1 = acc[ai][0][m][1] * rr + cg1, u0 = acc[ai][1][m][0] * rr + cu0, u1 = acc[ai][1][m][1] * rr + cu1;
                float o[8];
#pragma unroll
                for (int j = 0; j < 4; ++j) { o[j] = g0[j] * sigm(g0[j]) * u0[j]; o[4 + j] = g1[j] * sigm(g1[j]) * u1[j]; }
                u32x4 w; w.x = cvt_pk_bf16(o[0], o[1]); w.y = cvt_pk_bf16(o[2], o[3]); w.z = cvt_pk_bf16(o[4], o[5]); w.w = cvt_pk_bf16(o[6], o[7]);
                *(u32x4*)(ACT + (size_t)row * DFF + col0) = w;
            }
    }
};
struct EpiWinN {
    static constexpr bool PERM = true; bf16_t* Z; bf16_t* PT; const float* SSQ; const float* CB;
    __device__ __forceinline__ void operator()(const f32x4 (&acc)[2][2][4][2], const Unit& u, int wr, int wc, int fr, int fq) const {
        const int row0 = u.pm * 256 + wr * 64 + fr, cin = wc * 32 + fq * 8;
        if (u.kind == 0) {
            const int mi = u.pm < 16 ? 0 : 1 + ((u.pm - 16) >> 4);
            const float* cb = CB + mi * 3072 + u.pn * 256 + cin;
            f32x4 cv[2][2];
#pragma unroll
            for (int bj = 0; bj < 2; ++bj)
#pragma unroll
                for (int n = 0; n < 2; ++n) cv[bj][n] = *(const f32x4*)(cb + bj * 128 + n * 4);
            const int laneL = fr + 16 * fq, rowW = u.pm * 256 + wr * 64;
            const float my0 = row_rs(SSQ, rowW + laneL), my1 = row_rs(SSQ, rowW + 128 + laneL);
            float rs8[8];
#pragma unroll
            for (int m = 0; m < 4; ++m) { rs8[m] = __shfl(my0, m * 16 + fr); rs8[4 + m] = __shfl(my1, m * 16 + fr); }
#pragma unroll
            for (int ai = 0; ai < 2; ++ai)
#pragma unroll
                for (int m = 0; m < 4; ++m) {
                    const int row = row0 + ai * 128 + m * 16; const float rs = rs8[ai * 4 + m];
#pragma unroll
                    for (int bj = 0; bj < 2; ++bj) { const int col = u.pn * 256 + bj * 128 + cin;
                        const f32x4 v0 = acc[ai][bj][m][0] * rs + cv[bj][0], v1 = acc[ai][bj][m][1] * rs + cv[bj][1];
                        u32x4 w; w.x = cvt_pk_bf16(v0[0], v0[1]); w.y = cvt_pk_bf16(v0[2], v0[3]); w.z = cvt_pk_bf16(v1[0], v1[1]); w.w = cvt_pk_bf16(v1[2], v1[3]);
                        if (col < DZ) *(u32x4*)(Z + (size_t)row * DZ + col) = w; }
                }
        } else {
            const int mi = u.pn < 16 ? 0 : 1 + ((u.pn - 16) >> 4);
            const int lane_ = fr + 16 * fq;
            const float myrs = row_rs(SSQ, u.pn * 256 + (lane_ >> 5) * 128 + wc * 32 + (lane_ & 31));
            float rs[2][8];
#pragma unroll
            for (int bj = 0; bj < 2; ++bj)
#pragma unroll
                for (int e = 0; e < 8; ++e) rs[bj][e] = __shfl(myrs, bj * 32 + fq * 8 + e);
            float cb8[8];
#pragma unroll
            for (int r = 0; r < 8; ++r) cb8[r] = CB[mi * 3072 + 2048 + row0 + (r >> 2) * 128 + (r & 3) * 16];
#pragma unroll
            for (int ai = 0; ai < 2; ++ai)
#pragma unroll
                for (int m = 0; m < 4; ++m) {
                    const int row = row0 + ai * 128 + m * 16, part = row >> 9, ch = row & 511; const float cbv = cb8[ai * 4 + m];
#pragma unroll
                    for (int bj = 0; bj < 2; ++bj) {
                        const f32x4 a0 = acc[ai][bj][m][0], a1 = acc[ai][bj][m][1];
                        u32x4 w; w.x = cvt_pk_bf16(a0[0] * rs[bj][0] + cbv, a0[1] * rs[bj][1] + cbv); w.y = cvt_pk_bf16(a0[2] * rs[bj][2] + cbv, a0[3] * rs[bj][3] + cbv);
                        w.z = cvt_pk_bf16(a1[0] * rs[bj][4] + cbv, a1[1] * rs[bj][5] + cbv); w.w = cvt_pk_bf16(a1[2] * rs[bj][6] + cbv, a1[3] * rs[bj][7] + cbv);
                        const int ct = bj * 128 + cin; bf16_t* dst;
                        if (u.pn < 16) dst = PT + (((size_t)u.pn * 512 + ch) * 2 + part) * 256 + ct;
                        else { const int lt = u.pn - 16, bb = lt >> 4, s0 = (lt & 15) * 256; dst = PT + 4194304 + (((size_t)bb * 512 + ch) * 2 + part) * 4096 + s0 + ct; }
                        *(u32x4*)dst = w; }
                }
        }
    }
};
struct EpiWin {
    static constexpr bool PERM = true; bf16_t* Z; bf16_t* PT;
    __device__ __forceinline__ void operator()(const f32x4 (&acc)[2][2][4][2], const Unit& u, int wr, int wc, int fr, int fq) const {
        const int row0 = u.pm * 256 + wr * 64 + fr, cin = wc * 32 + fq * 8;
#pragma unroll
        for (int ai = 0; ai < 2; ++ai)
#pragma unroll
            for (int m = 0; m < 4; ++m) {
                const int row = row0 + ai * 128 + m * 16;
#pragma unroll
                for (int bj = 0; bj < 2; ++bj) {
                    const f32x4 v0 = acc[ai][bj][m][0], v1 = acc[ai][bj][m][1];
                    u32x4 w; w.x = cvt_pk_bf16(v0[0], v0[1]); w.y = cvt_pk_bf16(v0[2], v0[3]); w.z = cvt_pk_bf16(v1[0], v1[1]); w.w = cvt_pk_bf16(v1[2], v1[3]);
                    const int ct = bj * 128 + cin;
                    if (u.kind == 0) { const int col = u.pn * 256 + ct; if (col < DZ) *(u32x4*)(Z + (size_t)row * DZ + col) = w; }
                    else { const int part = row >> 9, ch = row & 511; bf16_t* dst;
                        if (u.pn < 16) dst = PT + (((size_t)u.pn * 512 + ch) * 2 + part) * 256 + ct;
                        else { const int lt = u.pn - 16, bb = lt >> 4, s0 = (lt & 15) * 256; dst = PT + 4194304 + (((size_t)bb * 512 + ch) * 2 + part) * 4096 + s0 + ct; }
                        *(u32x4*)dst = w; }
                }
            }
    }
};
struct EpiFour {
    static constexpr bool PERM = true; bf16_t* MIX; float scale;
    __device__ __forceinline__ void operator()(const f32x4 (&acc)[2][2][4][2], const Unit& u, int wr, int wc, int fr, int fq) const {
        const int row0 = u.aux + u.pm * 256 + wr * 64 + fr, col0 = u.pn * 256 + wc * 32 + fq * 8;
#pragma unroll
        for (int ai = 0; ai < 2; ++ai)
#pragma unroll
            for (int m = 0; m < 4; ++m)
#pragma unroll
                for (int bj = 0; bj < 2; ++bj) {
                    const f32x4 v0 = acc[ai][bj][m][0] * scale, v1 = acc[ai][bj][m][1] * scale;
                    u32x4 w; w.x = cvt_pk_bf16(v0[0], v0[1]); w.y = cvt_pk_bf16(v0[2], v0[3]); w.z = cvt_pk_bf16(v1[0], v1[1]); w.w = cvt_pk_bf16(v1[2], v1[3]);
                    *(u32x4*)(MIX + (size_t)(row0 + ai * 128 + m * 16) * DM + col0 + bj * 128) = w;
                }
    }
};

__device__ __forceinline__ void tconv_load(const float* __restrict__ src, int ld, int k0, int n0, float* tile) {
    const int tid = threadIdx.x;
#pragma unroll
    for (int r = 0; r < 2; ++r) { const int idx = tid + 512 * r, i = idx >> 4, j4 = idx & 15; const float4 v = *(const float4*)(src + (size_t)(k0 + i) * ld + n0 + 4 * j4);
        float* t = tile + i * 65 + 4 * j4; t[0] = v.x; t[1] = v.y; t[2] = v.z; t[3] = v.w; }
}
__device__ __forceinline__ void tconv_tile(const float* __restrict__ src, int ld, int k0, int n0, bf16_t* __restrict__ dst, int ldd, int drow0, float* tile) {
    const int tid = threadIdx.x;
    tconv_load(src, ld, k0, n0, tile);
    __syncthreads();
    { const int j = tid >> 3, ic = tid & 7; const float* t = tile + (ic * 8) * 65 + j; u32x4 w;
      w.x = cvt_pk_bf16(t[0], t[65]); w.y = cvt_pk_bf16(t[130], t[195]); w.z = cvt_pk_bf16(t[260], t[325]); w.w = cvt_pk_bf16(t[390], t[455]);
      *(u32x4*)(dst + (size_t)(drow0 + j) * ldd + k0 + ic * 8) = w; }
    __syncthreads();
}
__device__ __forceinline__ void ffn_conv(const float* wg, const float* wu, const float* wd, bf16_t* WGU, bf16_t* WD, float* tile, int bid, int nb) {
    for (int t = bid; t < 2112; t += nb) {
        int u = t;
        if (u < 1408) { const bool up = u >= 704; if (up) u -= 704; const int k0 = (u / 44) * 64, n0 = (u % 44) * 64;
            tconv_tile(up ? wu : wg, DFF, k0, n0, WGU, DM, (n0 >> 7) * 256 + (n0 & 127) + (up ? 128 : 0), tile); }
        else { u -= 1408; const int k0 = (u >> 4) * 64, n0 = (u & 15) * 64; tconv_tile(wd, DM, k0, n0, WD, DFF, n0, tile); }
    }
}

__device__ __forceinline__ void phase0(const Params& p, unsigned char* lds) {
    float* tile = (float*)lds; float* cos64 = (float*)(lds + 16640); float* T = (float*)(lds + 16896); float* sil = (float*)(lds + 33280); float* red = (float*)(lds + 53760);
    const int tid = threadIdx.x, bid = blockIdx.x, nb = gridDim.x;
    unsigned char* ws = p.ws;
    for (int i = tid; i < 4096; i += 512) T[i] = cospif((float)i * (1.0f / 2048.0f));
    if (tid < 64) cos64[tid] = cospif((float)tid * (1.0f / 32.0f));
    for (int i = tid; i < 5120; i += 512) { const int r = i >> 10, k = i & 1023; const float c = r == 0 ? p.in[I_CCTX][k] : p.in[I_C][(r - 1) * 1024 + k]; sil[i] = c * sigm(c); }
    __syncthreads();
    for (int it = bid; it < 288; it += nb) {
        const int jj = tid & 31, kg = tid >> 5, j = it * 32 + jj; const float* wp = p.in[I_WMOD] + (size_t)(kg * 64) * NMOD + j; const float* sp = sil + kg * 64;
        float a0 = 0.f, a1 = 0.f, a2 = 0.f, a3 = 0.f, a4 = 0.f;
#pragma unroll 64
        for (int k = 0; k < 64; ++k) { const float w = wp[(size_t)k * NMOD]; a0 += sp[k] * w; a1 += sp[1024 + k] * w; a2 += sp[2048 + k] * w; a3 += sp[3072 + k] * w; a4 += sp[4096 + k] * w; }
        float* rp = red + kg * 160 + jj; rp[0] = a0; rp[32] = a1; rp[64] = a2; rp[96] = a3; rp[128] = a4;
        __syncthreads();
        if (tid < 160) { float s = 0.f;
#pragma unroll
            for (int g = 0; g < 16; ++g) s += red[g * 160 + tid];
            const int i = tid >> 5; ((float*)(ws + WS_MOD))[i * NMOD + it * 32 + (tid & 31)] = s + p.in[I_BMOD][it * 32 + (tid & 31)]; }
        __syncthreads();
    }
}
__device__ __forceinline__ void phase0b(const Params& p, unsigned char* lds, const int bid, const int nb) {
    float* tile = (float*)lds; float* cos64 = (float*)(lds + 16640); float* T = (float*)(lds + 16896);
    const int tid = threadIdx.x;
    unsigned char* ws = p.ws;
    __syncthreads();
    for (int i = tid; i < 4096; i += 512) T[i] = cospif((float)i * (1.0f / 2048.0f));
    if (tid < 64) cos64[tid] = cospif((float)tid * (1.0f / 32.0f));
    __syncthreads();
    for (int t = bid; t < 784; t += nb) {
        int u = t;
        if (u < 480) { const int k0 = (u / 30) * 64, n0 = (u % 30) * 64; tconv_tile(p.in[I_WIN] + 512, 2432, k0, n0, (bf16_t*)(ws + WS_WZ), DM, n0, tile); }
        else if ((u -= 480) < 256) { const int k0 = (u >> 4) * 64, n0 = (u & 15) * 64; tconv_tile(p.in[I_WOUT], DM, k0, n0, (bf16_t*)(ws + WS_WOUT), DM, n0, tile); }
        else if ((u -= 256) < 16) { const int d = u >> 3, n0 = (u & 7) * 64; tconv_tile(p.in[I_W2] + d * 64 * 512, 512, 0, n0, (bf16_t*)(ws + WS_W2T) + d * 512 * 64, 64, n0, tile); }
        else if ((u -= 16) < 16) { const int d = u >> 3, n0 = (u & 7) * 64; tconv_tile(p.in[I_A2] + d * 64 * 512, 512, 0, n0, (bf16_t*)(ws + WS_A2T) + d * 512 * 64, 64, n0, tile); }
        else { u -= 16; const int k0 = (u >> 3) * 64, n0 = (u & 7) * 64; tconv_tile(p.in[I_G2], 512, k0, n0, (bf16_t*)(ws + WS_G2T), 128, n0, tile); }
    }
    for (int t = bid; t < 128; t += nb) {
        const int kt = t >> 3, g = t & 7;
        tconv_load(p.in[I_WIN], 2432, kt * 64, g * 64, tile);
        __syncthreads();
        { const int j = tid >> 3, ic = tid & 7; float ac[8], as[8];
#pragma unroll
          for (int e = 0; e < 8; ++e) { ac[e] = 0.f; as[e] = 0.f; }
          for (int c = 0; c < 64; ++c) { const float cs = cos64[(c * j) & 63], sn = cos64[(c * j - 16) & 63];
#pragma unroll
              for (int e = 0; e < 8; ++e) { const float w = tile[(ic * 8 + e) * 65 + c]; ac[e] += w * cs; as[e] += w * sn; } }
          u32x4 w; bf16_t* WF = (bf16_t*)(ws + WS_WF);
          w.x = cvt_pk_bf16(ac[0], ac[1]); w.y = cvt_pk_bf16(ac[2], ac[3]); w.z = cvt_pk_bf16(ac[4], ac[5]); w.w = cvt_pk_bf16(ac[6], ac[7]);
          *(u32x4*)(WF + (size_t)(g * 64 + j) * DM + kt * 64 + ic * 8) = w;
          w.x = cvt_pk_bf16(as[0], as[1]); w.y = cvt_pk_bf16(as[2], as[3]); w.z = cvt_pk_bf16(as[4], as[5]); w.w = cvt_pk_bf16(as[6], as[7]);
          *(u32x4*)(WF + (size_t)(512 + g * 64 + j) * DM + kt * 64 + ic * 8) = w; }
        __syncthreads();
    }
    { float* v2 = (float*)(lds + 33280); float* v3 = (float*)(lds + 53760); float* red = (float*)(lds + 74240); float* tb5 = (float*)(lds + 84480);
      const float* mod = (const float*)(ws + WS_MOD); float* CBW = (float*)(ws + WS_CBW); float* CBG = (float*)(ws + WS_CBG);
      for (int i = tid; i < 5120; i += 512) { const int r = i >> 10, k = i & 1023; v2[i] = mod[r * NMOD + 3072 + k]; v3[i] = mod[r * NMOD + 6144 + k]; }
      __syncthreads();
      for (int it = bid; it < 252; it += nb) {
          const bool isu = it >= 60 && it < 76; if (isu && (it & 1)) continue;
          for (int half = 0; half < (isu ? 2 : 1); ++half) {
              const float* W; int ld, colw; const float* vp;
              if (it < 60) { W = p.in[I_WIN]; ld = 2432; colw = 512 + it * 32; vp = v2; }
              else if (isu) { W = p.in[I_WIN]; ld = 2432; colw = (it - 60 + half) * 32; vp = v2; }
              else { const int u = it - 76; W = (u < 88 ? p.in[I_WG] : p.in[I_WU]) + (size_t)DM * DFF; ld = DFF; colw = (u % 88) * 32; vp = v3; }
              const int jj = tid & 31, kg = tid >> 5; const float* wp = W + (size_t)(kg * 64) * ld + colw + jj; const float* sp = vp + kg * 64;
              float a0 = 0.f, a1 = 0.f, a2 = 0.f, a3 = 0.f, a4 = 0.f;
#pragma unroll 4
              for (int k = 0; k < 64; ++k) { const float w = wp[(size_t)k * ld]; a0 += sp[k] * w; a1 += sp[1024 + k] * w; a2 += sp[2048 + k] * w; a3 += sp[3072 + k] * w; a4 += sp[4096 + k] * w; }
              float* rp = red + kg * 160 + jj; rp[0] = a0; rp[32] = a1; rp[64] = a2; rp[96] = a3; rp[128] = a4;
              __syncthreads();
              if (tid < 160) { float sm = 0.f;
#pragma unroll
                  for (int g = 0; g < 16; ++g) sm += red[g * 160 + tid];
                  const int i = tid >> 5, j5 = tid & 31;
                  if (it < 60) CBW[i * 3072 + it * 32 + j5] = sm;
                  else if (isu) tb5[i * 64 + half * 32 + j5] = sm;
                  else { const int u = it - 76, cgu = (u % 88) * 32 + j5; CBG[i * 5632 + (cgu >> 7) * 256 + (u < 88 ? 0 : 128) + (cgu & 127)] = sm; } }
              __syncthreads();
          }
          if (isu) { const int g = (it - 60) >> 1;
              for (int e = tid; e < 640; e += 512) { const int i = e >> 7, part = (e >> 6) & 1, cp = e & 63; float sm = 0.f;
                  for (int c = 0; c < 64; ++c) sm += tb5[i * 64 + c] * cos64[(c * cp - (part ? 16 : 0)) & 63];
                  CBW[i * 3072 + 2048 + part * 512 + g * 64 + cp] = sm; }
              __syncthreads(); }
      }
      for (int e = bid * 512 + tid; e < 640; e += nb * 512) CBW[(e >> 7) * 3072 + 1920 + (e & 127)] = 0.f; }
    const size_t gt = (size_t)bid * 512 + tid, ngt = (size_t)nb * 512;
    for (size_t i = gt; i < 16384; i += ngt) ((u32x4*)(ws + WS_WZ + (size_t)1920 * DM * 2))[i] = (u32x4){0u, 0u, 0u, 0u};
    for (size_t i = gt; i < (size_t)(gridDim.x == 256 ? 2048 : 4096) * 1024; i += ngt) {
        const int sp = (int)(i >> 10), k0 = ((int)i & 1023) * 8, part = k0 >> 12, kk0 = k0 & 4095; float v[8];
#pragma unroll
        for (int e = 0; e < 8; ++e) { const int j = (sp * (kk0 + e)) & 4095; v[e] = part ? -T[(j - 1024) & 4095] : T[j]; }
        u32x4 w; w.x = cvt_pk_bf16(v[0], v[1]); w.y = cvt_pk_bf16(v[2], v[3]); w.z = cvt_pk_bf16(v[4], v[5]); w.w = cvt_pk_bf16(v[6], v[7]);
        ((u32x4*)(ws + WS_DLAT))[i] = w;
    }
    for (size_t i = gt; i < (size_t)256 * 64; i += ngt) {
        const int sp = (int)(i >> 6), k0 = ((int)i & 63) * 8, part = k0 >> 8, kk0 = k0 & 255; float v[8];
#pragma unroll
        for (int e = 0; e < 8; ++e) { const int j = ((sp * (kk0 + e)) & 255) * 16; v[e] = part ? -T[(j - 1024) & 4095] : T[j]; }
        u32x4 w; w.x = cvt_pk_bf16(v[0], v[1]); w.y = cvt_pk_bf16(v[2], v[3]); w.z = cvt_pk_bf16(v[4], v[5]); w.w = cvt_pk_bf16(v[6], v[7]);
        ((u32x4*)(ws + WS_DCTX))[i] = w;
    }
}

__device__ __forceinline__ void norm_phase(const float* xa, const float* xb, const float* gamma, const float* mod, int sh_off, int sc_off, bf16_t* H, float* xcopy = nullptr) {
    const int lane = threadIdx.x & 63, gw = blockIdx.x * 8 + (threadIdx.x >> 6), nw = gridDim.x * 8;
    for (int row0 = gw * 4; row0 < NTOK; row0 += nw * 4) {
        float4 v[4][4]; float ss[4];
#pragma unroll
        for (int r = 0; r < 4; ++r) { const int row = row0 + r; const float* x = row < NCTX ? xa + (size_t)row * DM : xb + (size_t)(row - NCTX) * DM;
#pragma unroll
            for (int i = 0; i < 4; ++i) v[r][i] = ((const float4*)x)[lane + 64 * i]; }
#pragma unroll
        for (int r = 0; r < 4; ++r) { float s_ = 0.f;
#pragma unroll
            for (int i = 0; i < 4; ++i) s_ += v[r][i].x * v[r][i].x + v[r][i].y * v[r][i].y + v[r][i].z * v[r][i].z + v[r][i].w * v[r][i].w;
            ss[r] = wave_sum(s_); }
        const float* mp = mod + (row0 < NCTX ? 0 : 1 + ((row0 - NCTX) >> 12)) * NMOD;
#pragma unroll
        for (int i = 0; i < 4; ++i) { const int col = 4 * (lane + 64 * i);
            const float4 g = *(const float4*)(gamma + col), sc = *(const float4*)(mp + sc_off + col), sh = *(const float4*)(mp + sh_off + col);
#pragma unroll
            for (int r = 0; r < 4; ++r) { const float rs = rsqrtf(ss[r] * (1.0f / 1024.0f) + 1e-6f); const float4 x = v[r][i];
                u32x2 w; w.x = cvt_pk_bf16(x.x * rs * g.x * (1.0f + sc.x) + sh.x, x.y * rs * g.y * (1.0f + sc.y) + sh.y);
                w.y = cvt_pk_bf16(x.z * rs * g.z * (1.0f + sc.z) + sh.z, x.w * rs * g.w * (1.0f + sc.w) + sh.w);
                *(u32x2*)(H + (size_t)(row0 + r) * DM + col) = w; } }
    }
}
__device__ __forceinline__ void final_norm_phase(float* out, const float* gamma, const bf16_t* X3) {
    const int lane = threadIdx.x & 63, gw = blockIdx.x * 8 + (threadIdx.x >> 6), nw = gridDim.x * 8;
    for (int row0 = gw * 4; row0 < NTOK; row0 += nw * 4) {
        float4 v[4][4]; float ss[4];
#pragma unroll
        for (int r = 0; r < 4; ++r)
#pragma unroll
            for (int i = 0; i < 4; ++i) { const u32x2 pw = ((const u32x2*)(X3 + (size_t)(row0 + r) * DM))[lane + 64 * i];
                v[r][i] = make_float4(__uint_as_float(pw.x << 16), __uint_as_float(pw.x & 0xFFFF0000u), __uint_as_float(pw.y << 16), __uint_as_float(pw.y & 0xFFFF0000u)); }
#pragma unroll
        for (int r = 0; r < 4; ++r) { float s_ = 0.f;
#pragma unroll
            for (int i = 0; i < 4; ++i) s_ += v[r][i].x * v[r][i].x + v[r][i].y * v[r][i].y + v[r][i].z * v[r][i].z + v[r][i].w * v[r][i].w;
            ss[r] = wave_sum(s_); }
#pragma unroll
        for (int i = 0; i < 4; ++i) { const float4 g = ((const float4*)gamma)[lane + 64 * i];
#pragma unroll
            for (int r = 0; r < 4; ++r) { const float rs = rsqrtf(ss[r] * (1.0f / 1024.0f) + 1e-6f); const float4 x = v[r][i];
                ((float4*)(out + (size_t)(row0 + r) * DM))[lane + 64 * i] = make_float4(x.x * rs * g.x, x.y * rs * g.y, x.z * rs * g.z, x.w * rs * g.w); } }
    }
}

typedef float f32x2 __attribute__((ext_vector_type(2)));
constexpr int SC_CH = 32, SC_BUF = 43008, SC_TW = 86016, SC_YC = 104448, SC_CONST = 120832;

struct ScanLoads { u32x4 z0[5]; unsigned nb[5][4][2]; };

__device__ __forceinline__ void scan_issue(ScanLoads& L, const bf16_t* __restrict__ Z, int tb, int S, bool lat, int dir, int h, int c, int pw, int lane) {
    const int pos = c * SC_CH + 8 * pw + (lane >> 3), t = dir ? S - 1 - pos : pos, cg = lane & 7;
    int tn[4]; bool ok[4];
    tn[0] = t - 1; tn[1] = t + 1;
    if (lat) { ok[0] = (t & 63) != 0; ok[1] = (t & 63) != 63; tn[2] = t - 64; ok[2] = t >= 64; tn[3] = t + 64; ok[3] = t < S - 64; }
    else { ok[0] = t > 0; ok[1] = t < S - 1; tn[2] = tn[0]; ok[2] = ok[0]; tn[3] = tn[1]; ok[3] = ok[1]; }
    const bf16_t* zr = Z + (size_t)(tb + t) * DZ + cg * 8;
#pragma unroll
    for (int d = 0; d < 4; ++d) tn[d] = ok[d] ? (tn[d] - t) * DZ : 0;
#pragma unroll
    for (int sec = 0; sec < 5; ++sec) {
        const int col0 = sec < 3 ? sec * 512 + h * 64 : (sec == 3 ? 1536 + dir * 64 : 1664 + dir * 64);
        L.z0[sec] = *(const u32x4*)(zr + col0);
#pragma unroll
        for (int d = 0; d < 4; ++d) { const unsigned* np = (const unsigned*)(zr + col0 + tn[d]) + (d >> 1); const unsigned a = np[0], b = np[2]; L.nb[sec][d][0] = ok[d] ? a : 0u; L.nb[sec][d][1] = ok[d] ? b : 0u; }
    }
}
__device__ __forceinline__ float bfsel(const u32x4& v, int e) { const unsigned w = v[e >> 1]; return __uint_as_float((e & 1) ? (w & 0xFFFF0000u) : (w << 16)); }
__device__ __forceinline__ float bfhalf(unsigned w, int hi) { return __uint_as_float(hi ? (w & 0xFFFF0000u) : (w << 16)); }
template <int CTRL> __device__ __forceinline__ float dpp_add(float x) { return x + dpp_mov<CTRL>(x); }
__device__ __forceinline__ float red8(float x) { x = dpp_add<0xB1>(x); x = dpp_add<0x4E>(x); x = dpp_add<0x141>(x); return x; }

__device__ __forceinline__ void scan_prepA(const ScanLoads& L, unsigned char* lds, int buf, int quarter, int pw, int lane, float (&rv)[8], float (&kv)[8]) {
    float* R = (float*)(lds + buf * SC_BUF); float* W = R + 2048; float* BB = W + 2048; float* KD = BB + 2048; float* KK = KD + 2048; float* V = KK + 2048;
    bf16_t* TW = (bf16_t*)(lds + SC_TW + pw * 4608); bf16_t* TA = TW + 1152;
    const int p8 = lane >> 3, cg = lane & 7, pp = 8 * pw + p8;
    const float* CM = (const float*)(lds + SC_CONST); const bf16_t* CWT = (const bf16_t*)(lds + SC_CONST + 2560);
#pragma unroll
    for (int sec = 0; sec < 5; ++sec) {
        const float4 m0 = *(const float4*)(CM + sec * 64 + cg * 8), m1 = *(const float4*)(CM + sec * 64 + cg * 8 + 4);
        const float mu[8] = {m0.x, m0.y, m0.z, m0.w, m1.x, m1.y, m1.z, m1.w};
        float val[8];
#pragma unroll
        for (int e = 0; e < 8; ++e) { const float z0 = bfsel(L.z0[sec], e), zn = bfhalf(L.nb[sec][e & 3][e >> 2], e & 1); val[e] = z0 + mu[e] * (zn - z0); }
        if (sec == 0) {
#pragma unroll
            for (int e = 0; e < 8; ++e) rv[e] = val[e];
            *(float4*)(R + pp * 64 + cg * 8) = make_float4(val[0], val[1], val[2], val[3]); *(float4*)(R + pp * 64 + cg * 8 + 4) = make_float4(val[4], val[5], val[6], val[7]);
        } else if (sec == 1) {
#pragma unroll
            for (int e = 0; e < 8; ++e) kv[e] = val[e];
        } else if (sec == 2) {
            if ((cg >> 1) == quarter) { *(float4*)(V + pp * 16 + (cg & 1) * 8) = make_float4(val[0], val[1], val[2], val[3]); *(float4*)(V + pp * 16 + (cg & 1) * 8 + 4) = make_float4(val[4], val[5], val[6], val[7]); }
        } else {
            if (sec == 3) {
#pragma unroll
                for (int e = 0; e < 8; ++e) val[e] = 1.0f - 2.0f * __builtin_amdgcn_rcpf(1.0f + __expf(2.0f * val[e]));
            }
            u32x4 w; w.x = cvt_pk_bf16(val[0], val[1]); w.y = cvt_pk_bf16(val[2], val[3]); w.z = cvt_pk_bf16(val[4], val[5]); w.w = cvt_pk_bf16(val[6], val[7]);
            if (sec == 3) { *(u32x4*)(TW + p8 * 136 + cg * 8) = w; *(u32x4*)(TW + p8 * 136 + 64 + cg * 8) = (u32x4){0u, 0u, 0u, 0u}; }
            else { *(u32x4*)(TW + (p8 + 8) * 136 + 64 + cg * 8) = w; *(u32x4*)(TW + (p8 + 8) * 136 + cg * 8) = (u32x4){0u, 0u, 0u, 0u}; }
        }
    }
}
__device__ __forceinline__ void scan_prepB(const Params& p, unsigned char* lds, int buf, int tb, int S, int dir, int h, int quarter, int c, int pw, int lane, const float (&rv)[8], const float (&kv)[8]) {
    unsigned char* ws = p.ws;
    float* R = (float*)(lds + buf * SC_BUF); float* W = R + 2048; float* BB = W + 2048; float* KD = BB + 2048; float* KK = KD + 2048;
    bf16_t* TW = (bf16_t*)(lds + SC_TW + pw * 4608); bf16_t* TA = TW + 1152;
    const int p8 = lane >> 3, cg = lane & 7, pp = 8 * pw + p8;
    const float* CM = (const float*)(lds + SC_CONST); const bf16_t* CWT = (const bf16_t*)(lds + SC_CONST + 2560);
    __builtin_amdgcn_wave_barrier();
    { f32x4 acc[4];
#pragma unroll
      for (int nt = 0; nt < 4; ++nt) acc[nt] = (f32x4){0.f, 0.f, 0.f, 0.f};
#pragma unroll
      for (int k4 = 0; k4 < 4; ++k4) { const bf16x8 a = *(const bf16x8*)(TW + (lane & 15) * 136 + 32 * k4 + 8 * (lane >> 4));
#pragma unroll
          for (int nt = 0; nt < 4; ++nt) { const bf16x8 bb = *(const bf16x8*)(CWT + (16 * nt + (lane & 15)) * 136 + 32 * k4 + 8 * (lane >> 4)); acc[nt] = __builtin_amdgcn_mfma_f32_16x16x32_bf16(a, bb, acc[nt], 0, 0, 0); } }
      const int q4 = lane >> 4, isa = q4 >> 1; float* dst = isa ? BB : W;
#pragma unroll
      for (int nt = 0; nt < 4; ++nt) { const int j = 16 * nt + (lane & 15); const float bias = CM[512 + isa * 64 + j];
#pragma unroll
          for (int i = 0; i < 4; ++i) { const int q = 8 * pw + 4 * (q4 & 1) + i; const float sg = sigm(acc[nt][i] + bias);
              dst[q * 64 + j] = isa ? sg : __expf(-0.60653066f * sg); } } }
    __builtin_amdgcn_wave_barrier();
    { const float4 a0 = *(const float4*)(BB + pp * 64 + cg * 8), a1 = *(const float4*)(BB + pp * 64 + cg * 8 + 4);
      const float4 kw0 = *(const float4*)(CM + 320 + cg * 8), kw1 = *(const float4*)(CM + 324 + cg * 8), ka0 = *(const float4*)(CM + 384 + cg * 8), ka1 = *(const float4*)(CM + 388 + cg * 8),
                   rk0 = *(const float4*)(CM + 448 + cg * 8), rk1 = *(const float4*)(CM + 452 + cg * 8);
      const float a[8] = {a0.x, a0.y, a0.z, a0.w, a1.x, a1.y, a1.z, a1.w}, kw[8] = {kw0.x, kw0.y, kw0.z, kw0.w, kw1.x, kw1.y, kw1.z, kw1.w},
                  ka[8] = {ka0.x, ka0.y, ka0.z, ka0.w, ka1.x, ka1.y, ka1.z, ka1.w}, rk[8] = {rk0.x, rk0.y, rk0.z, rk0.w, rk1.x, rk1.y, rk1.z, rk1.w};
      float kkr[8], kd[8], n2 = 0.f, bon = 0.f;
#pragma unroll
      for (int e = 0; e < 8; ++e) { kkr[e] = kv[e] * kw[e]; n2 += kkr[e] * kkr[e]; kd[e] = kv[e] * (1.0f + (a[e] - 1.0f) * ka[e]); bon += rv[e] * kd[e] * rk[e]; }
      n2 = red8(n2); bon = red8(bon);
      const float inv = 1.0f / fmaxf(sqrtf(n2), 1e-12f);
      float kk[8];
#pragma unroll
      for (int e = 0; e < 8; ++e) kk[e] = kkr[e] * inv;
      *(float4*)(KK + pp * 64 + cg * 8) = make_float4(kk[0], kk[1], kk[2], kk[3]); *(float4*)(KK + pp * 64 + cg * 8 + 4) = make_float4(kk[4], kk[5], kk[6], kk[7]);
      *(float4*)(KD + pp * 64 + cg * 8) = make_float4(kd[0], kd[1], kd[2], kd[3]); *(float4*)(KD + pp * 64 + cg * 8 + 4) = make_float4(kd[4], kd[5], kd[6], kd[7]);
      *(float4*)(BB + pp * 64 + cg * 8) = make_float4(kk[0] * a[0], kk[1] * a[1], kk[2] * a[2], kk[3] * a[3]); *(float4*)(BB + pp * 64 + cg * 8 + 4) = make_float4(kk[4] * a[4], kk[5] * a[5], kk[6] * a[6], kk[7] * a[7]);
      if (quarter == 0 && cg == 0) { const int pos = c * SC_CH + pp, t = dir ? S - 1 - pos : pos; ((float*)(ws + WS_BONUS))[(size_t)(tb + t) * 16 + dir * 8 + h] = bon; } }
}

#define SCAN_BAR() do { asm volatile("s_waitcnt lgkmcnt(0)" ::: "memory"); __builtin_amdgcn_s_barrier(); asm volatile("" ::: "memory"); } while (0)

__device__ __forceinline__ void scan_phase(const Params& p, unsigned char* lds) {
    int tid = threadIdx.x; asm volatile("" : "+v"(tid));
    const int wid = __builtin_amdgcn_readfirstlane(tid >> 6), lane = tid & 63;
    unsigned char* ws = p.ws;
    const bf16_t* Z = (const bf16_t*)(ws + WS_Z); bf16_t* MIX = (bf16_t*)(ws + WS_H); bf16_t* Y1 = (bf16_t*)(ws + WS_Y1);
    float* YC = (float*)(lds + SC_YC);
    const bool bal = gridDim.x == 256; const int nbk = gridDim.x, bk = blockIdx.x;
    const int nitems = bal ? (bk < 128 ? 4 : 6) : (1280 - bk + nbk - 1) / nbk;
    for (int ii = 0; ii < nitems; ++ii) {
        int it;
        if (!bal) it = bk + ii * nbk;
        else if (ii == 0) it = bk;
        else it = 256 + (bk < 128 ? bk * 3 + (ii - 1) : 384 + (bk - 128) * 5 + (ii - 1));
        const bool lat = it < 256; const int q = lat ? it : it - 256;
        const int quarter = q & 3, dir = (q >> 2) & 1, h = (q >> 3) & 7, b = q >> 6;
        const int S = lat ? 4096 : 256, tb = lat ? NCTX + b * 4096 : b * 256, nch = S / SC_CH;
        const bool cons = (wid & 1) == 0;
        const int rl = (wid >> 1) * 4 + ((tid >> 4) & 3), ks = tid & 15, row = quarter * 16 + rl, pw = wid >> 1;
        f32x2 s01 = {0.f, 0.f}, s23 = {0.f, 0.f};
        ScanLoads L;
        { float* CM = (float*)(lds + SC_CONST); bf16_t* CWT = (bf16_t*)(lds + SC_CONST + 2560);
          if (tid < 320) { const int sec = tid >> 6, j = tid & 63; CM[tid] = p.in[I_MU][(sec < 3 ? sec * 512 + h * 64 : (sec == 3 ? 1536 + dir * 64 : 1664 + dir * 64)) + j]; }
          else if (tid < 384) CM[tid] = p.in[I_KK][h * 64 + tid - 320];
          else if (tid < 448) CM[tid] = p.in[I_KA][h * 64 + tid - 384];
          else CM[tid] = p.in[I_RK][h * 64 + tid - 448];
          if (tid < 128) CM[512 + tid] = (tid < 64 ? p.in[I_W0] : p.in[I_A0])[dir * 512 + h * 64 + (tid & 63)];
          for (int e = tid; e < 1024; e += 512) { const int mat = e >> 9, j = (e >> 3) & 63, i8 = e & 7;
              *(u32x4*)(CWT + j * 136 + mat * 64 + i8 * 8) = *(const u32x4*)((const bf16_t*)(ws + (mat ? WS_A2T : WS_W2T)) + (size_t)dir * 512 * 64 + (size_t)(h * 64 + j) * 64 + i8 * 8); }
          SCAN_BAR(); }
        if (cons) { if (lat) { const float4 v = *(const float4*)((dir ? p.in[I_SB] : p.in[I_SF]) + ((size_t)(b * 8 + h) * 64 + row) * 64 + ks * 4); s01 = (f32x2){v.x, v.y}; s23 = (f32x2){v.z, v.w}; } }
        else { float rv[8], kv[8]; scan_issue(L, Z, tb, S, lat, dir, h, 0, pw, lane); scan_prepA(L, lds, 0, quarter, pw, lane, rv, kv); scan_issue(L, Z, tb, S, lat, dir, h, 1, pw, lane);
               scan_prepB(p, lds, 0, tb, S, dir, h, quarter, 0, pw, lane, rv, kv); }
        SCAN_BAR();
        for (int c = 0; c < nch; ++c) {
            if (cons) {
                const unsigned char* bufp = lds + (c & 1) * SC_BUF;
                const float4* R4 = (const float4*)bufp; const float4* W4 = R4 + 512; const float4* B4 = W4 + 512; const float4* KD4 = B4 + 512; const float4* KK4 = KD4 + 512; const float* V = (const float*)(KK4 + 512);
                float* yc = YC + (c & 1) * 2048 + rl * 4 + (ks >> 2);
                float4 kkA, wA, bA, kdA, rA, kkB, wB, bB, kdB, rB; float vA, vB;
#define SC_LOAD(X, pp_) do { kk##X = KK4[(pp_) * 16 + ks]; w##X = W4[(pp_) * 16 + ks]; b##X = B4[(pp_) * 16 + ks]; kd##X = KD4[(pp_) * 16 + ks]; r##X = R4[(pp_) * 16 + ks]; v##X = V[(pp_) * 16 + rl]; } while (0)
#define SC_STEP(X, pp_) do { \
                    f32x2 d = s01 * (f32x2){kk##X.x, kk##X.y}; d = __builtin_elementwise_fma(s23, (f32x2){kk##X.z, kk##X.w}, d); \
                    const float sa = -red16(d.x + d.y); \
                    const f32x2 sa2 = {sa, sa}, vv2 = {v##X, v##X}; \
                    f32x2 t01 = vv2 * (f32x2){kd##X.x, kd##X.y}, t23 = vv2 * (f32x2){kd##X.z, kd##X.w}; \
                    t01 = __builtin_elementwise_fma(sa2, (f32x2){b##X.x, b##X.y}, t01); t23 = __builtin_elementwise_fma(sa2, (f32x2){b##X.z, b##X.w}, t23); \
                    s01 = __builtin_elementwise_fma(s01, (f32x2){w##X.x, w##X.y}, t01); s23 = __builtin_elementwise_fma(s23, (f32x2){w##X.z, w##X.w}, t23); \
                    f32x2 y2 = s01 * (f32x2){r##X.x, r##X.y}; y2 = __builtin_elementwise_fma(s23, (f32x2){r##X.z, r##X.w}, y2); \
                    float yp = y2.x + y2.y; yp = dpp_add<0xB1>(yp); yp = dpp_add<0x4E>(yp); yc[(pp_) * 64] = yp; } while (0)
                SC_LOAD(A, 0);
#pragma unroll 8
                for (int pp = 0; pp < SC_CH; pp += 2) {
                    SC_LOAD(B, pp + 1); __builtin_amdgcn_sched_barrier(0);
                    SC_STEP(A, pp); __builtin_amdgcn_sched_barrier(0);
                    SC_LOAD(A, (pp + 2) & (SC_CH - 1)); __builtin_amdgcn_sched_barrier(0);
                    SC_STEP(B, pp + 1); __builtin_amdgcn_sched_barrier(0);
                }
#undef SC_LOAD
#undef SC_STEP
            } else if (c + 1 < nch) {
                float rv[8], kv[8];
                scan_prepA(L, lds, (c + 1) & 1, quarter, pw, lane, rv, kv);
                if (c + 2 < nch) scan_issue(L, Z, tb, S, lat, dir, h, c + 2, pw, lane);
                __builtin_amdgcn_sched_barrier(0);
                scan_prepB(p, lds, (c + 1) & 1, tb, S, dir, h, quarter, c + 1, pw, lane, rv, kv);
            }
            SCAN_BAR();
            { const int pp = tid >> 4, r_ = tid & 15, pos = c * SC_CH + pp, t = dir ? S - 1 - pos : pos; const float4 y4 = *(const float4*)(YC + (c & 1) * 2048 + tid * 4); const bf16_t yv = f2bf((y4.x + y4.y) + (y4.z + y4.w));
              if (dir == 0) MIX[(size_t)(tb + t) * DM + 512 + h * 64 + quarter * 16 + r_] = yv; else Y1[(size_t)(tb + t) * DRW + h * 64 + quarter * 16 + r_] = yv; }
        }
        if (!lat && cons) *(float4*)(p.out + (size_t)NTOK * DM + (size_t)dir * 524288 + ((size_t)(b * 8 + h) * 64 + row) * 64 + ks * 4) = make_float4(s01.x, s01.y, s23.x, s23.y);
        SCAN_BAR();
    }
}


constexpr int S2_SA = 0, S2_SA_SZ = 16896, S2_SB = 50688, S2_SB_SZ = 16384, S2_SC = 83456, S2_SC_SZ = 15616, S2_SD = 130304, S2_SD_SZ = 3072, S2_CONST = 136448;
typedef short bf16x4 __attribute__((ext_vector_type(4)));

__device__ __forceinline__ bf16x8 frag2(const bf16_t* p0, const bf16_t* p1) { const u32x2 a = *(const u32x2*)p0, b = *(const u32x2*)p1; const u32x4 w = {a.x, a.y, b.x, b.y}; return __builtin_bit_cast(bf16x8, w); }
__device__ __forceinline__ bf16x8 frag1(const bf16_t* p0) { const u32x2 a = *(const u32x2*)p0; const u32x4 w = {a.x, a.y, 0u, 0u}; return __builtin_bit_cast(bf16x8, w); }
__device__ __forceinline__ bf16x8 fragf(const f32x4& lo) { const u32x4 w = {cvt_pk_bf16(lo[0], lo[1]), cvt_pk_bf16(lo[2], lo[3]), 0u, 0u}; return __builtin_bit_cast(bf16x8, w); }
__device__ __forceinline__ bf16x8 fragff(const f32x4& lo, const f32x4& hi) { const u32x4 w = {cvt_pk_bf16(lo[0], lo[1]), cvt_pk_bf16(lo[2], lo[3]), cvt_pk_bf16(hi[0], hi[1]), cvt_pk_bf16(hi[2], hi[3])}; return __builtin_bit_cast(bf16x8, w); }

struct Scan2Loads { u32x4 z0[5]; unsigned nb[5][4][2]; };
__device__ __forceinline__ void scan2_issue(Scan2Loads& L, const bf16_t* __restrict__ Z, int tb, int S, bool lat, int dir, int h, int c, int pw, int lane, bool need_r = true) {
    const int pos = c * 16 + 8 * pw + (lane >> 3), t = dir ? S - 1 - pos : pos, cg = lane & 7;
    int tn[4]; bool ok[4];
    tn[0] = t - 1; tn[1] = t + 1;
    if (lat) { ok[0] = (t & 63) != 0; ok[1] = (t & 63) != 63; tn[2] = t - 64; ok[2] = t >= 64; tn[3] = t + 64; ok[3] = t < S - 64; }
    else { ok[0] = t > 0; ok[1] = t < S - 1; tn[2] = tn[0]; ok[2] = ok[0]; tn[3] = tn[1]; ok[3] = ok[1]; }
    const bf16_t* zr = Z + (size_t)(tb + t) * DZ + cg * 8;
#pragma unroll
    for (int d = 0; d < 4; ++d) tn[d] = ok[d] ? (tn[d] - t) * DZ : 0;
#pragma unroll
    for (int sec = 0; sec < 5; ++sec) {
        const int col0 = sec < 3 ? sec * 512 + h * 64 : (sec == 3 ? 1536 + dir * 64 : 1664 + dir * 64);
        if (sec == 0 && !need_r) continue;
        L.z0[sec] = *(const u32x4*)(zr + col0);
#pragma unroll
        for (int d = 0; d < 4; ++d) { const unsigned* np = (const unsigned*)(zr + col0 + tn[d]) + (d >> 1); const unsigned a = np[0], b = np[2]; L.nb[sec][d][0] = ok[d] ? a : 0u; L.nb[sec][d][1] = ok[d] ? b : 0u; }
    }
}
__device__ __forceinline__ void scan2_stageA(const Scan2Loads& L, unsigned char* lds, int c, int pw, int lane, bool need_r = true) {
    unsigned char* sa = lds + S2_SA + (c % 3) * S2_SA_SZ;
    float* RR = (float*)sa; float* KR = RR + 1024; float* VR = KR + 1024; bf16_t* TWA = (bf16_t*)(sa + 12288); bf16_t* TAA = TWA + 1152;
    const float* CM = (const float*)(lds + S2_CONST);
    const int cg = lane & 7, pp = 8 * pw + (lane >> 3);
#pragma unroll
    for (int sec = 0; sec < 5; ++sec) {
        if (sec == 0 && !need_r) continue;
        const float4 m0 = *(const float4*)(CM + sec * 64 + cg * 8), m1 = *(const float4*)(CM + sec * 64 + cg * 8 + 4);
        const float mu[8] = {m0.x, m0.y, m0.z, m0.w, m1.x, m1.y, m1.z, m1.w};
        float val[8];
#pragma unroll
        for (int e = 0; e < 8; ++e) { const float z0 = bfsel(L.z0[sec], e), zn = bfhalf(L.nb[sec][e & 3][e >> 2], e & 1); val[e] = z0 + mu[e] * (zn - z0); }
        if (sec < 3) { float* D = sec == 0 ? RR : (sec == 1 ? KR : VR);
            *(float4*)(D + pp * 64 + cg * 8) = make_float4(val[0], val[1], val[2], val[3]); *(float4*)(D + pp * 64 + cg * 8 + 4) = make_float4(val[4], val[5], val[6], val[7]); }
        else {
            if (sec == 3) {
#pragma unroll
                for (int e = 0; e < 8; ++e) val[e] = 1.0f - 2.0f * __builtin_amdgcn_rcpf(1.0f + __expf(2.0f * val[e]));
            }
            u32x4 w; w.x = cvt_pk_bf16(val[0], val[1]); w.y = cvt_pk_bf16(val[2], val[3]); w.z = cvt_pk_bf16(val[4], val[5]); w.w = cvt_pk_bf16(val[6], val[7]);
            *(u32x4*)((sec == 3 ? TWA : TAA) + pp * 72 + cg * 8) = w;
        }
    }
}
__device__ __forceinline__ void scan2_stageB(const Params& p, unsigned char* lds, int c, bool iclr, int tb, int S, int dir, int h, int lane, int cb = 0, bool wbon = true) {
    unsigned char* sa = lds + S2_SA + (c % 3) * S2_SA_SZ; unsigned char* sb = lds + S2_SB + (c & 1) * S2_SB_SZ;
    const float* RR = (const float*)sa; const float* KR = RR + 1024; const bf16_t* TX = (const bf16_t*)(sa + 12288) + (iclr ? 1152 : 0);
    float* G = (float*)sb; float* KAP = G + 1024; float* BET = KAP + 1024; float* KDD = BET + 1024;
    const float* CM = (const float*)(lds + S2_CONST); const bf16_t* WT = (const bf16_t*)(lds + S2_CONST + 2560) + (iclr ? 4608 : 0);
    const int jl = lane & 15, q = lane >> 4;
    f32x4 acc[4];
#pragma unroll
    for (int nt = 0; nt < 4; ++nt) acc[nt] = (f32x4){0.f, 0.f, 0.f, 0.f};
#pragma unroll
    for (int k2 = 0; k2 < 2; ++k2) { const bf16x8 a = *(const bf16x8*)(TX + jl * 72 + 32 * k2 + 8 * q);
#pragma unroll
        for (int nt = 0; nt < 4; ++nt) { const bf16x8 bb = *(const bf16x8*)(WT + (16 * nt + jl) * 72 + 32 * k2 + 8 * q); acc[nt] = __builtin_amdgcn_mfma_f32_16x16x32_bf16(a, bb, acc[nt], 0, 0, 0); } }
    if (!iclr) {
#pragma unroll
        for (int nt = 0; nt < 4; ++nt) { const int j = 16 * nt + jl; const float bias = CM[512 + j]; float cs[4]; float run = 0.f;
#pragma unroll
            for (int i = 0; i < 4; ++i) { run += 0.60653066f * sigm(acc[nt][i] + bias); cs[i] = run; }
            const float t1 = __shfl(run, lane - 16), t2 = __shfl(run, lane - 32), t3 = __shfl(run, lane - 48);
            const float off = (q >= 1 ? t1 : 0.f) + (q >= 2 ? t2 : 0.f) + (q >= 3 ? t3 : 0.f);
#pragma unroll
            for (int i = 0; i < 4; ++i) G[(4 * q + i) * 64 + j] = __expf(-(off + cs[i])); }
    } else {
        float a[4][4], kkr[4][4], kv[4][4], rv[4][4], n2[4] = {0.f, 0.f, 0.f, 0.f}, bon[4] = {0.f, 0.f, 0.f, 0.f};
#pragma unroll
        for (int nt = 0; nt < 4; ++nt) { const int j = 16 * nt + jl; const float bias = CM[576 + j], kw = CM[320 + j], ka = CM[384 + j], rk = CM[448 + j];
#pragma unroll
            for (int i = 0; i < 4; ++i) { const int t = 4 * q + i; a[nt][i] = sigm(acc[nt][i] + bias); const float k = KR[t * 64 + j], r = wbon ? RR[t * 64 + j] : 0.f;
                kkr[nt][i] = k * kw; n2[i] += kkr[nt][i] * kkr[nt][i]; kv[nt][i] = k * (1.0f + (a[nt][i] - 1.0f) * ka); bon[i] += r * kv[nt][i] * rk; } }
#pragma unroll
        for (int i = 0; i < 4; ++i) { n2[i] = red16(n2[i]); bon[i] = red16(bon[i]); n2[i] = 1.0f / fmaxf(sqrtf(n2[i]), 1e-12f); }
#pragma unroll
        for (int nt = 0; nt < 4; ++nt) { const int j = 16 * nt + jl;
#pragma unroll
            for (int i = 0; i < 4; ++i) { const int t = 4 * q + i; const float kap = kkr[nt][i] * n2[i]; KAP[t * 64 + j] = kap; BET[t * 64 + j] = kap * a[nt][i]; KDD[t * 64 + j] = kv[nt][i]; } }
        if (jl == 0 && wbon) {
#pragma unroll
            for (int i = 0; i < 4; ++i) { const int pos = (c + cb) * 16 + 4 * q + i, t = dir ? S - 1 - pos : pos; ((float*)(p.ws + WS_BONUS))[(size_t)(tb + t) * 16 + dir * 8 + h] = bon[i]; } }
    }
}
__device__ __forceinline__ void scan2_stageC(unsigned char* lds, int c, int w, int lane) {
    const unsigned char* sa = lds + S2_SA + (c % 3) * S2_SA_SZ; const unsigned char* sb = lds + S2_SB + (c & 1) * S2_SB_SZ; unsigned char* sc = lds + S2_SC + (c % 3) * S2_SC_SZ;
    const float* RR = (const float*)sa; const float* VR = RR + 2048; const float* G = (const float*)sb; const float* KAP = G + 1024; const float* BET = KAP + 1024; const float* KDD = BET + 1024;
    bf16_t* KT = (bf16_t*)sc; bf16_t* RT = KT + 1152; bf16_t* BT = RT + 1152; bf16_t* KKT = BT + 1152; bf16_t* BTT = KKT + 1152; bf16_t* KKTT = BTT + 1024; bf16_t* VT = KKTT + 1024; float* GL = (float*)(sc + 15360);
    const int t = lane >> 2, k0 = 16 * w + 4 * (lane & 3), o = t * 64 + k0;
    const float4 g = *(const float4*)(G + o), gm = t > 0 ? *(const float4*)(G + o - 64) : make_float4(1.f, 1.f, 1.f, 1.f);
    const float4 kap = *(const float4*)(KAP + o), bet = *(const float4*)(BET + o), kdd = *(const float4*)(KDD + o), r = *(const float4*)(RR + o), v = *(const float4*)(VR + o);
    const float4 gi = make_float4(__builtin_amdgcn_rcpf(g.x), __builtin_amdgcn_rcpf(g.y), __builtin_amdgcn_rcpf(g.z), __builtin_amdgcn_rcpf(g.w));
    const float bt[4] = {bet.x * gi.x, bet.y * gi.y, bet.z * gi.z, bet.w * gi.w}, kt[4] = {kdd.x * gi.x, kdd.y * gi.y, kdd.z * gi.z, kdd.w * gi.w}, vv[4] = {v.x, v.y, v.z, v.w};
    u32x2 x;
    x.x = cvt_pk_bf16(kap.x * gm.x, kap.y * gm.y); x.y = cvt_pk_bf16(kap.z * gm.z, kap.w * gm.w); *(u32x2*)(KT + t * 72 + k0) = x;
    x.x = cvt_pk_bf16(r.x * g.x, r.y * g.y); x.y = cvt_pk_bf16(r.z * g.z, r.w * g.w); *(u32x2*)(RT + t * 72 + k0) = x;
    x.x = cvt_pk_bf16(bt[0], bt[1]); x.y = cvt_pk_bf16(bt[2], bt[3]); *(u32x2*)(BT + t * 72 + k0) = x;
    x.x = cvt_pk_bf16(kt[0], kt[1]); x.y = cvt_pk_bf16(kt[2], kt[3]); *(u32x2*)(KKT + t * 72 + k0) = x;
#pragma unroll
    for (int e = 0; e < 4; ++e) { BTT[(k0 + e) * 16 + t] = f2bf(bt[e]); KKTT[(k0 + e) * 16 + t] = f2bf(kt[e]); VT[(k0 + e) * 16 + t] = f2bf(vv[e]); }
    if (t == 15) *(float4*)(GL + k0) = g;
}
__device__ __forceinline__ void scan2_stageD(unsigned char* lds, int c, int w, int lane) {
    const unsigned char* sc = lds + S2_SC + (c % 3) * S2_SC_SZ; unsigned char* sd = lds + S2_SD + (c & 1) * S2_SD_SZ;
    const bf16_t* X = (const bf16_t*)sc + ((w & 2) ? 1152 : 0); const bf16_t* Y = (const bf16_t*)sc + 2304 + ((w & 1) ? 1152 : 0);
    bf16_t* AKK = (bf16_t*)sd; bf16_t* ABR = AKK + 256; bf16_t* AKR = ABR + 256; bf16_t* TT = AKR + 256; float* AF = (float*)(sd + 2048);
    const int s = lane & 15, q = lane >> 4;
    f32x4 acc = {0.f, 0.f, 0.f, 0.f};
#pragma unroll
    for (int k2 = 0; k2 < 2; ++k2) { const bf16x8 a = *(const bf16x8*)(X + s * 72 + 32 * k2 + 8 * q), bb = *(const bf16x8*)(Y + s * 72 + 32 * k2 + 8 * q); acc = __builtin_amdgcn_mfma_f32_16x16x32_bf16(a, bb, acc, 0, 0, 0); }
    if (w != 0) {
#pragma unroll
        for (int i = 0; i < 4; ++i) { const int t = 4 * q + i; const bool keep = (w & 2) ? (s <= t) : (s < t); (w == 1 ? AKK : (w == 2 ? ABR : AKR))[t * 16 + s] = f2bf(keep ? acc[i] : 0.f); }
    } else {
        f32x4 acc2 = {0.f, 0.f, 0.f, 0.f};
#pragma unroll
        for (int k2 = 0; k2 < 2; ++k2) { const bf16x8 a = *(const bf16x8*)(Y + s * 72 + 32 * k2 + 8 * q), bb = *(const bf16x8*)(X + s * 72 + 32 * k2 + 8 * q); acc2 = __builtin_amdgcn_mfma_f32_16x16x32_bf16(a, bb, acc2, 0, 0, 0); }
        f32x4 Nn, NT, Tt;
#pragma unroll
        for (int i = 0; i < 4; ++i) { const int m = 4 * q + i; Nn[i] = (m < s) ? acc2[i] : 0.f; NT[i] = (s < m) ? acc[i] : 0.f; Tt[i] = (m == s ? 1.0f : 0.0f) - NT[i]; }
#pragma unroll
        for (int lev = 0; lev < 3; ++lev) {
            f32x4 N2 = {0.f, 0.f, 0.f, 0.f}, N2T = {0.f, 0.f, 0.f, 0.f};
#pragma unroll
            for (int j = 0; j < 4; ++j) { N2 = __builtin_amdgcn_mfma_f32_16x16x4f32(NT[j], Nn[j], N2, 0, 0, 0); N2T = __builtin_amdgcn_mfma_f32_16x16x4f32(Nn[j], NT[j], N2T, 0, 0, 0); }
            f32x4 Tn = Tt;
#pragma unroll
            for (int j = 0; j < 4; ++j) Tn = __builtin_amdgcn_mfma_f32_16x16x4f32(N2[j], Tt[j], Tn, 0, 0, 0);
            Tt = Tn; Nn = N2; NT = N2T;
        }
#pragma unroll
        for (int i = 0; i < 4; ++i) TT[(4 * q + i) * 16 + s] = f2bf(-Tt[i]);
    }
}
__device__ __forceinline__ void scan2_stageE(unsigned char* lds, int c, int w, int lane, f32x4 (&P)[4], bf16_t* __restrict__ yout, int ystride, int tb, int S, int dir, int cb = 0) {
    const unsigned char* sc = lds + S2_SC + (c % 3) * S2_SC_SZ; const unsigned char* sd = lds + S2_SD + (c & 1) * S2_SD_SZ;
    const bf16_t* KT = (const bf16_t*)sc; const bf16_t* RT = KT + 1152; const bf16_t* BTT = KT + 4608; const bf16_t* KKTT = BTT + 1024; const bf16_t* VT = KKTT + 1024; const float* GL = (const float*)(sc + 15360);
    const bf16_t* AKK = (const bf16_t*)sd; const bf16_t* ABR = AKK + 256; const bf16_t* AKR = ABR + 256; const bf16_t* TT = AKR + 256;
    const int jl = lane & 15, q = lane >> 4;
    const f32x4 zero = {0.f, 0.f, 0.f, 0.f};
    const bf16x8 Pb0 = fragff(P[0], P[1]), Pb1 = fragff(P[2], P[3]);
    f32x4 QT = __builtin_amdgcn_mfma_f32_16x16x32_bf16(frag2(KT + jl * 72 + 4 * q, KT + jl * 72 + 16 + 4 * q), Pb0, zero, 0, 0, 0);
    QT = __builtin_amdgcn_mfma_f32_16x16x32_bf16(frag2(KT + jl * 72 + 32 + 4 * q, KT + jl * 72 + 48 + 4 * q), Pb1, QT, 0, 0, 0);
    f32x4 YT = __builtin_amdgcn_mfma_f32_16x16x32_bf16(frag2(RT + jl * 72 + 4 * q, RT + jl * 72 + 16 + 4 * q), Pb0, zero, 0, 0, 0);
    YT = __builtin_amdgcn_mfma_f32_16x16x32_bf16(frag2(RT + jl * 72 + 32 + 4 * q, RT + jl * 72 + 48 + 4 * q), Pb1, YT, 0, 0, 0);
    const bf16x8 Vb = frag1(VT + (16 * w + jl) * 16 + 4 * q);
    QT = __builtin_amdgcn_mfma_f32_16x16x32_bf16(frag1(AKK + jl * 16 + 4 * q), Vb, QT, 0, 0, 0);
    const f32x4 UT = __builtin_amdgcn_mfma_f32_16x16x32_bf16(frag1(TT + jl * 16 + 4 * q), fragf(QT), zero, 0, 0, 0);
    const bf16x8 Ub = fragf(UT);
    YT = __builtin_amdgcn_mfma_f32_16x16x32_bf16(frag1(ABR + jl * 16 + 4 * q), Ub, YT, 0, 0, 0);
    YT = __builtin_amdgcn_mfma_f32_16x16x32_bf16(frag1(AKR + jl * 16 + 4 * q), Vb, YT, 0, 0, 0);
#pragma unroll
    for (int i = 0; i < 4; ++i) { const int pos = (c + cb) * 16 + 4 * q + i, t = dir ? S - 1 - pos : pos; yout[(size_t)(tb + t) * ystride + 16 * w + jl] = f2bf(YT[i]); }
#pragma unroll
    for (int mt = 0; mt < 4; ++mt) {
        P[mt] = __builtin_amdgcn_mfma_f32_16x16x32_bf16(frag1(BTT + (16 * mt + jl) * 16 + 4 * q), Ub, P[mt], 0, 0, 0);
        P[mt] = __builtin_amdgcn_mfma_f32_16x16x32_bf16(frag1(KKTT + (16 * mt + jl) * 16 + 4 * q), Vb, P[mt], 0, 0, 0);
        const float4 gl = *(const float4*)(GL + 16 * mt + 4 * q);
        P[mt][0] *= gl.x; P[mt][1] *= gl.y; P[mt][2] *= gl.z; P[mt][3] *= gl.w;
    }
}

__device__ __forceinline__ void scan2_stageE1(unsigned char* lds, int c, int w, int lane, f32x4 (&P)[4], f32x4 (&X)[4]) {
    const unsigned char* sc = lds + S2_SC + (c % 3) * S2_SC_SZ; const unsigned char* sd = lds + S2_SD + (c & 1) * S2_SD_SZ;
    const bf16_t* KT = (const bf16_t*)sc; const bf16_t* BTT = KT + 4608; const bf16_t* KKTT = BTT + 1024; const bf16_t* VT = KKTT + 1024; const float* GL = (const float*)(sc + 15360);
    const bf16_t* AKK = (const bf16_t*)sd; const bf16_t* TT = AKK + 768;
    const int jl = lane & 15, q = lane >> 4;
    const f32x4 zero = {0.f, 0.f, 0.f, 0.f};
    const bf16x8 KT0 = frag2(KT + jl * 72 + 4 * q, KT + jl * 72 + 16 + 4 * q), KT1 = frag2(KT + jl * 72 + 32 + 4 * q, KT + jl * 72 + 48 + 4 * q);
    f32x4 QT = __builtin_amdgcn_mfma_f32_16x16x32_bf16(KT0, fragff(P[0], P[1]), zero, 0, 0, 0);
    QT = __builtin_amdgcn_mfma_f32_16x16x32_bf16(KT1, fragff(P[2], P[3]), QT, 0, 0, 0);
    f32x4 QX = __builtin_amdgcn_mfma_f32_16x16x32_bf16(KT0, fragff(X[0], X[1]), zero, 0, 0, 0);
    QX = __builtin_amdgcn_mfma_f32_16x16x32_bf16(KT1, fragff(X[2], X[3]), QX, 0, 0, 0);
    const bf16x8 Vb = frag1(VT + (16 * w + jl) * 16 + 4 * q);
    QT = __builtin_amdgcn_mfma_f32_16x16x32_bf16(frag1(AKK + jl * 16 + 4 * q), Vb, QT, 0, 0, 0);
    const bf16x8 TTf = frag1(TT + jl * 16 + 4 * q);
    const f32x4 UT = __builtin_amdgcn_mfma_f32_16x16x32_bf16(TTf, fragf(QT), zero, 0, 0, 0), UX = __builtin_amdgcn_mfma_f32_16x16x32_bf16(TTf, fragf(QX), zero, 0, 0, 0);
    const bf16x8 Ub = fragf(UT), UXb = fragf(UX);
#pragma unroll
    for (int mt = 0; mt < 4; ++mt) {
        const bf16x8 Bf = frag1(BTT + (16 * mt + jl) * 16 + 4 * q);
        P[mt] = __builtin_amdgcn_mfma_f32_16x16x32_bf16(Bf, Ub, P[mt], 0, 0, 0);
        P[mt] = __builtin_amdgcn_mfma_f32_16x16x32_bf16(frag1(KKTT + (16 * mt + jl) * 16 + 4 * q), Vb, P[mt], 0, 0, 0);
        X[mt] = __builtin_amdgcn_mfma_f32_16x16x32_bf16(Bf, UXb, X[mt], 0, 0, 0);
        const float4 gl = *(const float4*)(GL + 16 * mt + 4 * q);
        P[mt][0] *= gl.x; P[mt][1] *= gl.y; P[mt][2] *= gl.z; P[mt][3] *= gl.w; X[mt][0] *= gl.x; X[mt][1] *= gl.y; X[mt][2] *= gl.z; X[mt][3] *= gl.w;
    }
}

__device__ __forceinline__ void scan2_run(const Params& p, unsigned char* lds, const bool lat, const int b, const int h, const int dir, const int cb, const int nch, const int mode, const int seg) {
    int tid = threadIdx.x; asm volatile("" : "+v"(tid));
    const int wid = __builtin_amdgcn_readfirstlane(tid >> 6), lane = tid & 63;
    unsigned char* ws = p.ws;
    const bf16_t* Z = (const bf16_t*)(ws + WS_Z);
    const int S = lat ? 4096 : 256, tb = lat ? NCTX + b * 4096 : b * 256;
    float* SEG = (float*)(ws + WS_SEG) + (size_t)((b * 8 + h) * 2 + dir) * 3 * 8192;
    { float* CM = (float*)(lds + S2_CONST); bf16_t* CWT = (bf16_t*)(lds + S2_CONST + 2560);
      if (tid < 320) { const int sec = tid >> 6, j = tid & 63; CM[tid] = p.in[I_MU][(sec < 3 ? sec * 512 + h * 64 : (sec == 3 ? 1536 + dir * 64 : 1664 + dir * 64)) + j]; }
      else if (tid < 384) CM[tid] = p.in[I_KK][h * 64 + tid - 320];
      else if (tid < 448) CM[tid] = p.in[I_KA][h * 64 + tid - 384];
      else CM[tid] = p.in[I_RK][h * 64 + tid - 448];
      if (tid < 128) CM[512 + tid] = (tid < 64 ? p.in[I_W0] : p.in[I_A0])[dir * 512 + h * 64 + (tid & 63)];
      for (int e = tid; e < 1024; e += 512) { const int mat = e >> 9, j = (e >> 3) & 63, i8 = e & 7;
          *(u32x4*)(CWT + mat * 4608 + j * 72 + i8 * 8) = *(const u32x4*)((const bf16_t*)(ws + (mat ? WS_A2T : WS_W2T)) + (size_t)dir * 512 * 64 + (size_t)(h * 64 + j) * 64 + i8 * 8); }
      SCAN_BAR(); }
    bf16_t* yout = dir == 0 ? (bf16_t*)(ws + WS_H) + 512 + h * 64 : (bf16_t*)(ws + WS_Y1) + h * 64; const int ystride = dir == 0 ? DM : DRW;
    const int vrow = 16 * (wid & 3) + (lane & 15), q4 = lane >> 4;
    f32x4 P[4];
#pragma unroll
    for (int mt = 0; mt < 4; ++mt) P[mt] = (f32x4){0.f, 0.f, 0.f, 0.f};
    if (mode == 0 && lat) {
        if (wid < 4) {
#pragma unroll
            for (int mt = 0; mt < 4; ++mt) P[mt] = *(const f32x4*)((dir ? p.in[I_SB] : p.in[I_SF]) + ((size_t)(b * 8 + h) * 64 + vrow) * 64 + 16 * mt + 4 * q4);
        }
        float* XL = (float*)(lds + S2_SA);
        for (int jj = 0; jj < seg; ++jj) {
            const float* Xg = SEG + (size_t)jj * 8192; const float* Ng = Xg + 4096;
            for (int e = tid; e < 1024; e += 512) *(float4*)(XL + e * 4) = *(const float4*)(Xg + e * 4);
            SCAN_BAR();
            if (wid < 4) {
                f32x4 Pn[4];
#pragma unroll
                for (int mt = 0; mt < 4; ++mt) { Pn[mt] = *(const f32x4*)(Ng + vrow * 64 + 16 * mt + 4 * q4);
#pragma unroll
                    for (int m2 = 0; m2 < 4; ++m2)
#pragma unroll
                        for (int j = 0; j < 4; ++j) Pn[mt] = __builtin_amdgcn_mfma_f32_16x16x4f32(XL[(16 * m2 + 4 * q4 + j) * 64 + 16 * mt + (lane & 15)], P[m2][j], Pn[mt], 0, 0, 0); }
#pragma unroll
                for (int mt = 0; mt < 4; ++mt) P[mt] = Pn[mt];
            }
            SCAN_BAR();
        }
    }
    if (wid >= 6) {
        Scan2Loads L0, L1; const int pw = wid - 6;
        const bool nr = mode == 0; scan2_issue(L0, Z, tb, S, lat, dir, h, cb, pw, lane, nr); scan2_issue(L1, Z, tb, S, lat, dir, h, cb + 1, pw, lane, nr);
        for (int pd = 0; pd < nch + 4; pd += 2) {
            if (pd < nch) { scan2_stageA(L0, lds, pd, pw, lane, nr); if (pd + 2 < nch) scan2_issue(L0, Z, tb, S, lat, dir, h, cb + pd + 2, pw, lane, nr); }
            SCAN_BAR();
            if (pd + 1 < nch) { scan2_stageA(L1, lds, pd + 1, pw, lane, nr); if (pd + 3 < nch) scan2_issue(L1, Z, tb, S, lat, dir, h, cb + pd + 3, pw, lane, nr); }
            SCAN_BAR();
        }
    } else if (wid >= 4) {
        for (int pd = 0; pd < nch + 4; ++pd) { const int c = pd - 1; if (c >= 0 && c < nch) scan2_stageB(p, lds, c, wid == 5, tb, S, dir, h, lane, cb, mode == 0); SCAN_BAR(); }
    } else if (mode == 0) {
        for (int pd = 0; pd < nch + 4; ++pd) {
            const int cE = pd - 4, cC = pd - 2, cD = pd - 3;
            if (cE >= 0 && cE < nch) scan2_stageE(lds, cE, wid, lane, P, yout, ystride, tb, S, dir, cb);
            if (cC >= 0 && cC < nch) scan2_stageC(lds, cC, wid, lane);
            if (cD >= 0 && cD < nch) scan2_stageD(lds, cD, wid, lane);
            SCAN_BAR();
        }
        if (!lat) {
#pragma unroll
            for (int mt = 0; mt < 4; ++mt) *(f32x4*)(p.out + (size_t)NTOK * DM + (size_t)dir * 524288 + ((size_t)(b * 8 + h) * 64 + vrow) * 64 + 16 * mt + 4 * q4) = P[mt];
        }
    } else {
        f32x4 X[4];
#pragma unroll
        for (int mt = 0; mt < 4; ++mt)
#pragma unroll
            for (int i = 0; i < 4; ++i) X[mt][i] = (16 * mt + 4 * q4 + i == vrow) ? 1.0f : 0.0f;
        for (int pd = 0; pd < nch + 4; ++pd) {
            const int cE = pd - 4, cC = pd - 2, cD = pd - 3;
            if (cE >= 0 && cE < nch) scan2_stageE1(lds, cE, wid, lane, P, X);
            if (cC >= 0 && cC < nch) { if (wid >= 2) { scan2_stageC(lds, cC, wid, lane); scan2_stageC(lds, cC, wid == 2 ? 1 : 0, lane); } }
            if (cD >= 0 && cD < nch && wid < 2) scan2_stageD(lds, cD, wid, lane);
            SCAN_BAR();
        }
        float* Xg = SEG + (size_t)seg * 8192; float* Ng = Xg + 4096;
#pragma unroll
        for (int mt = 0; mt < 4; ++mt) { *(f32x4*)(Xg + vrow * 64 + 16 * mt + 4 * q4) = X[mt]; *(f32x4*)(Ng + vrow * 64 + 16 * mt + 4 * q4) = P[mt]; }
    }
    SCAN_BAR();
}
__device__ __forceinline__ void scan3_pass1(const Params& p, unsigned char* lds) {
    const int bk = blockIdx.x;
    if (bk < 192) { const int it = bk / 3, seg = bk % 3; scan2_run(p, lds, true, it >> 4, (it >> 1) & 7, it & 1, seg * 64, 64, 1, seg); }
}
__device__ __forceinline__ void scan3_pass2(const Params& p, unsigned char* lds) {
    const int bk = blockIdx.x;
    { const int it = bk >> 2, seg = bk & 3; scan2_run(p, lds, true, it >> 4, (it >> 1) & 7, it & 1, seg * 64, 64, 0, seg); }
    { const int ci = bk; scan2_run(p, lds, false, ci >> 4, (ci >> 1) & 7, ci & 1, 0, 16, 0, 0); }
}
__device__ __forceinline__ void scan2_phase(const Params& p, unsigned char* lds) {
    int tid = threadIdx.x; asm volatile("" : "+v"(tid));
    const int wid = __builtin_amdgcn_readfirstlane(tid >> 6), lane = tid & 63;
    unsigned char* ws = p.ws;
    const bf16_t* Z = (const bf16_t*)(ws + WS_Z);
    const int nbk = gridDim.x, bk = blockIdx.x; const bool bal = nbk == 256;
    for (int it = bk; it < 320; it += nbk) {
        const bool lat = it < 64; const int q_ = lat ? it : it - 64;
        const int dir = q_ & 1, h = (q_ >> 1) & 7, b = q_ >> 4;
        const int S = lat ? 4096 : 256, tb = lat ? NCTX + b * 4096 : b * 256, nch = S >> 4;
        { float* CM = (float*)(lds + S2_CONST); bf16_t* CWT = (bf16_t*)(lds + S2_CONST + 2560);
          if (tid < 320) { const int sec = tid >> 6, j = tid & 63; CM[tid] = p.in[I_MU][(sec < 3 ? sec * 512 + h * 64 : (sec == 3 ? 1536 + dir * 64 : 1664 + dir * 64)) + j]; }
          else if (tid < 384) CM[tid] = p.in[I_KK][h * 64 + tid - 320];
          else if (tid < 448) CM[tid] = p.in[I_KA][h * 64 + tid - 384];
          else CM[tid] = p.in[I_RK][h * 64 + tid - 448];
          if (tid < 128) CM[512 + tid] = (tid < 64 ? p.in[I_W0] : p.in[I_A0])[dir * 512 + h * 64 + (tid & 63)];
          for (int e = tid; e < 1024; e += 512) { const int mat = e >> 9, j = (e >> 3) & 63, i8 = e & 7;
              *(u32x4*)(CWT + mat * 4608 + j * 72 + i8 * 8) = *(const u32x4*)((const bf16_t*)(ws + (mat ? WS_A2T : WS_W2T)) + (size_t)dir * 512 * 64 + (size_t)(h * 64 + j) * 64 + i8 * 8); }
          SCAN_BAR(); }
        bf16_t* yout = dir == 0 ? (bf16_t*)(ws + WS_H) + 512 + h * 64 : (bf16_t*)(ws + WS_Y1) + h * 64; const int ystride = dir == 0 ? DM : DRW;
        if (wid >= 6) {
            Scan2Loads L0, L1; const int pw = wid - 6;
            scan2_issue(L0, Z, tb, S, lat, dir, h, 0, pw, lane); scan2_issue(L1, Z, tb, S, lat, dir, h, 1, pw, lane);
            for (int pd = 0; pd < nch + 4; pd += 2) {
                if (pd < nch) { scan2_stageA(L0, lds, pd, pw, lane); if (pd + 2 < nch) scan2_issue(L0, Z, tb, S, lat, dir, h, pd + 2, pw, lane); }
                SCAN_BAR();
                if (pd + 1 < nch) { scan2_stageA(L1, lds, pd + 1, pw, lane); if (pd + 3 < nch) scan2_issue(L1, Z, tb, S, lat, dir, h, pd + 3, pw, lane); }
                SCAN_BAR();
            }
        } else if (wid >= 4) {
            for (int pd = 0; pd < nch + 4; ++pd) { const int c = pd - 1; if (c >= 0 && c < nch) scan2_stageB(p, lds, c, wid == 5, tb, S, dir, h, lane); SCAN_BAR(); }
        } else {
            f32x4 P[4];
#pragma unroll
            for (int mt = 0; mt < 4; ++mt) P[mt] = (f32x4){0.f, 0.f, 0.f, 0.f};
            const int vrow = 16 * wid + (lane & 15);
            if (lat) {
#pragma unroll
                for (int mt = 0; mt < 4; ++mt) P[mt] = *(const f32x4*)((dir ? p.in[I_SB] : p.in[I_SF]) + ((size_t)(b * 8 + h) * 64 + vrow) * 64 + 16 * mt + 4 * (lane >> 4));
            }
            for (int pd = 0; pd < nch + 4; ++pd) {
                const int cE = pd - 4, cC = pd - 2, cD = pd - 3;
                if (cE >= 0 && cE < nch) scan2_stageE(lds, cE, wid, lane, P, yout, ystride, tb, S, dir);
                if (cC >= 0 && cC < nch) scan2_stageC(lds, cC, wid, lane);
                if (cD >= 0 && cD < nch) scan2_stageD(lds, cD, wid, lane);
                SCAN_BAR();
            }
            if (!lat) {
#pragma unroll
                for (int mt = 0; mt < 4; ++mt) *(f32x4*)(p.out + (size_t)NTOK * DM + (size_t)dir * 524288 + ((size_t)(b * 8 + h) * 64 + vrow) * 64 + 16 * mt + 4 * (lane >> 4)) = P[mt];
            }
        }
        SCAN_BAR();
    }
}

__device__ __forceinline__ void finalize_phase(const Params& p, unsigned char* lds) {
    bf16_t* GA = (bf16_t*)lds;
    const int tid = threadIdx.x, wid = tid >> 6, lane = tid & 63;
    unsigned char* ws = p.ws;
    const bf16_t* Z = (const bf16_t*)(ws + WS_Z); bf16_t* MIX = (bf16_t*)(ws + WS_H); const bf16_t* Y1 = (const bf16_t*)(ws + WS_Y1); const float* BON = (const float*)(ws + WS_BONUS);
    const bf16_t* G2T = (const bf16_t*)(ws + WS_G2T); const float* mu = p.in[I_MU];
    bf16x8 bfr[4][4]; float lw[4], lb[4];
#pragma unroll
    for (int nt = 0; nt < 4; ++nt) { const int c = 64 * wid + 16 * nt + (lane & 15); lw[nt] = p.in[I_LNW][c]; lb[nt] = p.in[I_LNB][c];
#pragma unroll
        for (int k4 = 0; k4 < 4; ++k4) bfr[k4][nt] = *(const bf16x8*)(G2T + (size_t)c * 128 + 32 * k4 + 8 * (lane >> 4)); }
    for (int tile = blockIdx.x; tile < 1280; tile += gridDim.x) {
        const int t0 = tile * 16; const bool lat = t0 >= NCTX;
        const int b = lat ? (t0 - NCTX) >> 12 : t0 >> 8, tb = lat ? NCTX + b * 4096 : b * 256, S = lat ? 4096 : 256, tl0 = t0 - tb;
        for (int e = tid; e < 2048; e += 512) { const int tt = e >> 7, j = e & 127, col = 1792 + j; GA[tt * 136 + j] = f2bf(sigm(zshift(Z, tb, tl0 + tt, S, lat, col, mu[col]))); }
        float ys[4][4], vs[4][4], bon[4];
#pragma unroll
        for (int i = 0; i < 4; ++i) {
            const int tl = tl0 + 4 * (lane >> 4) + i, tg = tb + tl;
            bon[i] = BON[(size_t)tg * 16 + wid] + BON[(size_t)tg * 16 + 8 + wid];
#pragma unroll
            for (int nt = 0; nt < 4; ++nt) { const int c = 64 * wid + 16 * nt + (lane & 15);
                ys[i][nt] = bf2f(MIX[(size_t)tg * DM + 512 + c]) + bf2f(Y1[(size_t)tg * DRW + c]);
                vs[i][nt] = zshift(Z, tb, tl, S, lat, 1024 + c, mu[1024 + c]); }
        }
        __syncthreads();
        f32x4 acc[4];
#pragma unroll
        for (int nt = 0; nt < 4; ++nt) acc[nt] = (f32x4){0.f, 0.f, 0.f, 0.f};
#pragma unroll
        for (int k4 = 0; k4 < 4; ++k4) { const bf16x8 a = *(const bf16x8*)(GA + (lane & 15) * 136 + 32 * k4 + 8 * (lane >> 4));
#pragma unroll
            for (int nt = 0; nt < 4; ++nt) acc[nt] = __builtin_amdgcn_mfma_f32_16x16x32_bf16(a, bfr[k4][nt], acc[nt], 0, 0, 0); }
        bf16_t ov[4][4];
#pragma unroll
        for (int i = 0; i < 4; ++i) {
            const float sm = (ys[i][0] + ys[i][1]) + (ys[i][2] + ys[i][3]);
            const float mean = red16(sm) * (1.0f / 64.0f); float sq = 0.f;
#pragma unroll
            for (int nt = 0; nt < 4; ++nt) { const float d = ys[i][nt] - mean; sq += d * d; }
            const float rstd = rsqrtf(red16(sq) * (1.0f / 64.0f) + 64e-5f);
#pragma unroll
            for (int nt = 0; nt < 4; ++nt) ov[i][nt] = f2bf(((ys[i][nt] - mean) * rstd * lw[nt] + lb[nt] + bon[i] * vs[i][nt]) * acc[nt][i]);
        }
#pragma unroll
        for (int i = 0; i < 4; ++i) { const int tg = tb + tl0 + 4 * (lane >> 4) + i;
#pragma unroll
            for (int nt = 0; nt < 4; ++nt) MIX[(size_t)tg * DM + 512 + 64 * wid + 16 * nt + (lane & 15)] = ov[i][nt]; }
        __syncthreads();
    }
}

#ifndef PROBE_DUP
#define PROBE_DUP 0
#endif
__global__ void __launch_bounds__(512, 2) fwd_megakernel(Params p) {
    extern __shared__ __attribute__((aligned(16))) unsigned char shm[];
    cg::grid_group grid = cg::this_grid();
    unsigned* bar = (unsigned*)(p.ws + WS_BAR);
    volatile PG8_LAS unsigned* st = (volatile PG8_LAS unsigned*)((PG8_LAS unsigned char*)shm + (LDS_BYTES - 16));
    if (threadIdx.x == 0) { st[0] = 0u; st[1] = 0u; }
    PG8_LAS unsigned char* lds3 = (PG8_LAS unsigned char*)shm;
    unsigned char* ws = p.ws; float* out = p.out; const float* mod = (const float*)(ws + WS_MOD);
    const char* H = (const char*)(ws + WS_H); const int G = gridDim.x, c = blockIdx.x;

    __syncthreads();
    const XcdBarrier xb = xcd_barrier_post(bar, st);
    if (p.out == nullptr) grid.sync();
    phase0(p, shm);
    xcd_barrier(xb);
#if PROBE_DUP == 3
    phase0(p, shm);
    xcd_barrier(xb);
#endif
    norm_phase(p.in[I_XP], p.in[I_XS], p.in[I_NORMG], mod, 0, 1024, (bf16_t*)(ws + WS_H));
    for (int e = blockIdx.x * 512 + threadIdx.x; e < 10240; e += gridDim.x * 512) { const int which = e / 5120, r = (e % 5120) >> 10, k = e & 1023;
        ((float*)(ws + WS_GP))[e] = p.in[I_NORMG][(1 + which) * 1024 + k] * (1.0f + mod[r * NMOD + (which ? 7168 : 4096) + k]); }
    __syncthreads();
    ffn_conv(p.in[I_WG], p.in[I_WU], p.in[I_WD], (bf16_t*)(ws + WS_W1GU), (bf16_t*)(ws + WS_W1D), (float*)shm, c, G);
    xcd_barrier(xb);
#if PROBE_DUP == 8
    norm_phase(p.in[I_XP], p.in[I_XS], p.in[I_NORMG], mod, 0, 1024, (bf16_t*)(ws + WS_H));
    xcd_barrier(xb);
#endif
    { SchedPlain S{H, (const char*)(ws + WS_W1GU), 80, 22, DM, G, c}; EpiGU E{(bf16_t*)(ws + WS_ACT)}; pg8::gemm_phase(lds3, DM, S, E); }
    xcd_barrier(xb);
#if PROBE_DUP == 5
    { SchedPlain S{H, (const char*)(ws + WS_W1GU), 80, 22, DM, G, c}; EpiGU E{(bf16_t*)(ws + WS_ACT)}; pg8::gemm_phase(lds3, DM, S, E); }
    xcd_barrier(xb);
#endif
    { SchedPlain S{(const char*)(ws + WS_ACT), (const char*)(ws + WS_W1D), 80, 4, DFF, G, c}; EpiResN E{p.in[I_XP], p.in[I_XS], out, ws, 2048, 0.5f, 0}; pg8::gemm_phase(lds3, DFF, S, E); }
    if (G == 256) { if (c >= 64) phase0b(p, shm, c - 64, 192); } else phase0b(p, shm, c, G);
    xcd_barrier(xb);
#if PROBE_DUP == 6
    { SchedPlain S{(const char*)(ws + WS_ACT), (const char*)(ws + WS_W1D), 80, 4, DFF, G, c}; EpiRes E{p.in[I_XP], p.in[I_XS], out, mod, 2048, 0.5f}; pg8::gemm_phase(lds3, DFF, S, E); }
    xcd_barrier(xb);
#endif
    { SchedWin S{H, (const char*)(ws + WS_WZ), (const char*)(ws + WS_WF), G, c}; EpiWinN E{(bf16_t*)(ws + WS_Z), (bf16_t*)(ws + WS_PT), (const float*)(ws + WS_SSQ), (const float*)(ws + WS_CBW)}; pg8::gemm_phase(lds3, DM, S, E); }
    xcd_barrier(xb);
#if PROBE_DUP == 7
    { SchedWin S{H, (const char*)(ws + WS_WZ), (const char*)(ws + WS_WF), G, c}; EpiWin E{(bf16_t*)(ws + WS_Z), (bf16_t*)(ws + WS_PT)}; pg8::gemm_phase(lds3, DM, S, E); }
    xcd_barrier(xb);
#endif
    if (G == 256) {
        scan3_pass1(p, shm);
        __syncthreads();
        { SchedFourSym S{(const char*)(ws + WS_DLAT), (const char*)(ws + WS_PT) + (size_t)4194304 * 2, c >= 192 ? c - 192 : 1000}; EpiFourSym E{(bf16_t*)(ws + WS_H), 1.0f / 512.0f}; pg8::gemm_phase(lds3, 8192, S, E, 4096); }
        fourier_nyquist((const bf16_t*)(ws + WS_PT) + 4194304, (bf16_t*)(ws + WS_H), 1.0f / 512.0f);
        __syncthreads();
        { SchedFourCtx S{(const char*)(ws + WS_DCTX), (const char*)(ws + WS_PT), 1024, c >= 192 && c < 224 ? c - 192 : 1000}; EpiFour E{(bf16_t*)(ws + WS_H), 1.0f / 128.0f}; pg8::gemm_phase(lds3, 512, S, E); }
        xcd_barrier(xb);
        scan3_pass2(p, shm);
        __syncthreads();
    } else {
    scan2_phase(p, shm);
    __syncthreads();
    { SchedFourLat S{(const char*)(ws + WS_DLAT), (const char*)(ws + WS_PT) + (size_t)4194304 * 2, G, c}; EpiFour E{(bf16_t*)(ws + WS_H), 1.0f / 512.0f}; pg8::gemm_phase(lds3, 8192, S, E); }
    __syncthreads();
    }
#if PROBE_DUP == 2
    { SchedFourLat S{(const char*)(ws + WS_DLAT), (const char*)(ws + WS_PT) + (size_t)4194304 * 2, G, c}; EpiFour E{(bf16_t*)(ws + WS_H), 1.0f / 512.0f}; pg8::gemm_phase(lds3, 8192, S, E); }
    __syncthreads();
#endif
    if (G != 256) { SchedFourCtx S{(const char*)(ws + WS_DCTX), (const char*)(ws + WS_PT), G, c}; EpiFour E{(bf16_t*)(ws + WS_H), 1.0f / 128.0f}; pg8::gemm_phase(lds3, 512, S, E); }
    xcd_barrier(xb);
    finalize_phase(p, shm);
    xcd_barrier(xb);
#if PROBE_DUP == 4
    xcd_barrier(xb); xcd_barrier(xb); xcd_barrier(xb); xcd_barrier(xb); xcd_barrier(xb); xcd_barrier(xb); xcd_barrier(xb); xcd_barrier(xb); xcd_barrier(xb); xcd_barrier(xb);
#endif
    { SchedPlain S{H, (const char*)(ws + WS_WOUT), 80, 4, DM, G, c}; EpiResN E{out, out + (size_t)NCTX * DM, out, ws, 5120, 1.0f, 1}; pg8::gemm_phase(lds3, DM, S, E); }
    __syncthreads();
    if (G == 256) { if (c >= 64) ffn_conv(p.in[I_WG] + (size_t)DM * DFF, p.in[I_WU] + (size_t)DM * DFF, p.in[I_WD] + (size_t)DM * DFF, (bf16_t*)(ws + WS_W2GU), (bf16_t*)(ws + WS_W2D), (float*)shm, c - 64, 192); }
    else ffn_conv(p.in[I_WG] + (size_t)DM * DFF, p.in[I_WU] + (size_t)DM * DFF, p.in[I_WD] + (size_t)DM * DFF, (bf16_t*)(ws + WS_W2GU), (bf16_t*)(ws + WS_W2D), (float*)shm, c, G);
    xcd_barrier(xb);
    { SchedPlain S{(const char*)(ws + WS_XG3), (const char*)(ws + WS_W2GU), 80, 22, DM, G, c}; EpiGUN E{(bf16_t*)(ws + WS_ACT), (const float*)(ws + WS_SSQ), (const float*)(ws + WS_CBG)}; pg8::gemm_phase(lds3, DM, S, E); }
    xcd_barrier(xb);
    { SchedPlain S{(const char*)(ws + WS_ACT), (const char*)(ws + WS_W2D), 80, 4, DFF, G, c}; EpiResB16 E{out, out + (size_t)NCTX * DM, (bf16_t*)(ws + WS_XG3), mod, 8192, 0.5f}; pg8::gemm_phase(lds3, DFF, S, E); }
    xcd_barrier(xb);
    final_norm_phase(out, p.in[I_FN], (const bf16_t*)(ws + WS_XG3));
}

extern "C" void kernel_launch(void* const* d_in, const int* in_sizes, int n_in, void* d_out, int out_size, void* d_ws, size_t ws_size, hipStream_t stream) {
    static int grid_blocks = 0;
    if (grid_blocks == 0) {
        if (n_in != 26 || ws_size < WS_END) { fprintf(stderr, "kernel_launch: unexpected n_in %d / ws_size %zu (need %zu)\n", n_in, ws_size, (size_t)WS_END); grid_blocks = -1; return; }
        int dev = 0, cus = 0, per_cu = 0;
        hipGetDevice(&dev);
        hipDeviceGetAttribute(&cus, hipDeviceAttributeMultiprocessorCount, dev);
        if (hipFuncSetAttribute((const void*)fwd_megakernel, hipFuncAttributeMaxDynamicSharedMemorySize, LDS_BYTES) != hipSuccess) { fprintf(stderr, "kernel_launch: hipFuncSetAttribute failed\n"); grid_blocks = -1; return; }
        if (hipOccupancyMaxActiveBlocksPerMultiprocessor(&per_cu, (const void*)fwd_megakernel, 512, LDS_BYTES) != hipSuccess || per_cu < 1) { fprintf(stderr, "kernel_launch: occupancy query failed (%d)\n", per_cu); grid_blocks = -1; return; }
        grid_blocks = cus * per_cu;
    }
    if (grid_blocks < 0) return;
    Params p{};
    for (int i = 0; i < 26; ++i) p.in[i] = (const float*)d_in[i];
    p.out = (float*)d_out; p.ws = (unsigned char*)d_ws;
    void* args[] = {&p};
    if (hipMemsetAsync((unsigned char*)d_ws + WS_BAR, 0, XCD_BAR_WORDS * sizeof(unsigned), stream) != hipSuccess) { fprintf(stderr, "kernel_launch: hipMemsetAsync of the barrier words failed\n"); return; }
    hipError_t e = hipLaunchCooperativeKernel((const void*)fwd_megakernel, dim3(grid_blocks), dim3(512), args, LDS_BYTES, stream);
    if (e != hipSuccess) fprintf(stderr, "cooperative launch failed: %s (grid %d)\n", hipGetErrorString(e), grid_blocks);
}
```
